# Optimizing an MI355X kernel written in HIP

```python
import math
import jax
import jax.numpy as jnp
from jax import lax
import numpy as np

D_MODEL = 2048
BATCH = 1
SEQ = 8192
DEPTH = 4

N_MIXERS = 2
A_HEADS = 16
A_HEAD_DIM = D_MODEL // A_HEADS
A_KV_HEADS = 4
A_GROUP = A_HEADS // A_KV_HEADS
IDX_HEADS = 16
IDX_DIM = 64
TOPK_MAX = 256
Q_BLOCK = 128
REL_BUCKETS = 32
REL_MAX_DIST = 128
B_KEY_DIM = 128
B_HEADS = D_MODEL // B_KEY_DIM
B_VAL_DIM = D_MODEL // B_HEADS
CHUNK = 64
D_FF = 5632
EPS = 1e-6

N_A_LAYERS = (DEPTH + N_MIXERS - 1) // N_MIXERS
N_B_LAYERS = DEPTH // N_MIXERS
A_Q_COLS = A_HEADS * A_HEAD_DIM
A_KV_COLS = A_KV_HEADS * A_HEAD_DIM
A_IQ_COLS = IDX_HEADS * IDX_DIM
A_IN_COLS = A_Q_COLS + 2 * A_KV_COLS + A_IQ_COLS + IDX_DIM + IDX_HEADS
B_IN_COLS = 4 * D_MODEL

kernel_name = 'hybrid_dsa_hgrn2_macaron_trunk'


def rmsnorm(x, g):
    xf = x.astype(jnp.float32)
    y = xf * lax.rsqrt(jnp.mean(xf * xf, axis=-1, keepdims=True) + EPS)
    return (y * g.astype(jnp.float32)).astype(x.dtype)


def swiglu(x, w_gate, w_up, w_down):
    return (jax.nn.silu(x @ w_gate) * (x @ w_up)) @ w_down


def t5_bucket(dist):
    exact = REL_BUCKETS // 2
    d = jnp.maximum(dist, 0)
    df = jnp.maximum(d, 1).astype(jnp.float32)
    large = exact + (jnp.log(df / exact) / math.log(REL_MAX_DIST / exact) * (REL_BUCKETS - exact)).astype(jnp.int32)
    large = jnp.minimum(large, REL_BUCKETS - 1)
    return jnp.where(d < exact, d, large)


def dsa_mixer(h, w_in, w_out, q_gain, k_gain, idx_k_gain, rel_table):
    B, S, _ = h.shape
    topk = min(TOPK_MAX, S // 4)
    s1 = A_Q_COLS
    s2 = s1 + A_KV_COLS
    s3 = s2 + A_KV_COLS
    s4 = s3 + A_IQ_COLS
    s5 = s4 + IDX_DIM
    proj = h @ w_in
    q, k, v, iq, ik, iw = jnp.split(proj, [s1, s2, s3, s4, s5], axis=-1)
    q = rmsnorm(q.reshape(B, S, A_HEADS, A_HEAD_DIM), q_gain)
    k = rmsnorm(k.reshape(B, S, A_KV_HEADS, A_HEAD_DIM), k_gain)
    v = v.reshape(B, S, A_KV_HEADS, A_HEAD_DIM)
    iq = iq.reshape(B, S, IDX_HEADS, IDX_DIM)
    ik = rmsnorm(ik, idx_k_gain)
    iw = iw * (IDX_HEADS ** -0.5)
    key_pos = jnp.arange(S, dtype=jnp.int32)
    scale = A_HEAD_DIM ** -0.5

    def block(i):
        t0 = i * Q_BLOCK
        qpos = t0 + jnp.arange(Q_BLOCK, dtype=jnp.int32)
        iq_b = lax.dynamic_slice_in_dim(iq, t0, Q_BLOCK, axis=1)
        iw_b = lax.dynamic_slice_in_dim(iw, t0, Q_BLOCK, axis=1)
        q_b = lax.dynamic_slice_in_dim(q, t0, Q_BLOCK, axis=1)
        raw = jnp.einsum('bthd,bsd->bths', iq_b, ik) * (IDX_DIM ** -0.5)
        score = jnp.einsum('bth,bths->bts', iw_b, jax.nn.relu(raw)).astype(jnp.float32)
        causal = key_pos[None, :] <= qpos[:, None]
        score = jnp.where(causal[None], score, -jnp.inf)
        _, sel = lax.top_k(score, topk)
        valid = sel <= qpos[None, :, None]
        kg = jax.vmap(lambda kk, ii: kk[ii])(k, sel)
        vg = jax.vmap(lambda vv, ii: vv[ii])(v, sel)
        qg = q_b.reshape(B, Q_BLOCK, A_KV_HEADS, A_GROUP, A_HEAD_DIM)
        logits = jnp.einsum('btjgd,btnjd->btjgn', qg, kg).astype(jnp.float32) * scale
        bias = rel_table[t5_bucket(qpos[None, :, None] - sel)].astype(jnp.float32)
        bias = bias.reshape(B, Q_BLOCK, topk, A_KV_HEADS, A_GROUP).transpose(0, 1, 3, 4, 2)
        logits = jnp.where(valid[:, :, None, None, :], logits + bias, -jnp.inf)
        p = jax.nn.softmax(logits, axis=-1).astype(vg.dtype)
        o = jnp.einsum('btjgn,btnjd->btjgd', p, vg)
        return o.reshape(B, Q_BLOCK, A_HEADS * A_HEAD_DIM)

    o = lax.map(block, jnp.arange(S // Q_BLOCK))
    o = o.transpose(1, 0, 2, 3).reshape(B, S, A_HEADS * A_HEAD_DIM)
    return o @ w_out


def hgrn2_mixer(h, w_in, w_out, lower_bound, o_gain):
    B, S, _ = h.shape
    nc = S // CHUNK
    proj = h @ w_in
    q, f, i, g = jnp.split(proj, 4, axis=-1)
    f_gate = lower_bound + (1.0 - lower_bound) * jax.nn.sigmoid(f.astype(jnp.float32))
    k_in = 1.0 - f_gate
    log_f = jnp.log(f_gate)

    def to_chunks(a, d):
        return a.astype(jnp.float32).reshape(B, nc, CHUNK, B_HEADS, d).transpose(1, 0, 3, 2, 4)

    qc = to_chunks(q, B_KEY_DIM) * (B_KEY_DIM ** -0.5)
    kc = to_chunks(k_in, B_KEY_DIM)
    vc = to_chunks(i, B_VAL_DIM)
    lfc = to_chunks(log_f, B_KEY_DIM)
    tri = jnp.tril(jnp.ones((CHUNK, CHUNK), dtype=bool))

    def step(state, xs):
        qq, kk, vv, lf = xs
        b = jnp.cumsum(lf, axis=2)
        o_inter = jnp.einsum('bhtd,bhde->bhte', qq * jnp.exp(b), state)
        diff = b[:, :, :, None, :] - b[:, :, None, :, :]
        decay = jnp.exp(jnp.where(tri[:, :, None], diff, -jnp.inf))
        a = jnp.einsum('bhtd,bhsd,bhtsd->bhts', qq, kk, decay)
        o_intra = jnp.einsum('bhts,bhse->bhte', a, vv)
        b_last = b[:, :, -1, :]
        k_dec = kk * jnp.exp(b_last[:, :, None, :] - b)
        state = state * jnp.exp(b_last)[..., None] + jnp.einsum('bhsd,bhse->bhde', k_dec, vv)
        return state, o_inter + o_intra

    s0 = jnp.zeros((B, B_HEADS, B_KEY_DIM, B_VAL_DIM), jnp.float32)
    _, ys = lax.scan(step, s0, (qc, kc, vc, lfc))
    o = ys.transpose(1, 0, 3, 2, 4).reshape(B, S, B_HEADS, B_VAL_DIM)
    o = rmsnorm(o, o_gain.reshape(B_HEADS, B_VAL_DIM)).reshape(B, S, D_MODEL)
    o = (o * jax.nn.silu(g.astype(jnp.float32))).astype(h.dtype)
    return o @ w_out


def setup_inputs(seed: int = 0) -> dict:
    key = jax.random.key(seed)
    ks = jax.random.split(key, 16)
    nrm = jax.random.normal
    f32 = jnp.float32
    return {
        'x': nrm(ks[0], (BATCH, SEQ, D_MODEL), f32),
        'norm_gains': 1.0 + 0.02 * nrm(ks[1], (DEPTH, 3, D_MODEL), f32),
        'ffn_w_gate': nrm(ks[2], (DEPTH, 2, D_MODEL, D_FF), f32) * D_MODEL ** -0.5,
        'ffn_w_up': nrm(ks[3], (DEPTH, 2, D_MODEL, D_FF), f32) * D_MODEL ** -0.5,
        'ffn_w_down': nrm(ks[4], (DEPTH, 2, D_FF, D_MODEL), f32) * D_FF ** -0.5,
        'dsa_w_in': nrm(ks[5], (N_A_LAYERS, D_MODEL, A_IN_COLS), f32) * D_MODEL ** -0.5,
        'dsa_w_out': nrm(ks[6], (N_A_LAYERS, A_Q_COLS, D_MODEL), f32) * A_Q_COLS ** -0.5,
        'dsa_q_gain': 1.0 + 0.02 * nrm(ks[7], (N_A_LAYERS, A_HEAD_DIM), f32),
        'dsa_k_gain': 1.0 + 0.02 * nrm(ks[8], (N_A_LAYERS, A_HEAD_DIM), f32),
        'dsa_idx_k_gain': 1.0 + 0.02 * nrm(ks[9], (N_A_LAYERS, IDX_DIM), f32),
        'rel_bias': 0.5 * nrm(ks[10], (REL_BUCKETS, A_HEADS), f32),
        'hgrn_w_in': nrm(ks[11], (N_B_LAYERS, D_MODEL, B_IN_COLS), f32) * D_MODEL ** -0.5,
        'hgrn_w_out': nrm(ks[12], (N_B_LAYERS, D_MODEL, D_MODEL), f32) * D_MODEL ** -0.5,
        'hgrn_lb_logits': 0.5 * nrm(ks[13], (DEPTH, D_MODEL), f32),
        'hgrn_o_gain': 1.0 + 0.02 * nrm(ks[14], (N_B_LAYERS, D_MODEL), f32),
    }


def reference(x, norm_gains, ffn_w_gate, ffn_w_up, ffn_w_down, dsa_w_in, dsa_w_out, dsa_q_gain, dsa_k_gain, dsa_idx_k_gain, rel_bias, hgrn_w_in, hgrn_w_out, hgrn_lb_logits, hgrn_o_gain):
    p_lb = jax.nn.softmax(hgrn_lb_logits.astype(jnp.float32), axis=0)
    lower_bounds = jnp.cumsum(p_lb, axis=0) - p_lb[0]
    for layer in range(DEPTH):
        j = layer // N_MIXERS
        x = x + 0.5 * swiglu(rmsnorm(x, norm_gains[layer, 0]), ffn_w_gate[layer, 0], ffn_w_up[layer, 0], ffn_w_down[layer, 0])
        hm = rmsnorm(x, norm_gains[layer, 1])
        if layer % N_MIXERS == 0:
            x = x + dsa_mixer(hm, dsa_w_in[j], dsa_w_out[j], dsa_q_gain[j], dsa_k_gain[j], dsa_idx_k_gain[j], rel_bias)
        else:
            x = x + hgrn2_mixer(hm, hgrn_w_in[j], hgrn_w_out[j], lower_bounds[layer], hgrn_o_gain[j])
        x = x + 0.5 * swiglu(rmsnorm(x, norm_gains[layer, 2]), ffn_w_gate[layer, 1], ffn_w_up[layer, 1], ffn_w_down[layer, 1])
    return x
```

```cpp
#include <hip/hip_runtime.h>
#include <cstdio>
#include <cstdint>

#ifndef GU8_MASK
#define GU8_MASK 0xFC
#endif
#ifndef DN8_MASK
#define DN8_MASK 0xFE
#endif
#ifndef GUI8_MASK
#define GUI8_MASK 0xFF
#endif
#ifndef MIX8_MASK
#define MIX8_MASK 0xE
#endif
#ifndef MK_ONE_LAUNCH
#define MK_ONE_LAUNCH 1
#endif

namespace pg8 {
#define PG8_LAS __attribute__((address_space(3)))
typedef unsigned short bf16_t;
typedef short bf16x8 __attribute__((ext_vector_type(8)));
typedef float f32x4 __attribute__((ext_vector_type(4)));
typedef unsigned u32x4 __attribute__((ext_vector_type(4)));
constexpr int BM = 256, BK = 64, HALF = 128, HTB = HALF * BK * 2, STAGE_BYTES = 8 * HTB, NXCD = 8, WGM = 8;

__host__ __device__ __forceinline__ int lds_byte(int r, int c) { const int st = (r >> 4) * 2 + (c >> 5), rr = r & 15, cc = c & 31, ob = rr * 64 + cc * 2; return st * 1024 + (ob ^ (((ob >> 9) & 1) << 5)); }
__host__ __device__ __forceinline__ void stage_rc(int b, int& R, int& C) { const int st = b / 1024, sb = b % 1024, swz = sb ^ (((sb >> 9) & 1) << 5); R = (st >> 1) * 16 + swz / 64; C = (st & 1) * 32 + (swz % 64) / 2; }
__host__ __device__ __forceinline__ int perm32(int rho) { const int n = rho >> 4, i = rho & 15; return 8 * (i >> 2) + 4 * n + (i & 3); }

struct Unit { int pm, pn; };
struct Gemm { const void* A; const void* Bt; int M, N, KB; int ntk = 0; };

struct StaticOrder {
    int nM, nN, nwg, G, c;
    __host__ __device__ __forceinline__ void init(int M, int N, int G_, int c_) { nM = M / BM; nN = N / BM; nwg = nM * nN; G = G_; c = c_; }
    __host__ __device__ __forceinline__ bool next(int i, Unit& u) const {
        const long L = (long)i * G + c; if (L >= nwg) return false;
        int wgid = (int)L; { const int q = nwg / NXCD, r = nwg % NXCD, xcd = wgid % NXCD, off = wgid / NXCD; wgid = (xcd < r ? xcd * (q + 1) : r * (q + 1) + (xcd - r) * q) + off; }
        const int nig = WGM * nN, gid = wgid / nig, fm = gid * WGM, gsz = (nM - fm) < WGM ? (nM - fm) : WGM;
        u.pm = fm + ((wgid % nig) % gsz); u.pn = (wgid % nig) / gsz; return true;
    }
    __device__ __forceinline__ void a_ready(const Unit&) const {}
    __device__ __forceinline__ void done(const Unit&) const {}
};
struct SingleOrder {
    Unit u0;
    __device__ __forceinline__ bool next(int i, Unit& u) const { if (i != 0) return false; u = u0; return true; }
    __device__ __forceinline__ void a_ready(const Unit&) const {}
    __device__ __forceinline__ void done(const Unit&) const {}
};

typedef int i32x8 __attribute__((ext_vector_type(8)));
typedef int i32x4v __attribute__((ext_vector_type(4)));
__device__ __forceinline__ i32x8 cat8(bf16x8 lo, bf16x8 hi) { const i32x4v a = __builtin_bit_cast(i32x4v, lo), b = __builtin_bit_cast(i32x4v, hi); return (i32x8){a[0], a[1], a[2], a[3], b[0], b[1], b[2], b[3]}; }
template <class Epi, int FP8> struct FP8SC { static constexpr int A = 0, B = 0; };
template <class Epi> struct FP8SC<Epi, 1> { static constexpr int A = Epi::SCALE_A, B = Epi::SCALE_B; };
template <class Epi, class Sched, bool ALIGN_EPI = false, bool SP2 = false, int FP8 = 0, bool TA = false, bool TB = true>
__device__ __forceinline__ void gemm_phase(PG8_LAS unsigned char* lds, const Gemm g, const Sched& S, const Epi& E, const int tid) {
    const int wid = __builtin_amdgcn_readfirstlane(tid >> 6), lane = tid & 63, wr = wid >> 2, wc = wid & 3, fr = lane & 15, fq = lane >> 4;
    const int K = g.KB, nt = g.ntk ? g.ntk : K / 128;
    unsigned voffA[2], voffB[2];
#pragma unroll
    for (int i = 0; i < 2; ++i) { int R, C; stage_rc(tid * 16 + i * 8192, R, C); const int Rb = Epi::PERM ? ((R & ~31) + perm32(R & 31)) : R;
        voffA[i] = TA ? (unsigned)(R * 128 + C * 2) : (unsigned)(R * K + C * 2); voffB[i] = TB ? (unsigned)(Rb * 128 + C * 2) : (unsigned)(Rb * K + C * 2); }
    const size_t kstepA = TA ? 32768 : 128, kstepB = TB ? 32768 : 128;
    const size_t hstepA = TA ? 16384 : (size_t)HALF * K, hstepB = TB ? 16384 : (size_t)HALF * K;
    const size_t tstepA = TA ? (size_t)32768 * nt : (size_t)256 * K, tstepB = TB ? (size_t)32768 * nt : (size_t)256 * K;
    const unsigned ldsw = (unsigned)wid * 1024u;
    const int aoff = lds_byte(wr * 64 + fr, fq * 8), boff = lds_byte(wc * 32 + fr, fq * 8);
#define PG8_SA(b, h) (((b) * 2 + (h)) * HTB)
#define PG8_SB(b, h) ((4 + (b) * 2 + (h)) * HTB)
#define PG8_STAGE(bufoff, gbase, voff) do { _Pragma("unroll") for (int _i = 0; _i < 2; ++_i) \
        __builtin_amdgcn_global_load_lds((const unsigned*)((const char*)(gbase) + (voff)[_i]), (PG8_LAS unsigned*)(lds + (bufoff) + ldsw + _i * 8192), 16, 0, 0); } while (0)
#define PG8_LD8(p) __builtin_shufflevector(*(const PG8_LAS i32x4v*)(p), *(const PG8_LAS i32x4v*)((p) + 1024), 0, 1, 2, 3, 4, 5, 6, 7)
#define PG8_LDA(dst, b, h) do { _Pragma("unroll") for (int m = 0; m < 4; ++m) { if constexpr (FP8 == 1) dst##8[m] = PG8_LD8(lds + PG8_SA(b, h) + aoff + m * 2048); else { _Pragma("unroll") for (int k = 0; k < 2; ++k) dst[m][k] = *(const PG8_LAS bf16x8*)(lds + PG8_SA(b, h) + aoff + m * 2048 + k * 1024); } } } while (0)
#define PG8_LDB(dst, b, h) do { _Pragma("unroll") for (int n = 0; n < 2; ++n) { if constexpr (FP8 == 1) dst##8[n] = PG8_LD8(lds + PG8_SB(b, h) + boff + n * 2048); else { _Pragma("unroll") for (int k = 0; k < 2; ++k) dst[n][k] = *(const PG8_LAS bf16x8*)(lds + PG8_SB(b, h) + boff + n * 2048 + k * 1024); } } } while (0)
#define PG8_MMA(ai, bj, At, Bt) do { __builtin_amdgcn_s_setprio(1); _Pragma("unroll") for (int m = 0; m < 4; ++m) _Pragma("unroll") for (int n = 0; n < 2; ++n) { \
        if constexpr (FP8 == 1) asm volatile("v_mfma_scale_f32_16x16x128_f8f6f4 %0, %1, %2, %0, %3, %4 op_sel_hi:[0,0,0]" : "+v"(acc[ai][bj][m][n]) : "v"(Bt##8[n]), "v"(At##8[m]), "v"(sc_b), "v"(sc_a)); \
        else if constexpr (FP8 == 2) { _Pragma("unroll") for (int k = 0; k < 2; ++k) asm volatile("v_mfma_i32_16x16x64_i8 %0, %1, %2, %0" : "+v"(acc[ai][bj][m][n]) : "v"(Bt[n][k]), "v"(At[m][k])); } \
        else { _Pragma("unroll") for (int k = 0; k < 2; ++k) acc[ai][bj][m][n] = __builtin_amdgcn_mfma_f32_16x16x32_bf16(Bt[n][k], At[m][k], acc[ai][bj][m][n], 0, 0, 0); } } __builtin_amdgcn_s_setprio(0); } while (0)
#define PG8_WAIT_V(n) asm volatile("s_waitcnt vmcnt(" #n ")" ::: "memory")
#define PG8_WAIT_L(n) asm volatile("s_waitcnt lgkmcnt(" #n ")" ::: "memory")
#define PG8_BAR __builtin_amdgcn_s_barrier()
#define PG8_SCHED __builtin_amdgcn_sched_barrier(0)
    Unit cur, nxt; int ui = 0;
    if (!S.next(0, cur)) return;
    f32x4 acc[2][2][4][2];
#pragma unroll
    for (int a = 0; a < 2; ++a)
#pragma unroll
        for (int b = 0; b < 2; ++b)
#pragma unroll
            for (int m = 0; m < 4; ++m)
#pragma unroll
                for (int n = 0; n < 2; ++n) acc[a][b][m][n] = (f32x4){0.f, 0.f, 0.f, 0.f};
    const int sc_a = Epi::PERM ? FP8SC<Epi, FP8>::A : FP8SC<Epi, FP8>::A, sc_b = FP8SC<Epi, FP8>::B;
    bf16x8 At[4][2], B0[2][2], B1[2][2]; i32x8 At8[4], B08[2], B18[2];
    const char* cA = (const char*)g.A + (size_t)cur.pm * tstepA; const char* cB = (const char*)g.Bt + (size_t)cur.pn * tstepB;
    S.a_ready(cur);
    if constexpr (SP2) {
        PG8_STAGE(PG8_SB(0, 0), cB, voffB); PG8_STAGE(PG8_SB(0, 1), cB + hstepB, voffB); PG8_STAGE(PG8_SA(0, 0), cA, voffA); PG8_STAGE(PG8_SA(0, 1), cA + hstepA, voffA);
        if (wr == 1) PG8_BAR;
        PG8_WAIT_V(2); PG8_BAR;
        PG8_STAGE(PG8_SB(1, 0), cB + kstepB, voffB); PG8_STAGE(PG8_SA(1, 0), cA + kstepA, voffA); PG8_STAGE(PG8_SB(1, 1), cB + hstepB + kstepB, voffB);
        PG8_WAIT_V(6); PG8_BAR;
    } else {
        PG8_STAGE(PG8_SB(0, 0), cB, voffB); PG8_STAGE(PG8_SA(0, 0), cA, voffA); PG8_STAGE(PG8_SB(0, 1), cB + hstepB, voffB); PG8_STAGE(PG8_SA(0, 1), cA + hstepA, voffA);
        if (wr == 1) PG8_BAR;
        PG8_WAIT_V(4); PG8_BAR;
        PG8_STAGE(PG8_SB(1, 0), cB + kstepB, voffB); PG8_STAGE(PG8_SA(1, 0), cA + kstepA, voffA); PG8_STAGE(PG8_SB(1, 1), cB + hstepB + kstepB, voffB);
        PG8_WAIT_V(6); PG8_BAR;
    }
    for (;;) {
        const bool has_next = S.next(ui + 1, nxt);
        const char* nA = has_next ? (const char*)g.A + (size_t)nxt.pm * tstepA : cA; const char* nB = has_next ? (const char*)g.Bt + (size_t)nxt.pn * tstepB : cB;
        for (int t = 0; t < nt; t += 2) {
            const bool last = (t == nt - 2);
            const char* a1 = cA + (size_t)(t + 1) * kstepA;
            const char* a2 = last ? nA : cA + (size_t)(t + 2) * kstepA; const char* b2 = last ? nB : cB + (size_t)(t + 2) * kstepB;
            const char* a3 = a2 + kstepA; const char* b3 = b2 + kstepB;
            if (last && has_next) S.a_ready(nxt);
            if constexpr (SP2) {
            PG8_LDB(B0, 0, 0); PG8_LDB(B1, 0, 1); PG8_SCHED; PG8_LDA(At, 0, 0); PG8_STAGE(PG8_SA(1, 1), a1 + hstepA, voffA);
            PG8_WAIT_V(8); PG8_WAIT_L(0); PG8_BAR; PG8_MMA(0, 0, At, B0); PG8_MMA(0, 1, At, B1); PG8_BAR; PG8_SCHED;
            PG8_LDA(At, 0, 1); PG8_STAGE(PG8_SB(0, 0), b2, voffB); PG8_STAGE(PG8_SB(0, 1), b2 + hstepB, voffB); PG8_STAGE(PG8_SA(0, 0), a2, voffA);
            PG8_WAIT_V(8); PG8_WAIT_L(0); PG8_BAR; PG8_MMA(1, 0, At, B0); PG8_MMA(1, 1, At, B1); PG8_BAR; PG8_SCHED;
            PG8_LDB(B0, 1, 0); PG8_LDB(B1, 1, 1); PG8_SCHED; PG8_LDA(At, 1, 0); PG8_STAGE(PG8_SA(0, 1), a2 + hstepA, voffA);
            PG8_WAIT_V(8); PG8_WAIT_L(0); PG8_BAR; PG8_MMA(0, 0, At, B0); PG8_MMA(0, 1, At, B1); PG8_BAR; PG8_SCHED;
            PG8_LDA(At, 1, 1); PG8_STAGE(PG8_SB(1, 0), b3, voffB); PG8_STAGE(PG8_SB(1, 1), b3 + hstepB, voffB); PG8_STAGE(PG8_SA(1, 0), a3, voffA);
            PG8_WAIT_V(8); PG8_WAIT_L(0); PG8_BAR; PG8_MMA(1, 0, At, B0); PG8_MMA(1, 1, At, B1); PG8_BAR; PG8_SCHED;
            } else {
            PG8_LDB(B0, 0, 0); PG8_SCHED; PG8_LDA(At, 0, 0); PG8_STAGE(PG8_SA(1, 1), a1 + hstepA, voffA);
            PG8_WAIT_L(8); PG8_BAR; PG8_WAIT_L(0); PG8_MMA(0, 0, At, B0); PG8_BAR; PG8_SCHED;
            PG8_LDB(B1, 0, 1); PG8_STAGE(PG8_SB(0, 0), b2, voffB);
            PG8_BAR; PG8_WAIT_L(0); PG8_MMA(0, 1, At, B1); PG8_BAR;
            PG8_LDA(At, 0, 1); PG8_STAGE(PG8_SA(0, 0), a2, voffA);
            PG8_BAR; PG8_WAIT_L(0); PG8_MMA(1, 0, At, B0); PG8_BAR; PG8_SCHED;
            PG8_STAGE(PG8_SB(0, 1), b2 + hstepB, voffB);
            PG8_WAIT_V(6); PG8_BAR; PG8_MMA(1, 1, At, B1); PG8_BAR;
            PG8_LDB(B0, 1, 0); PG8_SCHED; PG8_LDA(At, 1, 0); PG8_STAGE(PG8_SA(0, 1), a2 + hstepA, voffA);
            PG8_WAIT_L(8); PG8_BAR; PG8_WAIT_L(0); PG8_MMA(0, 0, At, B0); PG8_BAR; PG8_SCHED;
            PG8_LDB(B1, 1, 1); PG8_STAGE(PG8_SB(1, 0), b3, voffB);
            PG8_BAR; PG8_WAIT_L(0); PG8_MMA(0, 1, At, B1); PG8_BAR;
            PG8_LDA(At, 1, 1); PG8_STAGE(PG8_SA(1, 0), a3, voffA);
            PG8_BAR; PG8_WAIT_L(0); PG8_MMA(1, 0, At, B0); PG8_BAR; PG8_SCHED;
            PG8_STAGE(PG8_SB(1, 1), b3 + hstepB, voffB);
            PG8_WAIT_V(6); PG8_BAR; PG8_MMA(1, 1, At, B1); PG8_BAR;
            }
        }
        if constexpr (ALIGN_EPI) { if (wr == 0) PG8_BAR; }
        E(acc, cur, wr, wc, fr, fq);
        if (!has_next) break;
#pragma unroll
        for (int a = 0; a < 2; ++a)
#pragma unroll
            for (int b = 0; b < 2; ++b)
#pragma unroll
                for (int m = 0; m < 4; ++m)
#pragma unroll
                    for (int n = 0; n < 2; ++n) acc[a][b][m][n] = (f32x4){0.f, 0.f, 0.f, 0.f};
        cur = nxt; cA = nA; cB = nB; ++ui;
        if constexpr (ALIGN_EPI) { if (wr == 1) PG8_BAR; }
    }
    PG8_WAIT_V(0);
    if constexpr (!ALIGN_EPI) { if (wr == 0) PG8_BAR; }
    PG8_BAR;
#undef PG8_SA
#undef PG8_SB
#undef PG8_STAGE
#undef PG8_LDA
#undef PG8_LD8
#undef PG8_LDB
#undef PG8_MMA
#undef PG8_WAIT_V
#undef PG8_WAIT_L
#undef PG8_BAR
#undef PG8_SCHED
}
}

constexpr int S_ = 8192, D_ = 2048, FF_ = 5632, DEPTH_ = 4;
constexpr int A_IN = 4176, A_IN_PAD = 4352;
constexpr int PROJ_LD = 4096;
constexpr int EX_LD = 128;
constexpr int TOPK = 256;
constexpr float EPS_ = 1e-6f;
constexpr int NWAVES = 8, NTHREADS = 512;

typedef unsigned short bf16;
typedef short bf16x8 __attribute__((ext_vector_type(8)));
typedef short s16x4 __attribute__((ext_vector_type(4)));
typedef float f32x4 __attribute__((ext_vector_type(4)));
typedef float f32x2 __attribute__((ext_vector_type(2)));
typedef float f32x16 __attribute__((ext_vector_type(16)));
typedef unsigned u32x4 __attribute__((ext_vector_type(4)));
typedef unsigned u32x2 __attribute__((ext_vector_type(2)));
typedef int i32x4 __attribute__((ext_vector_type(4)));
typedef __bf16 bf2_t __attribute__((ext_vector_type(2)));
#define LAS __attribute__((address_space(3)))
#define GAS __attribute__((address_space(1)))
#define DI __device__ __forceinline__

DI unsigned pk2(float lo, float hi) { f32x2 v = {lo, hi}; bf2_t r = __builtin_convertvector(v, bf2_t); return __builtin_bit_cast(unsigned, r); }
DI float bf_lo(unsigned w) { return __uint_as_float(w << 16); }
DI float bf_hi(unsigned w) { return __uint_as_float(w & 0xffff0000u); }
typedef _Float16 h2_t __attribute__((ext_vector_type(2)));
DI unsigned pkh2(float a, float b) { const h2_t h = {(_Float16)a, (_Float16)b}; return __builtin_bit_cast(unsigned, h); }
DI float h_lo(unsigned w) { return (float)__builtin_bit_cast(h2_t, w)[0]; }
DI float h_hi(unsigned w) { return (float)__builtin_bit_cast(h2_t, w)[1]; }
DI bf16x8 pack8(const float* v) { u32x4 w; w.x = pk2(v[0], v[1]); w.y = pk2(v[2], v[3]); w.z = pk2(v[4], v[5]); w.w = pk2(v[6], v[7]); return __builtin_bit_cast(bf16x8, w); }
DI void unpack8(u32x4 w, float* v) { v[0] = bf_lo(w.x); v[1] = bf_hi(w.x); v[2] = bf_lo(w.y); v[3] = bf_hi(w.y); v[4] = bf_lo(w.z); v[5] = bf_hi(w.z); v[6] = bf_lo(w.w); v[7] = bf_hi(w.w); }
DI float silu_f(float g) { return g * __builtin_amdgcn_rcpf(1.0f + __expf(-g)); }
DI float sigmoid_f(float g) { return __builtin_amdgcn_rcpf(1.0f + __expf(-g)); }
#define LDS_WAIT() asm volatile("s_waitcnt lgkmcnt(0)" ::: "memory")
#define MFMA32(a, b, c) __builtin_amdgcn_mfma_f32_32x32x16_bf16((a), (b), (c), 0, 0, 0)
#define MFMA16(a, b, c) __builtin_amdgcn_mfma_f32_16x16x32_bf16((a), (b), (c), 0, 0, 0)

constexpr size_t MiB = 1u << 20;
constexpr size_t WS_CTL = 0, CTL_ZERO_BYTES = 1 * MiB;
constexpr size_t WS_LB = 1 * MiB;
constexpr size_t WS_SSQ = 2 * MiB;
constexpr size_t WS_XB = 3 * MiB;
constexpr size_t WS_AO = 35 * MiB;
constexpr size_t WS_W = 67 * MiB;
constexpr size_t SZ_WGU = 44 * MiB, SZ_WD = 22 * MiB, SZ_DWIN = 17 * MiB, SZ_WO = 8 * MiB, SZ_HWIN = 32 * MiB;
constexpr size_t WS_WGU = WS_W;
constexpr size_t WS_WD = WS_WGU + 8 * SZ_WGU;
constexpr size_t WS_DWIN = WS_WD + 8 * SZ_WD;
constexpr size_t WS_DWO = WS_DWIN + 2 * SZ_DWIN;
constexpr size_t WS_HWIN = WS_DWO + 2 * SZ_WO;
constexpr size_t WS_HWO = WS_HWIN + 2 * SZ_HWIN;
constexpr size_t WS_R = WS_HWO + 2 * SZ_WO;
constexpr size_t R_H = 0;
constexpr size_t R_PROJ = 0;
constexpr size_t R_EX = 112 * MiB;
constexpr size_t R_IKN = 72 * MiB;
constexpr size_t R_IWS = 73 * MiB;
constexpr size_t R_SEL = 74 * MiB;
constexpr size_t R_Q8 = 82 * MiB;
constexpr size_t R_K8 = 98 * MiB;
constexpr size_t R_V8 = 102 * MiB;
constexpr size_t R_Q = 0;
constexpr size_t R_F = 32 * MiB;
constexpr size_t R_G = 96 * MiB;
constexpr size_t R_VT = 128 * MiB;
constexpr size_t R_BC = 160 * MiB;
constexpr size_t R_ST = 224 * MiB;
constexpr size_t R_EBL = 352 * MiB;
constexpr size_t WS_X8 = WS_R + 353 * MiB;
constexpr size_t WS_SSQ1 = WS_X8 + 16 * MiB;
constexpr size_t WS_XS = WS_SSQ1 + 1 * MiB;
constexpr size_t WS_END = WS_XS + 1 * MiB;

constexpr int CW_BAR = 4096;
constexpr int CW_WQ = 8192;

constexpr int RING_BYTES = 131072;
constexpr int LDS_AUX = RING_BYTES;
constexpr int LDS_TAB = 161792;
constexpr int LDS_MISC = 162816;
constexpr int LDS_BYTES = 163840;

#define XB_TMO      128
#define XB_XCNT(j)  (256  + 64 * (j))
#define XB_XSUB(j)  (1280 + 64 * (j))
#define XB_XGEN(j)  (2304 + 64 * (j))
#define XB_TOP      3328
#define XB_TOPGEN   3392
#define XCD_BAR_WORDS 3456
#define XB_SPIN_CAP (1u << 18)

__device__ __forceinline__ unsigned xb_ld(unsigned* p)              { return __hip_atomic_load(p, __ATOMIC_RELAXED, __HIP_MEMORY_SCOPE_AGENT); }
__device__ __forceinline__ unsigned xb_add(unsigned* p, unsigned v) { return __hip_atomic_fetch_add(p, v, __ATOMIC_RELAXED, __HIP_MEMORY_SCOPE_AGENT); }
__device__ __forceinline__ unsigned xb_xcc_id() { return (unsigned)__builtin_amdgcn_s_getreg((3 << 11) | 20) & 0xFu; }
#define XB_SPIN(cond, bar) do { unsigned _sp = 0; while (cond) { __builtin_amdgcn_s_sleep(1); \
    if ((++_sp & 255u) == 0u) { if (xb_ld(&(bar)[XB_TMO])) break; if (_sp > XB_SPIN_CAP) { atomicAdd(&(bar)[XB_TMO], 1u); break; } } } } while (0)

struct XcdBarrier {
    unsigned* bar; unsigned x;
    volatile LAS unsigned* st;
};
__device__ __forceinline__ XcdBarrier xcd_barrier_post(unsigned* bar, volatile LAS unsigned* st) {
    XcdBarrier b; b.bar = bar; b.x = xb_xcc_id(); b.st = st;
    if (threadIdx.x == 0) (void)xb_add(&bar[XB_XCNT(b.x)], 1u);
    return b;
}
__device__ __forceinline__ void xcd_barrier_complete(unsigned* bar, unsigned x, unsigned& nloc, unsigned& nx) {
    const unsigned G = gridDim.x * gridDim.y * gridDim.z;
    unsigned sum, cnt, mine, sp = 0u;
    for (;;) {
        sum = 0u; cnt = 0u; mine = 0u;
#pragma unroll
        for (unsigned j = 0; j < 16; ++j) { const unsigned c = xb_ld(&bar[XB_XCNT(j)]); sum += c; cnt += (c > 0u) ? 1u : 0u; mine = (j == x) ? c : mine; }
        if (sum == G) break;
        __builtin_amdgcn_s_sleep(1);
        if ((++sp & 255u) == 0u) { if (xb_ld(&bar[XB_TMO])) break; if (sp > XB_SPIN_CAP) { atomicAdd(&bar[XB_TMO], 1u); break; } }
    }
    nloc = mine > 0u ? mine : 1u; nx = cnt > 0u ? cnt : 1u;
}
__device__ __forceinline__ void xcd_barrier(const XcdBarrier& b) {
    asm volatile("s_waitcnt vmcnt(0)" ::: "memory");
    __syncthreads();
    if (threadIdx.x == 0) {
        unsigned* bar = b.bar;
        __builtin_amdgcn_s_waitcnt(0);
        unsigned nloc = b.st[0], nx = b.st[1];
        if (nloc == 0u) { xcd_barrier_complete(bar, b.x, nloc, nx); b.st[0] = nloc; b.st[1] = nx; }
        const unsigned old = xb_add(&bar[XB_XSUB(b.x)], 1u);
        const unsigned gen = old / nloc;
        if (old + 1u == (gen + 1u) * nloc) {
            __builtin_amdgcn_fence(__ATOMIC_RELEASE, "agent");
            asm volatile("s_waitcnt vmcnt(0)" ::: "memory");
            const unsigned og = xb_add(&bar[XB_TOP], 1u);
            const unsigned tg = og / nx;
            if (og + 1u == (tg + 1u) * nx) xb_add(&bar[XB_TOPGEN], 1u);
            else XB_SPIN(xb_ld(&bar[XB_TOPGEN]) == tg, bar);
            __builtin_amdgcn_fence(__ATOMIC_ACQUIRE, "agent");
            xb_add(&bar[XB_XGEN(b.x)], 1u);
            asm volatile("s_waitcnt vmcnt(0)" ::: "memory");
        } else {
            XB_SPIN(xb_ld(&bar[XB_XGEN(b.x)]) == gen, bar);
            __builtin_amdgcn_fence(__ATOMIC_ACQUIRE, "agent");
            asm volatile("s_waitcnt vmcnt(0)" ::: "memory");
        }
    }
    __syncthreads();
}

DI size_t tiled_off(int r, int kb, int KB) { return (size_t)(r >> 8) * ((size_t)KB * 256) + (size_t)(kb >> 7) * 32768 + (size_t)(r & 255) * 128 + (kb & 127); }
DI float load_rstd1(const float* ssq, int row, int fq) {
    const f32x4* p = (const f32x4*)(ssq + (size_t)row * 32 + 8 * fq);
    const f32x4 a = p[0], b = p[1];
    float s = ((a[0] + a[1]) + (a[2] + a[3])) + ((b[0] + b[1]) + (b[2] + b[3]));
    s += __shfl_xor(s, 16); s += __shfl_xor(s, 32);
    return __builtin_amdgcn_rsqf(s * (1.0f / D_) + EPS_);
}
#define EPI_FENCE() asm volatile("" ::: "memory")
constexpr float WI8_SCALE = 1250.0f;
template <int NB = 1> DI void row_factors8(const float* ssq, const float* XS, const bool i8, const int row0, const int fq, float (&rq)[8]) {
    __builtin_amdgcn_s_waitcnt(0);
    constexpr int GB = 8 / NB;
#pragma unroll
    for (int b0 = 0; b0 < 8; b0 += GB) {
        f32x4 pa[GB], pb[GB]; float xv[GB], sp[GB], t[GB];
#pragma unroll
        for (int gi = 0; gi < GB; ++gi) { const int row = row0 + ((b0 + gi) >> 2) * 128 + ((b0 + gi) & 3) * 16; const f32x4* p = (const f32x4*)(ssq + (size_t)row * 32 + 8 * fq); pa[gi] = p[0]; pb[gi] = p[1]; xv[gi] = XS[row]; }
        EPI_FENCE();
#pragma unroll
        for (int gi = 0; gi < GB; ++gi) sp[gi] = ((pa[gi][0] + pa[gi][1]) + (pa[gi][2] + pa[gi][3])) + ((pb[gi][0] + pb[gi][1]) + (pb[gi][2] + pb[gi][3]));
#pragma unroll
        for (int gi = 0; gi < GB; ++gi) t[gi] = __shfl_xor(sp[gi], 16);
#pragma unroll
        for (int gi = 0; gi < GB; ++gi) sp[gi] += t[gi];
#pragma unroll
        for (int gi = 0; gi < GB; ++gi) t[gi] = __shfl_xor(sp[gi], 32);
#pragma unroll
        for (int gi = 0; gi < GB; ++gi) { const float r = __builtin_amdgcn_rsqf((sp[gi] + t[gi]) * (1.0f / D_) + EPS_); rq[b0 + gi] = i8 ? r * __builtin_amdgcn_rcpf(xv[gi] * WI8_SCALE) : r; }
        EPI_FENCE();
    }
}

DI float sat8(float v) { return __builtin_amdgcn_fmed3f(v, -448.0f, 448.0f); }
DI unsigned pk4_fp8s(float a, float b, float c, float d) { int w = 0; w = __builtin_amdgcn_cvt_pk_fp8_f32(sat8(a), sat8(b), w, false); w = __builtin_amdgcn_cvt_pk_fp8_f32(sat8(c), sat8(d), w, true); return (unsigned)w; }
DI unsigned pk4_i8(float a, float b, float c, float d) {
    const unsigned ua = __float_as_uint(__builtin_amdgcn_fmed3f(a, -127.f, 127.f) + 12582912.0f), ub = __float_as_uint(__builtin_amdgcn_fmed3f(b, -127.f, 127.f) + 12582912.0f);
    const unsigned uc = __float_as_uint(__builtin_amdgcn_fmed3f(c, -127.f, 127.f) + 12582912.0f), ud = __float_as_uint(__builtin_amdgcn_fmed3f(d, -127.f, 127.f) + 12582912.0f);
    return __builtin_amdgcn_perm(ub, ua, 0x0c0c0400u) | __builtin_amdgcn_perm(ud, uc, 0x04000c0cu); }
constexpr int SC_ONE = 0x7f7f7f7f;
constexpr int SC_W64 = 0x79797979;
constexpr int SC_H8 = 0x7c7c7c7c;

template <int IN8, bool OUT8> struct EpiSwiglu {
    static constexpr bool PERM = true; static constexpr int SCALE_A = SC_ONE, SCALE_B = SC_W64;
    unsigned char* H; const float* ssq; const float* XS;
    DI void operator()(const f32x4 (&acc)[2][2][4][2], const pg8::Unit& u, int wr, int wc, int fr_in, int fq_in) const {
        int fr = fr_in, fq = fq_in; asm volatile("" : "+v"(fr), "+v"(fq));
        const int row0 = u.pm * 256 + wr * 64 + fr;
        const int col0 = u.pn * 128 + wc * 32 + 8 * fq;
        float rqa[8];
        row_factors8(ssq, XS, IN8 == 2, row0, fq, rqa);
#pragma unroll
        for (int ai = 0; ai < 2; ++ai)
#pragma unroll
            for (int m = 0; m < 4; ++m) {
                const int row = row0 + ai * 128 + m * 16;
                const float rq = rqa[ai * 4 + m];
                const float rq_e = rq * -1.4426950408889634f, rq_h = rq * rq * (OUT8 ? 8.0f : 1.0f);
                float h[8];
#pragma unroll
                for (int n = 0; n < 2; ++n)
#pragma unroll
                    for (int e = 0; e < 4; ++e) {
                        const float ag = (IN8 == 2) ? (float)__float_as_int(acc[ai][0][m][n][e]) : acc[ai][0][m][n][e];
                        const float au = (IN8 == 2) ? (float)__float_as_int(acc[ai][1][m][n][e]) : acc[ai][1][m][n][e];
                        const float sg = __builtin_amdgcn_rcpf(1.0f + __builtin_amdgcn_exp2f(ag * rq_e));
                        h[4 * n + e] = (ag * au) * rq_h * sg; }
                if constexpr (OUT8) { u32x2 w; w.x = pk4_fp8s(h[0], h[1], h[2], h[3]); w.y = pk4_fp8s(h[4], h[5], h[6], h[7]); *(u32x2*)(H + tiled_off(row, col0, FF_)) = w; }
                else *(bf16x8*)(H + tiled_off(row, 2 * col0, 2 * FF_)) = pack8(h);
                EPI_FENCE();
            }
    }
};

constexpr float XI8_CLIP = 5.0f;
template <bool F8> struct EpiResid {
    static constexpr bool PERM = true; static constexpr int SCALE_A = SC_H8, SCALE_B = SC_W64;
    const float* base32; float* out32; bf16* XB; unsigned char* X8; const float* ssq_old; float* ssq; float* XS; float coef; int x8i; bool first, last;
    DI void operator()(const f32x4 (&acc)[2][2][4][2], const pg8::Unit& u, int wr, int wc, int fr_in, int fq_in) const {
        int fr = fr_in, fq = fq_in; asm volatile("" : "+v"(fr), "+v"(fq));
        const int row0 = u.pm * 256 + wr * 64 + fr, col0 = u.pn * 256 + wc * 32 + 8 * fq;
        float xsa[8];
        if (x8i == 1) {
            row_factors8<2>(ssq_old, ssq_old, false, row0, fq, xsa);
#pragma unroll
            for (int gi = 0; gi < 8; ++gi) { xsa[gi] *= (127.0f / XI8_CLIP); if (u.pn == 0 && wc == 0 && fq == 0) XS[row0 + (gi >> 2) * 128 + (gi & 3) * 16] = xsa[gi]; }
        } else {
            __builtin_amdgcn_s_waitcnt(0);
#pragma unroll
            for (int gi = 0; gi < 8; ++gi) xsa[gi] = 0.f;
        }
        f32x4 bq[2][2]; u32x4 bw[2];
#define RES_LOADB(gi_) do { const int row_ = row0 + ((gi_) >> 2) * 128 + ((gi_) & 3) * 16; \
            if (first) { _Pragma("unroll") for (int bj = 0; bj < 2; ++bj) _Pragma("unroll") for (int n = 0; n < 2; ++n) bq[bj][n] = *(const f32x4*)(base32 + (size_t)row_ * D_ + col0 + bj * 128 + n * 4); } \
            else { _Pragma("unroll") for (int bj = 0; bj < 2; ++bj) bw[bj] = *(const u32x4*)(XB + (size_t)row_ * D_ + col0 + bj * 128); } } while (0)
        RES_LOADB(0);
#pragma unroll
        for (int ai = 0; ai < 2; ++ai)
#pragma unroll
            for (int m = 0; m < 4; ++m) {
                const int gi = ai * 4 + m;
                const int row = row0 + ai * 128 + m * 16; float s = 0.f;
                const float xs = xsa[gi];
                f32x4 b[2][2];
#pragma unroll
                for (int bj = 0; bj < 2; ++bj) {
                    const f32x4 lo_ = {bf_lo(bw[bj].x), bf_hi(bw[bj].x), bf_lo(bw[bj].y), bf_hi(bw[bj].y)}; const f32x4 hi_ = {bf_lo(bw[bj].z), bf_hi(bw[bj].z), bf_lo(bw[bj].w), bf_hi(bw[bj].w)};
                    b[bj][0] = first ? bq[bj][0] : lo_; b[bj][1] = first ? bq[bj][1] : hi_; }
                EPI_FENCE();
                if (gi < 7) RES_LOADB(gi + 1);
                EPI_FENCE();
#pragma unroll
                for (int bj = 0; bj < 2; ++bj) {
                    const size_t off = (size_t)row * D_ + col0 + bj * 128;
                    const f32x4 v0 = b[bj][0] + coef * acc[ai][bj][m][0], v1 = b[bj][1] + coef * acc[ai][bj][m][1];
                    if (last) { *(f32x4*)(out32 + off) = v0; *(f32x4*)(out32 + off + 4) = v1; }
                    else { u32x4 w; w.x = pk2(v0[0], v0[1]); w.y = pk2(v0[2], v0[3]); w.z = pk2(v1[0], v1[1]); w.w = pk2(v1[2], v1[3]); *(u32x4*)(XB + off) = w; }
                    if (x8i != 0) { u32x2 q;
                        q.x = (x8i == 1) ? pk4_i8(v0[0] * xs, v0[1] * xs, v0[2] * xs, v0[3] * xs) : pk4_fp8s(v0[0], v0[1], v0[2], v0[3]);
                        q.y = (x8i == 1) ? pk4_i8(v1[0] * xs, v1[1] * xs, v1[2] * xs, v1[3] * xs) : pk4_fp8s(v1[0], v1[1], v1[2], v1[3]);
                        *(u32x2*)(X8 + off) = q; }
                    s += ((v0[0] * v0[0] + v0[1] * v0[1]) + (v0[2] * v0[2] + v0[3] * v0[3])) + ((v1[0] * v1[0] + v1[1] * v1[1]) + (v1[2] * v1[2] + v1[3] * v1[3]));
                }
                s += __shfl_xor(s, 16); s += __shfl_xor(s, 32);
                if (fq == 0) ssq[(size_t)row * 32 + u.pn * 4 + wc] = s;
                EPI_FENCE();
            }
#undef RES_LOADB
    }
};

DI f32x4 acc_f(const f32x4 a, const bool i8) { f32x4 o;
#pragma unroll
    for (int e = 0; e < 4; ++e) o[e] = i8 ? (float)__float_as_int(a[e]) : a[e];
    return o; }
struct EpiDsaEx {
    static constexpr bool PERM = true; static constexpr int SCALE_A = SC_ONE, SCALE_B = SC_W64;
    float* EXP; const float* ssq; const float* XS; bool i8;
    DI void operator()(const f32x4 (&acc)[2][2][4][2], const pg8::Unit& u, int wr, int wc, int fr_in, int fq_in) const {
        int fr = fr_in, fq = fq_in; asm volatile("" : "+v"(fr), "+v"(fq));
        const int row0 = u.pm * 256 + wr * 64 + fr, col0 = wc * 32 + 8 * fq;
        float rqa[8]; row_factors8<2>(ssq, XS, i8, row0, fq, rqa);
#pragma unroll
        for (int ai = 0; ai < 2; ++ai)
#pragma unroll
            for (int m = 0; m < 4; ++m) {
                const int row = row0 + ai * 128 + m * 16;
                const float r = rqa[ai * 4 + m];
                float* p = EXP + ((size_t)u.pn * S_ + row) * EX_LD + col0;
                *(f32x4*)p = acc_f(acc[ai][0][m][0], i8) * r; *(f32x4*)(p + 4) = acc_f(acc[ai][0][m][1], i8) * r;
                EPI_FENCE();
            }
    }
};
struct EpiDsaIn {
    static constexpr bool PERM = true; static constexpr int SCALE_A = SC_ONE, SCALE_B = SC_W64;
    bf16* PROJ; const float* ssq; const float* XS; bool i8;
    DI void operator()(const f32x4 (&acc)[2][2][4][2], const pg8::Unit& u, int wr, int wc, int fr_in, int fq_in) const {
        int fr = fr_in, fq = fq_in; asm volatile("" : "+v"(fr), "+v"(fq));
        const int row0 = u.pm * 256 + wr * 64 + fr;
        const int col0 = u.pn * 256 + wc * 32 + 8 * fq;
        float rqa[8]; row_factors8<2>(ssq, XS, i8, row0, fq, rqa);
#pragma unroll
        for (int ai = 0; ai < 2; ++ai)
#pragma unroll
            for (int m = 0; m < 4; ++m) {
                const int row = row0 + ai * 128 + m * 16;
                const float r = rqa[ai * 4 + m];
#pragma unroll
                for (int bj = 0; bj < 2; ++bj) {
                    const f32x4 v0 = acc_f(acc[ai][bj][m][0], i8) * r, v1 = acc_f(acc[ai][bj][m][1], i8) * r;
                    float h[8] = {v0[0], v0[1], v0[2], v0[3], v1[0], v1[1], v1[2], v1[3]};
                    *(bf16x8*)(PROJ + (size_t)row * PROJ_LD + col0 + bj * 128) = pack8(h);
                }
                EPI_FENCE();
            }
    }
};

template <int T> struct EpiHgrnIn {
    static constexpr bool PERM = true; static constexpr int SCALE_A = SC_ONE, SCALE_B = SC_W64;
    bf16* O; float* F; const float* ssq; const float* lb; const float* XS; bool i8;
    DI void operator()(const f32x4 (&acc)[2][2][4][2], const pg8::Unit& u, int wr, int wc, int fr_in, int fq_in) const {
        int fr = fr_in, fq = fq_in; asm volatile("" : "+v"(fr), "+v"(fq));
        const int row0 = u.pm * 256 + wr * 64 + fr;
        const int col0 = u.pn * 256 + wc * 32 + 8 * fq;
        float rqa[8]; row_factors8<2>(ssq, XS, i8, row0, fq, rqa);
#pragma unroll
        for (int ai = 0; ai < 2; ++ai)
#pragma unroll
            for (int m = 0; m < 4; ++m) {
                const int row = row0 + ai * 128 + m * 16;
                const float r = rqa[ai * 4 + m];
#pragma unroll
                for (int bj = 0; bj < 2; ++bj) {
                    float v[8]; const f32x4 a0 = acc_f(acc[ai][bj][m][0], i8), a1 = acc_f(acc[ai][bj][m][1], i8);
#pragma unroll
                    for (int e = 0; e < 4; ++e) { v[e] = a0[e] * r; v[4 + e] = a1[e] * r; }
                    const int col = col0 + bj * 128;
                    if constexpr (T == 1) {
                        const f32x4 l0 = *(const f32x4*)(lb + col), l1 = *(const f32x4*)(lb + col + 4);
                        float kq[8];
#pragma unroll
                        for (int e = 0; e < 4; ++e) { kq[e] = (1.0f - l0[e]) * sigmoid_f(-v[e]); kq[4 + e] = (1.0f - l1[e]) * sigmoid_f(-v[4 + e]); }
                        u32x4 w; w.x = pkh2(kq[0], kq[1]); w.y = pkh2(kq[2], kq[3]); w.z = pkh2(kq[4], kq[5]); w.w = pkh2(kq[6], kq[7]);
                        *(u32x4*)((unsigned short*)F + (size_t)row * D_ + col) = w;
                    } else {
#pragma unroll
                        for (int e = 0; e < 8; ++e) v[e] = (T == 0) ? v[e] * 0.08838834764831845f : silu_f(v[e]);
                        *(bf16x8*)(O + (size_t)row * D_ + col) = pack8(v);
                    }
                }
                EPI_FENCE();
            }
    }
};

struct EpiHgrnVT {
    static constexpr bool PERM = true; static constexpr int SCALE_A = SC_W64, SCALE_B = SC_ONE;
    bf16* VT; const LAS float* tab; bool i8;
    DI void operator()(const f32x4 (&acc)[2][2][4][2], const pg8::Unit& u, int wr, int wc, int fr_in, int fq_in) const {
        int fr = fr_in, fq = fq_in; asm volatile("" : "+v"(fr), "+v"(fq));
        const int row0 = u.pm * 256 + wr * 64 + fr, cl = wc * 32 + 8 * fq;
#pragma unroll
        for (int bj = 0; bj < 2; ++bj) {
            const f32x4 r0 = *(const LAS f32x4*)(tab + cl + bj * 128), r1 = *(const LAS f32x4*)(tab + cl + bj * 128 + 4);
#pragma unroll
            for (int ai = 0; ai < 2; ++ai)
#pragma unroll
                for (int m = 0; m < 4; ++m) {
                    float h[8];
                    const f32x4 a0 = acc_f(acc[ai][bj][m][0], i8), a1 = acc_f(acc[ai][bj][m][1], i8);
#pragma unroll
                    for (int e = 0; e < 4; ++e) { h[e] = a0[e] * r0[e]; h[4 + e] = a1[e] * r1[e]; }
                    *(bf16x8*)(VT + (size_t)(row0 + ai * 128 + m * 16) * S_ + u.pn * 256 + cl + bj * 128) = pack8(h);
                }
        }
    }
};

DI float wave_sum(float v) {
#pragma unroll
    for (int o = 1; o < 64; o <<= 1) v += __shfl_xor(v, o);
    return v;
}
template <int MAP> DI int map_row(int n) {
    if (MAP == 1) return 256 * (n >> 7) + (n & 127);
    if (MAP == 2) return 256 * (n >> 7) + (n & 127) + 128;
    if (MAP == 3) return n < 4096 ? n : (n < 6144 ? n + 2048 : n - 2048);
    return n;
}
constexpr int P0_PITCH = 66;
template <int MAP, int F8> DI void cvt_tile(const float* __restrict__ W, int ldw, int ncols, const float* __restrict__ gain, unsigned char* __restrict__ WT, int K, int n0, int k0, int lane, LAS unsigned short* scr) {
    constexpr int KT = F8 ? 128 : 64;
    const int q = lane & 15, kr = lane >> 4;
    int nc = n0 + 4 * q; nc = nc < ncols - 4 ? nc : ncols - 4;
    const float* src = W + (size_t)(k0 + kr) * ldw + nc;
    const float gs = F8 == 1 ? 64.0f : (F8 == 2 ? WI8_SCALE : 1.0f);
#pragma unroll
    for (int h = 0; h < KT / 64; ++h) {
        f32x4 v[16];
#pragma unroll
        for (int i = 0; i < 16; ++i) v[i] = __builtin_nontemporal_load((const f32x4*)(src + (size_t)(64 * h + 4 * i) * ldw));
#pragma unroll
        for (int i = 0; i < 16; ++i) {
            const int k = 64 * h + 4 * i + kr;
            const float gk = gain ? gain[k0 + k] * gs : gs;
            LAS unsigned* d = (LAS unsigned*)(scr + k * P0_PITCH + 4 * q);
            d[0] = pk2(v[i][0] * gk, v[i][1] * gk); d[1] = pk2(v[i][2] * gk, v[i][3] * gk);
        }
    }
    LDS_WAIT();
    const int nl = lane >> 3, c = lane & 7;
#pragma unroll
    for (int jj = 0; jj < 8; ++jj) {
        const int n = 8 * jj + nl;
        const int row = map_row<MAP>(n0 + n);
        if constexpr (F8) {
            const LAS unsigned short* sp = scr + (16 * c) * P0_PITCH + n;
            float f[16];
#pragma unroll
            for (int i = 0; i < 16; ++i) f[i] = __uint_as_float((unsigned)sp[i * P0_PITCH] << 16);
            u32x4 o;
            if constexpr (F8 == 2) { o.x = pk4_i8(f[0], f[1], f[2], f[3]); o.y = pk4_i8(f[4], f[5], f[6], f[7]); o.z = pk4_i8(f[8], f[9], f[10], f[11]); o.w = pk4_i8(f[12], f[13], f[14], f[15]); }
            else { o.x = pk4_fp8s(f[0], f[1], f[2], f[3]); o.y = pk4_fp8s(f[4], f[5], f[6], f[7]); o.z = pk4_fp8s(f[8], f[9], f[10], f[11]); o.w = pk4_fp8s(f[12], f[13], f[14], f[15]); }
            *(u32x4*)(WT + tiled_off(row, k0 + 16 * c, K)) = o;
        } else {
            const LAS unsigned short* sp = scr + (8 * c) * P0_PITCH + n;
            unsigned e[8];
#pragma unroll
            for (int i = 0; i < 8; ++i) e[i] = sp[i * P0_PITCH];
            u32x4 o; o.x = e[0] | (e[1] << 16); o.y = e[2] | (e[3] << 16); o.z = e[4] | (e[5] << 16); o.w = e[6] | (e[7] << 16);
            *(u32x4*)(WT + tiled_off(row, (k0 + 8 * c) * 2, K * 2)) = o;
        }
    }
    LDS_WAIT();
}

struct Args {
    const float* in[15]; float* out; unsigned char* ws; int ph_lo, ph_hi;
};

constexpr int DEF8 = 1024, DEF16 = 2048;
DI void p0_deferred_down(const Args& a, LAS unsigned char* lds, int f, int widx, int nw, int lane, int wave) {
    LAS unsigned short* scr = (LAS unsigned short*)(lds + wave * 17408);
    const bool f8 = ((DN8_MASK >> f) & 1) != 0;
    const int cnt = f8 ? 1408 : 2816, def = f8 ? DEF8 : DEF16;
    const float* W = a.in[4] + (size_t)f * FF_ * D_; unsigned char* WT = a.ws + WS_WD + (size_t)f * SZ_WD;
    for (int r = cnt - def + widx; r < cnt; r += nw) {
        const int kb = r / 32, nb = r % 32;
        if (f8) cvt_tile<0, 1>(W, D_, D_, nullptr, WT, FF_, nb * 64, kb * 128, lane, scr);
        else cvt_tile<0, 0>(W, D_, D_, nullptr, WT, FF_, nb * 64, kb * 64, lane, scr);
    }
}
DI void p0_prologue(const Args& a, LAS unsigned char* lds, int gw, int NGW, int lane, int wave) {
    unsigned char* ws = a.ws;
    const float* ng = a.in[1];
    LAS unsigned short* scr = (LAS unsigned short*)(lds + wave * 17408);
    constexpr int NT_DIN = 66 * 32, NT_O = 32 * 32, NT_HIN = 128 * 32;
    int n_ffn = 0;
#pragma unroll
    for (int m = 0; m < 24; ++m) { const bool f8m = ((((m >> 3) < 2 ? (GU8_MASK | GUI8_MASK) : DN8_MASK) >> (m & 7)) & 1) != 0; n_ffn += (f8m ? 1408 : 2816) - ((m >> 3) == 2 ? (f8m ? DEF8 : DEF16) : 0); }
    const int NITEMS = n_ffn + 2 * (NT_DIN + NT_O + NT_HIN + NT_O);
    for (int it = gw; it < NITEMS; it += NGW) {
        int r = it;
        if (r < n_ffn) {
            int m = 0; bool f8 = false;
            for (; m < 24; ++m) { f8 = ((((m >> 3) < 2 ? (GU8_MASK | GUI8_MASK) : DN8_MASK) >> (m & 7)) & 1) != 0; const int cnt = (f8 ? 1408 : 2816) - ((m >> 3) == 2 ? (f8 ? DEF8 : DEF16) : 0); if (r < cnt) break; r -= cnt; }
            const int f = m & 7, kind = m >> 3;
            if (kind < 2) {
                const int kb = r / 88, nb = r % 88;
                const float* W = a.in[2 + kind] + (size_t)f * D_ * FF_;
                const float* gain = ng + (size_t)((f >> 1) * 3 + ((f & 1) ? 2 : 0)) * D_;
                unsigned char* WT = ws + WS_WGU + (size_t)f * SZ_WGU;
                if (f8 && ((GUI8_MASK >> f) & 1)) { if (kind == 0) cvt_tile<1, 2>(W, FF_, FF_, gain, WT, D_, nb * 64, kb * 128, lane, scr); else cvt_tile<2, 2>(W, FF_, FF_, gain, WT, D_, nb * 64, kb * 128, lane, scr); }
                else if (f8) { if (kind == 0) cvt_tile<1, 1>(W, FF_, FF_, gain, WT, D_, nb * 64, kb * 128, lane, scr); else cvt_tile<2, 1>(W, FF_, FF_, gain, WT, D_, nb * 64, kb * 128, lane, scr); }
                else { if (kind == 0) cvt_tile<1, 0>(W, FF_, FF_, gain, WT, D_, nb * 64, kb * 64, lane, scr); else cvt_tile<2, 0>(W, FF_, FF_, gain, WT, D_, nb * 64, kb * 64, lane, scr); }
            } else {
                const int kb = r / 32, nb = r % 32;
                const float* W = a.in[4] + (size_t)f * FF_ * D_; unsigned char* WT = ws + WS_WD + (size_t)f * SZ_WD;
                if (f8) cvt_tile<0, 1>(W, D_, D_, nullptr, WT, FF_, nb * 64, kb * 128, lane, scr);
                else cvt_tile<0, 0>(W, D_, D_, nullptr, WT, FF_, nb * 64, kb * 64, lane, scr);
            }
            continue;
        }
        r -= n_ffn;
        if (r < 2 * NT_DIN) { const int j = r / NT_DIN; r %= NT_DIN; const int kb = r / 66, nb = r % 66;
            if ((MIX8_MASK >> (2 * j)) & 1) { if ((kb & 1) == 0) cvt_tile<0, 2>(a.in[5] + (size_t)j * D_ * A_IN, A_IN, A_IN, ng + (size_t)((2 * j) * 3 + 1) * D_, ws + WS_DWIN + (size_t)j * SZ_DWIN, D_, nb * 64, kb * 64, lane, scr); }
            else cvt_tile<0, 0>(a.in[5] + (size_t)j * D_ * A_IN, A_IN, A_IN, ng + (size_t)((2 * j) * 3 + 1) * D_, ws + WS_DWIN + (size_t)j * SZ_DWIN, D_, nb * 64, kb * 64, lane, scr);
            continue; }
        r -= 2 * NT_DIN;
        if (r < 2 * NT_O) { const int j = r / NT_O; r %= NT_O; const int kb = r / 32, nb = r % 32;
            cvt_tile<0, 0>(a.in[6] + (size_t)j * D_ * D_, D_, D_, nullptr, ws + WS_DWO + (size_t)j * SZ_WO, D_, nb * 64, kb * 64, lane, scr); continue; }
        r -= 2 * NT_O;
        if (r < 2 * NT_HIN) { const int j = r / NT_HIN; r %= NT_HIN; const int kb = r / 128, nb = r % 128;
            if ((MIX8_MASK >> (2 * j + 1)) & 1) { if ((kb & 1) == 0) cvt_tile<3, 2>(a.in[11] + (size_t)j * D_ * 4 * D_, 4 * D_, 4 * D_, ng + (size_t)((2 * j + 1) * 3 + 1) * D_, ws + WS_HWIN + (size_t)j * SZ_HWIN, D_, nb * 64, kb * 64, lane, scr); }
            else cvt_tile<3, 0>(a.in[11] + (size_t)j * D_ * 4 * D_, 4 * D_, 4 * D_, ng + (size_t)((2 * j + 1) * 3 + 1) * D_, ws + WS_HWIN + (size_t)j * SZ_HWIN, D_, nb * 64, kb * 64, lane, scr);
            continue; }
        r -= 2 * NT_HIN;
        { const int j = r / NT_O; r %= NT_O; const int kb = r / 32, nb = r % 32;
            cvt_tile<0, 0>(a.in[12] + (size_t)j * D_ * D_, D_, D_, nullptr, ws + WS_HWO + (size_t)j * SZ_WO, D_, nb * 64, kb * 64, lane, scr); }
    }
    const float* x = a.in[0]; bf16* XB = (bf16*)(ws + WS_XB); float* ssq = (float*)(ws + WS_SSQ); float* XS = (float*)(ws + WS_XS);
    for (int m = gw; m < S_; m += NGW) {
        const f32x4* xr = (const f32x4*)(x + (size_t)m * D_) + lane; float s = 0.f;
        u32x2* o8 = (u32x2*)(XB + (size_t)m * D_) + lane; unsigned* o4 = (unsigned*)(ws + WS_X8 + (size_t)m * D_) + lane;
        f32x4 v[8];
#pragma unroll
        for (int j = 0; j < 8; ++j) { v[j] = xr[64 * j]; s += (v[j][0] * v[j][0] + v[j][1] * v[j][1]) + (v[j][2] * v[j][2] + v[j][3] * v[j][3]); }
        s = wave_sum(s);
        const float xs = __builtin_amdgcn_rsqf(s * (1.0f / D_) + EPS_) * (127.0f / XI8_CLIP);
#pragma unroll
        for (int j = 0; j < 8; ++j) {
            if (((GUI8_MASK | GU8_MASK) & 1) == 0) { u32x2 w; w.x = pk2(v[j][0], v[j][1]); w.y = pk2(v[j][2], v[j][3]); o8[64 * j] = w; }
            else o4[64 * j] = (GUI8_MASK & 1) ? pk4_i8(v[j][0] * xs, v[j][1] * xs, v[j][2] * xs, v[j][3] * xs) : pk4_fp8s(v[j][0], v[j][1], v[j][2], v[j][3]); }
        if (lane < 32) ssq[(size_t)m * 32 + lane] = (lane == 0) ? s : 0.f;
        if (lane == 0) XS[m] = xs;
    }
    const float* lg = a.in[13]; float* LB = (float*)(ws + WS_LB);
    for (int c = gw * 64 + lane; c < D_; c += NGW * 64) {
        const float l0 = lg[c], l1 = lg[D_ + c], l2 = lg[2 * D_ + c], l3 = lg[3 * D_ + c];
        const float mx = fmaxf(fmaxf(l0, l1), fmaxf(l2, l3));
        const float e0 = expf(l0 - mx), e1 = expf(l1 - mx), e2 = expf(l2 - mx), e3 = expf(l3 - mx), inv = 1.0f / (e0 + e1 + e2 + e3);
        LB[c] = e1 * inv; LB[D_ + c] = (e1 + e2 + e3) * inv;
    }
}

DI unsigned pk4_fp8(float a, float b, float c, float d) { int w = 0; w = __builtin_amdgcn_cvt_pk_fp8_f32(a, b, w, false); w = __builtin_amdgcn_cvt_pk_fp8_f32(c, d, w, true); return (unsigned)w; }
DI void dsa_prep(unsigned char* ws, const float* qg, const float* kg, const float* ikg, int gw, int NGW, int lane) {
    const bf16* PROJ = (const bf16*)(ws + WS_R + R_PROJ); const float* EX = (const float*)(ws + WS_R + R_EX);
    bf16* IKN = (bf16*)(ws + WS_R + R_IKN); float* IWS = (float*)(ws + WS_R + R_IWS);
    unsigned char* Q8 = ws + WS_R + R_Q8; unsigned char* K8 = ws + WS_R + R_K8; unsigned char* V8 = ws + WS_R + R_V8;
    for (int t = gw; t < S_; t += NGW) {
        const bf16* row = PROJ + (size_t)t * PROJ_LD;
        {
            u32x4 w[4]; float v[32]; float s = 0.f;
#pragma unroll
            for (int i = 0; i < 4; ++i) { w[i] = *(const u32x4*)(row + lane * 32 + 8 * i); unpack8(w[i], v + 8 * i); }
#pragma unroll
            for (int i = 0; i < 32; ++i) s += v[i] * v[i];
            s += __shfl_xor(s, 1); s += __shfl_xor(s, 2);
            const float r = __builtin_amdgcn_rsqf(s * (1.0f / 128.0f) + EPS_);
            const int d0 = (lane & 3) * 32;
#pragma unroll
            for (int i = 0; i < 32; ++i) v[i] = v[i] * r * qg[d0 + i];
#pragma unroll
            for (int i = 0; i < 2; ++i) { u32x4 o; o.x = pk4_fp8(v[16 * i], v[16 * i + 1], v[16 * i + 2], v[16 * i + 3]); o.y = pk4_fp8(v[16 * i + 4], v[16 * i + 5], v[16 * i + 6], v[16 * i + 7]);
                o.z = pk4_fp8(v[16 * i + 8], v[16 * i + 9], v[16 * i + 10], v[16 * i + 11]); o.w = pk4_fp8(v[16 * i + 12], v[16 * i + 13], v[16 * i + 14], v[16 * i + 15]);
                *(u32x4*)(Q8 + (size_t)t * 2048 + lane * 32 + 16 * i) = o; }
        }
        {
            float v[8]; float s = 0.f; unpack8(*(const u32x4*)(row + 2048 + lane * 8), v);
#pragma unroll
            for (int i = 0; i < 8; ++i) s += v[i] * v[i];
            s += __shfl_xor(s, 1); s += __shfl_xor(s, 2); s += __shfl_xor(s, 4); s += __shfl_xor(s, 8);
            const float r = __builtin_amdgcn_rsqf(s * (1.0f / 128.0f) + EPS_);
            const int d0 = (lane & 15) * 8;
#pragma unroll
            for (int i = 0; i < 8; ++i) v[i] = v[i] * r * kg[d0 + i];
            u32x2 o; o.x = pk4_fp8(v[0], v[1], v[2], v[3]); o.y = pk4_fp8(v[4], v[5], v[6], v[7]);
            *(u32x2*)(K8 + (size_t)t * 512 + lane * 8) = o;
        }
        {
            float v[8]; unpack8(*(const u32x4*)(row + 2560 + lane * 8), v);
            u32x2 o; o.x = pk4_fp8(v[0], v[1], v[2], v[3]); o.y = pk4_fp8(v[4], v[5], v[6], v[7]);
            *(u32x2*)(V8 + (size_t)t * 512 + lane * 8) = o;
        }
        {
            float v = 0.f, wv = 0.f;
#pragma unroll
            for (int sl = 0; sl < 8; ++sl) { const float* ex = EX + ((size_t)sl * S_ + t) * EX_LD; v += ex[lane]; if (lane < 16) wv += ex[64 + lane]; }
            const float s = wave_sum(v * v);
            const float r = __builtin_amdgcn_rsqf(s * (1.0f / 64.0f) + EPS_);
            const float o = v * r * ikg[lane]; const float o2 = __shfl_xor(o, 1);
            if ((lane & 1) == 0) *(unsigned*)(IKN + (size_t)(t >> 5) * 2048 + (lane >> 4) * 512 + ((lane >> 3) & 1) * 256 + (t & 31) * 8 + (lane & 7)) = pk2(o, o2);
            if (lane < 16) IWS[(size_t)t * 16 + lane] = wv * 0.03125f;
        }
    }
}

DI unsigned okey(float f) { const unsigned u = __float_as_uint(f); return (u & 0x80000000u) ? ~u : (u | 0x80000000u); }

DI unsigned short okey16(float f) { const _Float16 h = (_Float16)f; const unsigned short u = __builtin_bit_cast(unsigned short, h); return (unsigned short)((u & 0x8000u) ? ~u : (u | 0x8000u)); }
DI void digit_search(LAS unsigned* hist, unsigned need, int lane, unsigned& dig, unsigned& nn) {
    unsigned c[4]; unsigned s4 = 0u;
#pragma unroll
    for (int i = 0; i < 4; ++i) { c[i] = hist[255 - (4 * lane + i)]; s4 += c[i]; }
    unsigned incl = s4;
#pragma unroll
    for (int d = 1; d < 64; d <<= 1) { const unsigned x = __shfl_up(incl, d); if (lane >= d) incl += x; }
    const unsigned excl = incl - s4;
    const bool hit = excl < need && need <= incl;
    unsigned run = excl, dd = 0u, n2 = 0u; bool found = false;
#pragma unroll
    for (int i = 0; i < 4; ++i) { if (!found && run + c[i] >= need) { dd = 255u - (unsigned)(4 * lane + i); n2 = need - run; found = true; } run += c[i]; }
    const unsigned long long hb = __ballot(hit);
    const int src = hb ? (__ffsll((long long)hb) - 1) : 0;
    dig = (unsigned)__builtin_amdgcn_readlane((int)dd, src); nn = (unsigned)__builtin_amdgcn_readlane((int)n2, src);
}
DI float relu_i(float x) { const int xi = __builtin_bit_cast(int, x); return __builtin_bit_cast(float, xi > 0 ? xi : 0); }
DI void dsa_select(unsigned char* ws, LAS unsigned char* lds, int tid, int lane, int wave, int bid, int G, int score_only) {
    const bf16* PROJ = (const bf16*)(ws + WS_R + R_PROJ); const bf16* IKN = (const bf16*)(ws + WS_R + R_IKN); const float* IWS = (const float*)(ws + WS_R + R_IWS);
    int* SELG = (int*)(ws + WS_R + R_SEL);
    LAS unsigned short* SC = (LAS unsigned short*)lds;
    LAS unsigned* HIST = (LAS unsigned*)(lds + LDS_AUX);
    for (int wi = bid; wi < S_ / 8; wi += G) {
        const int rr = wi >> 8, ww = wi & 255, u = (rr << 8) + ((rr & 1) ? 255 - ww : ww);
        const int t0 = 8 * u;
        {
            const int rho = lane & 31, hf = lane >> 5, qq = (rho >> 2) & 1, hh = (rho & 3) + 4 * (rho >> 3);
            bf16x8 afr[4][4];
#pragma unroll
            for (int rt = 0; rt < 4; ++rt)
#pragma unroll
                for (int ks = 0; ks < 4; ++ks) afr[rt][ks] = *(const bf16x8*)(PROJ + (size_t)(t0 + 2 * rt + qq) * PROJ_LD + 3072 + hh * 64 + 16 * ks + 8 * hf);
            f32x4 wv[4][4];
#pragma unroll
            for (int rt = 0; rt < 4; ++rt)
#pragma unroll
                for (int i4 = 0; i4 < 4; ++i4) wv[rt][i4] = *(const f32x4*)(IWS + (size_t)(t0 + 2 * rt + hf) * 16 + 4 * i4);
            const int ntiles = (t0 + 8 + 31) >> 5;
            const bf16* ikb = IKN + lane * 8;
            bf16x8 b0[4], b1[4], b2[4];
#define SEL_LOADB(B, KT) do { int k_ = (KT); k_ = k_ < ntiles ? k_ : ntiles - 1; _Pragma("unroll") for (int ks = 0; ks < 4; ++ks) B[ks] = *(const bf16x8*)(ikb + (size_t)k_ * 2048 + ks * 512); } while (0)
#define SEL_FMA(S, W, R) asm("v_fma_f32 %0, %1, %2, %0" : "+v"(S) : "v"(W), "v"(R))
#define SEL_TILE(B, KT) do { const int key = 32 * (KT) + (lane & 31); float sc4[4]; \
                _Pragma("unroll") for (int rt = 0; rt < 4; ++rt) { f32x16 acc; \
                    _Pragma("unroll") for (int i = 0; i < 16; ++i) acc[i] = 0.f; \
                    _Pragma("unroll") for (int ks = 0; ks < 4; ++ks) acc = MFMA32(afr[rt][ks], B[ks], acc); \
                    float s0 = 0.f, s1 = 0.f; \
                    _Pragma("unroll") for (int i4 = 0; i4 < 4; ++i4) { \
                        SEL_FMA(s0, wv[rt][i4][0], relu_i(acc[4 * i4])); SEL_FMA(s1, wv[rt][i4][1], relu_i(acc[4 * i4 + 1])); \
                        SEL_FMA(s0, wv[rt][i4][2], relu_i(acc[4 * i4 + 2])); SEL_FMA(s1, wv[rt][i4][3], relu_i(acc[4 * i4 + 3])); } \
                    sc4[rt] = s0 + s1; } \
                _Pragma("unroll") for (int rt = 0; rt < 4; ++rt) SC[(2 * rt + hf) * 8192 + key] = okey16(sc4[rt]); } while (0)
            EPI_FENCE();
            SEL_LOADB(b0, wave); EPI_FENCE(); SEL_LOADB(b1, wave + 8); EPI_FENCE(); SEL_LOADB(b2, wave + 16); EPI_FENCE();
            int kt = wave;
            for (; kt + 16 < ntiles; kt += 24) {
                SEL_TILE(b0, kt); EPI_FENCE(); SEL_LOADB(b0, kt + 24); EPI_FENCE();
                SEL_TILE(b1, kt + 8); EPI_FENCE(); SEL_LOADB(b1, kt + 32); EPI_FENCE();
                SEL_TILE(b2, kt + 16); EPI_FENCE(); SEL_LOADB(b2, kt + 40); EPI_FENCE();
            }
            if (kt < ntiles) { SEL_TILE(b0, kt); EPI_FENCE(); if (kt + 8 < ntiles) { SEL_TILE(b1, kt + 8); } }
        }
        __syncthreads();
        if (!score_only) {
            const int t = t0 + wave, n = t + 1;
            LAS unsigned short* sc = SC + wave * 8192; LAS unsigned* hist = HIST + wave * 256;
            const LAS unsigned* sc2 = (const LAS unsigned*)sc;
            int* selg = SELG + (size_t)t * TOPK;
            if (n <= TOPK) {
#pragma unroll
                for (int i = 0; i < 4; ++i) { const int p = lane + 64 * i; selg[p] = p < n ? p : 0; }
            } else {
                const int nw2 = (n + 1) >> 1;
#pragma unroll
                for (int i = 0; i < 4; ++i) hist[lane + 64 * i] = 0u;
                unsigned wn = sc2[lane < nw2 ? lane : nw2 - 1];
                for (int i0 = 0; i0 < nw2; i0 += 64) { const int i = i0 + lane; const unsigned wd = wn; { const int j = i + 64; wn = sc2[j < nw2 ? j : nw2 - 1]; }
                    if (i < nw2) {
                        __hip_atomic_fetch_add(&hist[(wd >> 8) & 255u], 1u, __ATOMIC_RELAXED, __HIP_MEMORY_SCOPE_WORKGROUP);
                        if (2 * i + 1 < n) __hip_atomic_fetch_add(&hist[wd >> 24], 1u, __ATOMIC_RELAXED, __HIP_MEMORY_SCOPE_WORKGROUP); } }
                LDS_WAIT();
                unsigned dA, need; digit_search(hist, TOPK, lane, dA, need);
#pragma unroll
                for (int i = 0; i < 4; ++i) hist[lane + 64 * i] = 0u;
                wn = sc2[lane < nw2 ? lane : nw2 - 1];
                for (int i0 = 0; i0 < nw2; i0 += 64) { const int i = i0 + lane; const unsigned wd = wn; { const int j = i + 64; wn = sc2[j < nw2 ? j : nw2 - 1]; }
                    if (i < nw2) {
                        if (((wd >> 8) & 255u) == dA) __hip_atomic_fetch_add(&hist[wd & 255u], 1u, __ATOMIC_RELAXED, __HIP_MEMORY_SCOPE_WORKGROUP);
                        if (2 * i + 1 < n && (wd >> 24) == dA) __hip_atomic_fetch_add(&hist[(wd >> 16) & 255u], 1u, __ATOMIC_RELAXED, __HIP_MEMORY_SCOPE_WORKGROUP); } }
                LDS_WAIT();
                unsigned dB, need_eq; digit_search(hist, need, lane, dB, need_eq);
                const unsigned T = (dA << 8) | dB;
                unsigned goff = 0u, eoff = 0u; const unsigned gtot = TOPK - need_eq;
                LAS int* rowb = (LAS int*)(lds + LDS_AUX + 8192) + wave * 256;
                const unsigned long long ltm = (1ull << lane) - 1ull;
                wn = sc2[lane < nw2 ? lane : nw2 - 1];
                for (int i0 = 0; i0 < nw2; i0 += 64) { const int i = i0 + lane; const bool v0 = i < nw2, v1 = v0 && (2 * i + 1 < n); const unsigned wd = v0 ? wn : 0u; { const int j = i + 64; wn = sc2[j < nw2 ? j : nw2 - 1]; }
                    const unsigned k0 = wd & 0xffffu, k1 = wd >> 16;
                    const bool g0 = v0 && k0 > T, g1 = v1 && k1 > T, e0 = v0 && k0 == T, e1 = v1 && k1 == T;
                    const unsigned long long bg0 = __ballot(g0), bg1 = __ballot(g1), be0 = __ballot(e0), be1 = __ballot(e1);
                    const unsigned pg = goff + (unsigned)__popcll(bg0 & ltm) + (unsigned)__popcll(bg1 & ltm);
                    if (g0) rowb[pg] = 2 * i;
                    if (g1) rowb[pg + (g0 ? 1u : 0u)] = 2 * i + 1;
                    const unsigned pe = eoff + (unsigned)__popcll(be0 & ltm) + (unsigned)__popcll(be1 & ltm);
                    if (e0 && pe < need_eq) rowb[gtot + pe] = 2 * i;
                    if (e1 && pe + (e0 ? 1u : 0u) < need_eq) rowb[gtot + pe + (e0 ? 1u : 0u)] = 2 * i + 1;
                    goff += (unsigned)__popcll(bg0) + (unsigned)__popcll(bg1); eoff += (unsigned)__popcll(be0) + (unsigned)__popcll(be1); }
                LDS_WAIT();
                *(i32x4*)(selg + 4 * lane) = *(const LAS i32x4*)(rowb + 4 * lane);
            }
        }
        __syncthreads();
    }
}

DI bf16x8 tr_read2(unsigned a0, unsigned a1) {
    s16x4 lo, hi;
    asm volatile("ds_read_b64_tr_b16 %0, %2\n\tds_read_b64_tr_b16 %1, %3\n\ts_waitcnt lgkmcnt(0)" : "=&v"(lo), "=&v"(hi) : "v"(a0), "v"(a1) : "memory");
    return (bf16x8){lo[0], lo[1], lo[2], lo[3], hi[0], hi[1], hi[2], hi[3]};
}
DI void dsa_attend(unsigned char* ws, const float* relb, LAS unsigned char* lds, int tid, int lane, int wave, int jl) {
    const unsigned char* Q8 = ws + WS_R + R_Q8; const unsigned char* K8 = ws + WS_R + R_K8; const unsigned char* V8 = ws + WS_R + R_V8;
    const int* SELG = (const int*)(ws + WS_R + R_SEL);
    bf16* AO = (bf16*)(ws + WS_AO);
    unsigned* wq = (unsigned*)(ws + WS_CTL) + CW_WQ + 256 * jl;
    LAS int* SELL = (LAS int*)lds;
    LAS unsigned char* VBUF = lds + 8192;
    LAS float* BIAS = (LAS float*)(lds + 8192 + 131072);
    for (int i = tid; i < 129 * 16; i += NTHREADS) { const int d = i >> 4; int b = d; if (d >= 16) { b = 16 + (int)(logf((float)d * (1.0f / 16.0f)) / 2.0794415416798357f * 16.0f); b = b < 31 ? b : 31; }
        BIAS[i] = relb[b * 16 + (i & 15)]; }
    __syncthreads();
    LAS int* sel = SELL + wave * 256; LAS unsigned char* vbuf = VBUF + wave * 16384;
    const int g = lane & 15, kg = lane >> 4;
    LAS int* selg = sel + g; LAS int* selk = sel + 4 * kg;
    const int vrow = lane >> 3;
    LAS int* selv = sel + vrow;
    const int tq = (lane & 15) >> 2, tp = lane & 3;
    const int j0 = (int)(xb_xcc_id() >> 1) & 3;
    for (int dj = 0; dj < 4; ++dj) {
        const int j = (j0 + dj) & 3;
        const int hcol = 4 * j + (g & 3);
        const unsigned char* Vb = V8 + j * 128;
        for (;;) {
            unsigned it = 0u;
            if (lane == 0) it = __hip_atomic_fetch_add(wq + 64 * j, 1u, __ATOMIC_RELAXED, __HIP_MEMORY_SCOPE_AGENT);
            it = (unsigned)__builtin_amdgcn_readfirstlane((int)it);
            if (it >= (unsigned)S_) break;
            const int t = (int)it, cnt = (t + 1) < TOPK ? (t + 1) : TOPK;
            *(LAS i32x4*)(sel + 4 * lane) = *(const i32x4*)(SELG + (size_t)t * TOPK + 4 * lane);
            u32x4 qf[2];
#pragma unroll
            for (int p = 0; p < 2; ++p) qf[p] = *(const u32x4*)(Q8 + (size_t)t * 2048 + hcol * 128 + 64 * p + 16 * kg);
            LDS_WAIT();
#define ATT_VIDX(S, c) do { _Pragma("unroll") for (int m_ = 0; m_ < 8; ++m_) S[m_] = selv[64 * (c) + 8 * m_] & 8191; } while (0)
#define ATT_VDMA(S, bufi) do { _Pragma("unroll") for (int m_ = 0; m_ < 8; ++m_) { const int row_ = 8 * m_ + vrow; \
                const int ch_ = (lane & 7) ^ (((row_ >> 1) & 3) << 1); \
                __builtin_amdgcn_global_load_lds((const unsigned*)(Vb + (size_t)S[m_] * 512 + 16 * ch_), (LAS unsigned*)(vbuf + (bufi) * 8192 + m_ * 1024), 16, 0, 0); } } while (0)
            int vs0[8], vs1[8], ksel[16];
            ATT_VIDX(vs0, 0); ATT_VIDX(vs1, 1);
#pragma unroll
            for (int i = 0; i < 16; ++i) ksel[i] = selg[16 * i] & 8191;
            ATT_VDMA(vs0, 0); ATT_VDMA(vs1, 1);
            __builtin_amdgcn_s_waitcnt(0xC07F);
            __builtin_amdgcn_sched_barrier(0);
            f32x4 lg[16];
            const unsigned char* Kb = K8 + j * 128 + 16 * kg;
            u32x4 kb[8][2];
#pragma unroll
            for (int i = 0; i < 8; ++i) { const unsigned char* kp = Kb + (size_t)ksel[i] * 512;
#pragma unroll
                for (int p = 0; p < 2; ++p) kb[i][p] = *(const u32x4*)(kp + 64 * p); }
            __builtin_amdgcn_sched_barrier(0);
#pragma unroll
            for (int kt = 0; kt < 16; ++kt) {
                f32x4 a4 = {0.f, 0.f, 0.f, 0.f};
#pragma unroll
                for (int p = 0; p < 2; ++p) {
                    const u32x4 kk = kb[kt & 7][p];
                    const long a0 = (long)(((unsigned long long)kk.y << 32) | kk.x), a1 = (long)(((unsigned long long)kk.w << 32) | kk.z);
                    const long b0 = (long)(((unsigned long long)qf[p].y << 32) | qf[p].x), b1 = (long)(((unsigned long long)qf[p].w << 32) | qf[p].z);
                    a4 = __builtin_amdgcn_mfma_f32_16x16x32_fp8_fp8(a0, b0, a4, 0, 0, 0);
                    a4 = __builtin_amdgcn_mfma_f32_16x16x32_fp8_fp8(a1, b1, a4, 0, 0, 0);
                }
                lg[kt] = a4;
                if (kt + 8 < 16) { const unsigned char* kp = Kb + (size_t)ksel[kt + 8] * 512;
#pragma unroll
                    for (int p = 0; p < 2; ++p) kb[kt & 7][p] = *(const u32x4*)(kp + 64 * p); }
                __builtin_amdgcn_sched_barrier(0);
            }
            const int cq = g >> 2;
            float mx = -INFINITY;
            const int cntk = cnt - 4 * kg;
            float pw[4][4];
#pragma unroll
            for (int i = 0; i < 4; ++i) {
                f32x4 lgi = (cq == 0) ? lg[i] : (cq == 1) ? lg[4 + i] : (cq == 2) ? lg[8 + i] : lg[12 + i];
                const int kt = 4 * cq + i;
                const i32x4 s4 = *(const LAS i32x4*)(selk + 16 * kt);
#pragma unroll
                for (int r = 0; r < 4; ++r) {
                    int dist = t - s4[r]; dist = dist < 0 ? 0 : (dist > 128 ? 128 : dist);
                    float v = lgi[r] * 0.08838834764831845f + BIAS[dist * 16 + hcol];
                    v = (16 * kt + r < cntk) ? v : -INFINITY;
                    pw[i][r] = v; mx = fmaxf(mx, v);
                }
            }
            mx = fmaxf(mx, __shfl_xor(mx, 4)); mx = fmaxf(mx, __shfl_xor(mx, 8)); mx = fmaxf(mx, __shfl_xor(mx, 16)); mx = fmaxf(mx, __shfl_xor(mx, 32));
            float sum = 0.f;
#pragma unroll
            for (int i = 0; i < 4; ++i)
#pragma unroll
                for (int r = 0; r < 4; ++r) { const float e = __expf(pw[i][r] - mx); pw[i][r] = e; sum += e; }
            sum += __shfl_xor(sum, 4); sum += __shfl_xor(sum, 8); sum += __shfl_xor(sum, 16); sum += __shfl_xor(sum, 32);
            const float inv = __builtin_amdgcn_rcpf(sum) * 128.0f;
            const unsigned pA0 = pk4_fp8(pw[0][0] * inv, pw[0][1] * inv, pw[0][2] * inv, pw[0][3] * inv), pB0 = pk4_fp8(pw[1][0] * inv, pw[1][1] * inv, pw[1][2] * inv, pw[1][3] * inv);
            const unsigned pA1 = pk4_fp8(pw[2][0] * inv, pw[2][1] * inv, pw[2][2] * inv, pw[2][3] * inv), pB1 = pk4_fp8(pw[3][0] * inv, pw[3][1] * inv, pw[3][2] * inv, pw[3][3] * inv);
            f32x4 o[8];
#pragma unroll
            for (int dt = 0; dt < 8; ++dt) o[dt] = (f32x4){0.f, 0.f, 0.f, 0.f};
#pragma unroll
            for (int c = 0; c < 4; ++c) {
                if (c < 3) asm volatile("s_waitcnt vmcnt(8)" ::: "memory"); else asm volatile("s_waitcnt vmcnt(0)" ::: "memory");
                const unsigned base = (unsigned)(size_t)(vbuf + (c & 1) * 8192);
#pragma unroll
                for (int s2 = 0; s2 < 2; ++s2) {
                    const int ks = 2 * c + s2;
                    const int rA = 32 * s2 + 4 * kg + tq, rB = rA + 16;
                    const bool mine = (ks >> 1) == cq;
                    const unsigned pa = mine ? ((ks & 1) ? pA1 : pA0) : 0u, pb = mine ? ((ks & 1) ? pB1 : pB0) : 0u;
                    const long pf = (long)(((unsigned long long)pb << 32) | pa);
                    u32x2 vl[4], vh[4];
#pragma unroll
                    for (int mp = 0; mp < 4; ++mp) {
                        const unsigned a0 = base + 128u * rA + 16u * ((2 * mp + (tp >> 1)) ^ (((rA >> 1) & 3) << 1)) + 8u * (tp & 1);
                        const unsigned a1 = base + 128u * rB + 16u * ((2 * mp + (tp >> 1)) ^ (((rB >> 1) & 3) << 1)) + 8u * (tp & 1);
                        asm volatile("ds_read_b64_tr_b16 %0, %2\n\tds_read_b64_tr_b16 %1, %3" : "=&v"(vl[mp]), "=&v"(vh[mp]) : "v"(a0), "v"(a1) : "memory");
                    }
                    asm volatile("s_waitcnt lgkmcnt(0)" : "+v"(vl[0]), "+v"(vl[1]), "+v"(vl[2]), "+v"(vl[3]), "+v"(vh[0]), "+v"(vh[1]), "+v"(vh[2]), "+v"(vh[3]) :: "memory");
#pragma unroll
                    for (int mp = 0; mp < 4; ++mp) {
                        const unsigned e0 = __builtin_amdgcn_perm(vl[mp].y, vl[mp].x, 0x06040200u), e1 = __builtin_amdgcn_perm(vh[mp].y, vh[mp].x, 0x06040200u);
                        const unsigned o0 = __builtin_amdgcn_perm(vl[mp].y, vl[mp].x, 0x07050301u), o1 = __builtin_amdgcn_perm(vh[mp].y, vh[mp].x, 0x07050301u);
                        const long fe = (long)(((unsigned long long)e1 << 32) | e0), fo = (long)(((unsigned long long)o1 << 32) | o0);
                        o[2 * mp] = __builtin_amdgcn_mfma_f32_16x16x32_fp8_fp8(fe, pf, o[2 * mp], 0, 0, 0);
                        o[2 * mp + 1] = __builtin_amdgcn_mfma_f32_16x16x32_fp8_fp8(fo, pf, o[2 * mp + 1], 0, 0, 0);
                    }
                }
                if (c + 2 < 4) { int vsn[8]; ATT_VIDX(vsn, c + 2); ATT_VDMA(vsn, c & 1); }
            }
#undef ATT_VDMA
#undef ATT_VIDX
#pragma unroll
            for (int dt = 0; dt < 8; ++dt)
#pragma unroll
                for (int r = 0; r < 4; ++r) { float x = o[dt][r];
                    x += __builtin_bit_cast(float, __builtin_amdgcn_update_dpp(0, __builtin_bit_cast(int, x), 0x128, 0xf, 0xf, false));
                    x += __builtin_bit_cast(float, __builtin_amdgcn_update_dpp(0, __builtin_bit_cast(int, x), 0x124, 0xf, 0xf, false)); o[dt][r] = x; }
            if (g < 4) {
#pragma unroll
                for (int mp = 0; mp < 4; ++mp) { const f32x4 ev = o[2 * mp] * (1.0f / 128.0f), ov = o[2 * mp + 1] * (1.0f / 128.0f);
                    const float h8[8] = {ev[0], ov[0], ev[1], ov[1], ev[2], ov[2], ev[3], ov[3]};
                    *(bf16x8*)(AO + (size_t)t * D_ + (4 * j + g) * 128 + 32 * mp + 8 * kg) = pack8(h8); }
            }
            LDS_WAIT();
        }
    }
}

DI void hgrn_a(unsigned char* ws, int lane, int wave, int bid, int G) {
    const float* F = (const float*)(ws + WS_R + R_F); const bf16* VT = (const bf16*)(ws + WS_R + R_VT);
    float* BC = (float*)(ws + WS_R + R_BC); unsigned char* STB = ws + WS_R + R_ST; float* EBL = (float*)(ws + WS_R + R_EBL);
    const int u2 = wave >> 2, dt = wave & 3, dl = lane & 31, hf = lane >> 5;
    for (int U = bid * 2 + u2; U < 2048; U += 2 * G) {
        const int c = U >> 4, h = U & 15, d = h * 128 + dt * 32 + dl;
        float b[4][8], kd[4][8], tot[4];
#pragma unroll
        for (int i = 0; i < 4; ++i) {
            float run = 0.f;
#pragma unroll
            for (int jj = 0; jj < 8; ++jj) { const float f = F[(size_t)(c * 64 + 8 * (2 * i + hf) + jj) * D_ + d]; kd[i][jj] = 1.0f - f; run += logf(f); b[i][jj] = run; }
            tot[i] = run;
        }
        float pre = 0.f;
#pragma unroll
        for (int i = 0; i < 4; ++i) {
            const float pt = __shfl_xor(tot[i], 32);
            const float mypre = pre + (hf ? pt : 0.f);
#pragma unroll
            for (int jj = 0; jj < 8; ++jj) b[i][jj] += mypre;
            pre += tot[i] + pt;
        }
        const float blast = pre;
#pragma unroll
        for (int i = 0; i < 4; ++i)
#pragma unroll
            for (int jj = 0; jj < 8; ++jj) { BC[(size_t)(c * 64 + 8 * (2 * i + hf) + jj) * D_ + d] = b[i][jj]; kd[i][jj] *= __expf(blast - b[i][jj]); }
        if (hf == 0) EBL[(size_t)U * 128 + dt * 32 + dl] = __expf(blast);
        f32x16 acc[4];
#pragma unroll
        for (int et = 0; et < 4; ++et)
#pragma unroll
            for (int i = 0; i < 16; ++i) acc[et][i] = 0.f;
#pragma unroll
        for (int ks = 0; ks < 4; ++ks) {
            const bf16x8 bfr = pack8(kd[ks]);
#pragma unroll
            for (int et = 0; et < 4; ++et) {
                const bf16x8 afr = *(const bf16x8*)(VT + (size_t)(h * 128 + et * 32 + dl) * S_ + c * 64 + 16 * ks + 8 * hf);
                acc[et] = MFMA32(bfr, afr, acc[et]);
            }
        }
#pragma unroll
        for (int et = 0; et < 4; ++et)
#pragma unroll
            for (int s2 = 0; s2 < 2; ++s2) {
                float v[8];
#pragma unroll
                for (int i = 0; i < 8; ++i) v[i] = acc[et][8 * s2 + i];
                *(bf16x8*)(STB + (((size_t)U * 4 + et) * 8 + 2 * dt + s2) * 1024 + lane * 16) = pack8(v);
            }
    }
}
DI void hgrn_b(unsigned char* ws, int gtid, int nthreads, int dummy) {
    unsigned char* STB = ws + WS_R + R_ST; const float* EBL = (const float*)(ws + WS_R + R_EBL);
    for (int p = gtid; p < 131072; p += nthreads) {
        const int h = p >> 13, rem = p & 8191, ks = (rem >> 8) & 7, ln = (rem >> 2) & 63, wsel = rem & 3;
        const int d0 = 16 * ks + 8 * (wsel >> 1) + 4 * (ln >> 5) + 2 * (wsel & 1);
        float r0 = 0.f, r1 = 0.f;
#pragma unroll 8
        for (int c = 0; c < 128; ++c) {
            unsigned* ptr = (unsigned*)(STB + (size_t)(c * 16 + h) * 32768 + (size_t)rem * 4);
            const unsigned loc = *ptr; const f32x2 eb = *(const f32x2*)(EBL + (size_t)(c * 16 + h) * 128 + d0);
            *ptr = dummy ? loc : pk2(r0, r1);
            r0 = r0 * eb[0] + bf_lo(loc); r1 = r1 * eb[1] + bf_hi(loc);
        }
    }
}
DI void hgrn_c(unsigned char* ws, const float* ogain, int lane, int wave, int bid, int NG) {
    const bf16* Q = (const bf16*)(ws + WS_R + R_Q); const float* F = (const float*)(ws + WS_R + R_F); const bf16* G = (const bf16*)(ws + WS_R + R_G);
    const bf16* VT = (const bf16*)(ws + WS_R + R_VT); const float* BC = (const float*)(ws + WS_R + R_BC); const unsigned char* STB = ws + WS_R + R_ST;
    bf16* AO = (bf16*)(ws + WS_AO);
    const int u4 = wave >> 1, tt = wave & 1, tl = lane & 31, hf = lane >> 5;
    for (int U = bid * 4 + u4; U < 2048; U += 4 * NG) {
        const int c = U >> 4, h = U & 15, t = c * 64 + tt * 32 + tl;
        const size_t cb = (size_t)h * 128 + 4 * hf;
        bf16x8 qt[8];
        const bf16* qrow = Q + (size_t)t * D_ + cb; const float* brow = BC + (size_t)t * D_ + cb; const float* b31 = BC + (size_t)(c * 64 + 31) * D_ + cb;
#pragma unroll
        for (int ks = 0; ks < 8; ++ks) {
            const u32x2 qa = *(const u32x2*)(qrow + 16 * ks), qb2 = *(const u32x2*)(qrow + 16 * ks + 8);
            const float q[8] = {bf_lo(qa.x), bf_hi(qa.x), bf_lo(qa.y), bf_hi(qa.y), bf_lo(qb2.x), bf_hi(qb2.x), bf_lo(qb2.y), bf_hi(qb2.y)};
            const f32x4 b0 = *(const f32x4*)(brow + 16 * ks), b1 = *(const f32x4*)(brow + 16 * ks + 8);
            float v[8];
#pragma unroll
            for (int e = 0; e < 4; ++e) { v[e] = q[e] * __expf(b0[e]); v[4 + e] = q[4 + e] * __expf(b1[e]); }
            qt[ks] = pack8(v);
        }
        f32x16 acc[4];
#pragma unroll
        for (int et = 0; et < 4; ++et)
#pragma unroll
            for (int i = 0; i < 16; ++i) acc[et][i] = 0.f;
#pragma unroll
        for (int ks = 0; ks < 8; ++ks) {
#pragma unroll
            for (int et = 0; et < 4; ++et) {
                const bf16x8 sf = *(const bf16x8*)(STB + (((size_t)U * 4 + et) * 8 + ks) * 1024 + lane * 16);
                acc[et] = MFMA32(sf, qt[ks], acc[et]);
            }
            if ((ks & 3) == 3) asm volatile("" ::: "memory");
        }
        for (int st = 0; st <= tt; ++st) {
            const int sa = c * 64 + st * 32 + tl;
            const float* frow = F + (size_t)sa * D_ + cb; const float* srow = BC + (size_t)sa * D_ + cb;
            f32x16 X;
#pragma unroll
            for (int i = 0; i < 16; ++i) X[i] = 0.f;
#pragma unroll
            for (int ks = 0; ks < 8; ++ks) {
                const f32x4 f0 = *(const f32x4*)(frow + 16 * ks), f1 = *(const f32x4*)(frow + 16 * ks + 8);
                const f32x4 b0 = *(const f32x4*)(srow + 16 * ks), b1 = *(const f32x4*)(srow + 16 * ks + 8);
                f32x4 c0 = {0.f, 0.f, 0.f, 0.f}, c1 = {0.f, 0.f, 0.f, 0.f};
                bf16x8 qb = qt[ks];
                if (st == 1) {
                    c0 = *(const f32x4*)(b31 + 16 * ks); c1 = *(const f32x4*)(b31 + 16 * ks + 8);
                    const u32x2 qa = *(const u32x2*)(qrow + 16 * ks), qb2 = *(const u32x2*)(qrow + 16 * ks + 8);
                    const float q[8] = {bf_lo(qa.x), bf_hi(qa.x), bf_lo(qa.y), bf_hi(qa.y), bf_lo(qb2.x), bf_hi(qb2.x), bf_lo(qb2.y), bf_hi(qb2.y)};
                    const f32x4 t0 = *(const f32x4*)(brow + 16 * ks), t1 = *(const f32x4*)(brow + 16 * ks + 8);
                    float w[8];
#pragma unroll
                    for (int e = 0; e < 4; ++e) { w[e] = q[e] * __expf(t0[e] - c0[e]); w[4 + e] = q[4 + e] * __expf(t1[e] - c1[e]); }
                    qb = pack8(w);
                }
                float v[8];
#pragma unroll
                for (int e = 0; e < 4; ++e) { v[e] = (1.0f - f0[e]) * __expf(c0[e] - b0[e]); v[4 + e] = (1.0f - f1[e]) * __expf(c1[e] - b1[e]); }
                X = MFMA32(pack8(v), qb, X);
                if (ks & 1) asm volatile("" ::: "memory");
            }
            if (st == tt) {
#pragma unroll
                for (int r = 0; r < 16; ++r) { const int sl = (r & 3) + 8 * (r >> 2) + 4 * hf; X[r] = (sl <= tl) ? X[r] : 0.f; }
            }
#pragma unroll
            for (int kp = 0; kp < 2; ++kp) {
                float xv[8];
#pragma unroll
                for (int i = 0; i < 8; ++i) xv[i] = X[8 * kp + i];
                const bf16x8 xb = pack8(xv);
#pragma unroll
                for (int et = 0; et < 4; ++et) {
                    const bf16* vp = VT + (size_t)(h * 128 + et * 32 + tl) * S_ + c * 64 + st * 32 + 16 * kp + 4 * hf;
                    const s16x4 lo = *(const s16x4*)vp, hi = *(const s16x4*)(vp + 8);
                    const bf16x8 vf = {lo[0], lo[1], lo[2], lo[3], hi[0], hi[1], hi[2], hi[3]};
                    acc[et] = MFMA32(vf, xb, acc[et]);
                }
            }
        }
        float ss = 0.f;
#pragma unroll
        for (int et = 0; et < 4; ++et)
#pragma unroll
            for (int i = 0; i < 16; ++i) ss += acc[et][i] * acc[et][i];
        ss += __shfl_xor(ss, 32);
        const float rstd = __builtin_amdgcn_rsqf(ss * (1.0f / 128.0f) + EPS_);
#pragma unroll
        for (int et = 0; et < 4; ++et)
#pragma unroll
            for (int rq = 0; rq < 4; ++rq) {
                const int e0 = h * 128 + et * 32 + 8 * rq + 4 * hf;
                const f32x4 og = *(const f32x4*)(ogain + e0);
                const u32x2 gw = *(const u32x2*)(G + (size_t)t * D_ + e0);
                const float g0 = bf_lo(gw.x), g1 = bf_hi(gw.x), g2 = bf_lo(gw.y), g3 = bf_hi(gw.y);
                u32x2 w;
                w.x = pk2(acc[et][4 * rq] * rstd * og[0] * g0, acc[et][4 * rq + 1] * rstd * og[1] * g1);
                w.y = pk2(acc[et][4 * rq + 2] * rstd * og[2] * g2, acc[et][4 * rq + 3] * rstd * og[3] * g3);
                *(u32x2*)(AO + (size_t)t * D_ + e0) = w;
            }
    }
}

DI void hgrn_a2(unsigned char* ws, LAS unsigned char* lds, int tid, int lane, int wave, int bid, int NG) {
    const unsigned short* K1 = (const unsigned short*)(ws + WS_R + R_F); const bf16* VT = (const bf16*)(ws + WS_R + R_VT);
    unsigned short* BC = (unsigned short*)(ws + WS_R + R_BC); unsigned char* STB = ws + WS_R + R_ST; float* EBL = (float*)(ws + WS_R + R_EBL);
    constexpr int BLK = 1040;
    LAS unsigned char* Ft = lds;
    LAS float* QT = (LAS float*)(lds + 32 * BLK);
    LAS unsigned char* KDT = lds + 32 * BLK + 2048;
    LAS unsigned char* BCT = lds + 65536;
    const int d = tid & 127, tq = tid >> 7;
    const int dt = wave & 3, ep = wave >> 2, dl = lane & 31, hf = lane >> 5;
#define A2_STAGE(U_) do { const int c_ = (U_) >> 4, h_ = (U_) & 15; \
        _Pragma("unroll") for (int i_ = 0; i_ < 2; ++i_) { const int m_ = wave * 2 + i_; \
            __builtin_amdgcn_global_load_lds((const unsigned*)(K1 + (size_t)(c_ * 64 + 4 * m_ + (lane >> 4)) * D_ + h_ * 128 + (lane & 15) * 8), (LAS unsigned*)(Ft + m_ * BLK), 16, 0, 0); } } while (0)
    int U = bid;
    if (U < 2048) A2_STAGE(U);
    for (; U < 2048; U += NG) {
        const int c = U >> 4, h = U & 15;
        bf16x8 vf[2][4];
#pragma unroll
        for (int e2 = 0; e2 < 2; ++e2)
#pragma unroll
            for (int ks = 0; ks < 4; ++ks) vf[e2][ks] = *(const bf16x8*)(VT + (size_t)(h * 128 + (2 * ep + e2) * 32 + dl) * S_ + c * 64 + 16 * ks + 8 * hf);
        asm volatile("s_waitcnt vmcnt(0)" ::: "memory");
        __syncthreads();
        float f[16], b[16];
        float run = 0.f;
#pragma unroll
        for (int i = 0; i < 16; ++i) { const int r = 16 * tq + i; f[i] = (float)*(const LAS _Float16*)(Ft + (r >> 2) * BLK + (r & 3) * 256 + d * 2); run += __logf(1.0f - f[i]); b[i] = run; }
        QT[tq * 128 + d] = run;
        LDS_WAIT();
        __syncthreads();
        if (U + NG < 2048) A2_STAGE(U + NG);
        const float q0 = QT[d], q1 = QT[128 + d], q2 = QT[256 + d], q3 = QT[384 + d];
        const float pre = (tq > 0 ? q0 : 0.f) + (tq > 1 ? q1 : 0.f) + (tq > 2 ? q2 : 0.f);
        const float blast = (q0 + q1) + (q2 + q3);
        float kd[16];
#pragma unroll
        for (int i = 0; i < 16; ++i) { b[i] += pre; *(LAS unsigned short*)(BCT + (16 * tq + i) * 272 + d * 2) = __builtin_bit_cast(unsigned short, (_Float16)b[i]); kd[i] = f[i] * __expf(blast - b[i]); }
        if (tq == 0) EBL[(size_t)U * 128 + d] = __expf(blast);
        *(LAS bf16x8*)(KDT + d * 144 + 32 * tq) = pack8(kd); *(LAS bf16x8*)(KDT + d * 144 + 32 * tq + 16) = pack8(kd + 8);
        LDS_WAIT();
        __syncthreads();
#pragma unroll
        for (int i = 0; i < 2; ++i) { const int q = tid + NTHREADS * i, r = q >> 4, cc = q & 15;
            *(u32x4*)(BC + (size_t)(c * 64 + r) * D_ + h * 128 + cc * 8) = *(const LAS u32x4*)(BCT + r * 272 + cc * 16); }
        f32x16 acc[2];
#pragma unroll
        for (int e2 = 0; e2 < 2; ++e2)
#pragma unroll
            for (int i = 0; i < 16; ++i) acc[e2][i] = 0.f;
#pragma unroll
        for (int ks = 0; ks < 4; ++ks) {
            const bf16x8 af = *(const LAS bf16x8*)(KDT + (dt * 32 + dl) * 144 + 32 * ks + 16 * hf);
#pragma unroll
            for (int e2 = 0; e2 < 2; ++e2) acc[e2] = MFMA32(af, vf[e2][ks], acc[e2]);
        }
#pragma unroll
        for (int e2 = 0; e2 < 2; ++e2)
#pragma unroll
            for (int s2 = 0; s2 < 2; ++s2) {
                float v[8];
#pragma unroll
                for (int i = 0; i < 8; ++i) v[i] = acc[e2][8 * s2 + i];
                *(bf16x8*)(STB + (((size_t)U * 4 + 2 * ep + e2) * 8 + 2 * dt + s2) * 1024 + lane * 16) = pack8(v);
            }
    }
#undef A2_STAGE
}

DI void hgrn_c2(unsigned char* ws, const float* ogain, LAS unsigned char* lds, int tid, int lane, int wave, int bid, int NG) {
    const bf16* Q = (const bf16*)(ws + WS_R + R_Q); const unsigned short* K1 = (const unsigned short*)(ws + WS_R + R_F); const bf16* G = (const bf16*)(ws + WS_R + R_G);
    const bf16* VT = (const bf16*)(ws + WS_R + R_VT); const unsigned short* BC = (const unsigned short*)(ws + WS_R + R_BC); const unsigned char* STB = ws + WS_R + R_ST;
    bf16* AO = (bf16*)(ws + WS_AO);
    constexpr int BLK = 1040;
    constexpr int SETB = 48 * BLK;
    LAS float* SSt = (LAS float*)(lds + 2 * SETB);
    LAS unsigned char* XFt = lds + 2 * SETB + 1024;
    const int et = wave & 3, tt = wave >> 2, tl = lane & 31, hf = lane >> 5;
    const int rt = tt * 32 + tl;
#define C2_DMA(G_, L_) do { const unsigned la_ = (unsigned)(size_t)(L_); asm volatile("s_mov_b32 m0, %1\n\ts_nop 0\n\tglobal_load_lds_dwordx4 %0, off" :: "v"(G_), "s"(la_) : "memory", "m0"); } while (0)
#define C2_STAGE(U_, S_) do { const int c_ = (U_) >> 4, h_ = (U_) & 15; LAS unsigned char* sb_ = lds + (S_) * SETB; \
        _Pragma("unroll") for (int i_ = 0; i_ < 2; ++i_) { const int m_ = wave * 2 + i_; const size_t ro_ = (size_t)(c_ * 64 + 4 * m_ + (lane >> 4)) * D_ + h_ * 128 + (lane & 15) * 8; \
            C2_DMA(BC + ro_, sb_ + m_ * BLK); C2_DMA(K1 + ro_, sb_ + (16 + m_) * BLK); C2_DMA(Q + ro_, sb_ + (32 + m_) * BLK); } } while (0)
#define C2_ROW4(T, r) ((T) + ((r) >> 2) * BLK + ((r) & 3) * 256)
#define C2_ROWQ(r) C2_ROW4(Qt, r)
#define C2_H4(p_) ({ const u32x2 w_ = *(const LAS u32x2*)(p_); (f32x4){h_lo(w_.x), h_hi(w_.x), h_lo(w_.y), h_hi(w_.y)}; })
    int U = bid;
    if (U < 2048) C2_STAGE(U, 0);
    asm volatile("s_waitcnt vmcnt(0)" ::: "memory");
    for (int iter = 0; U < 2048; U += NG, ++iter) {
        const int par = iter & 1;
        const int c = U >> 4, h = U & 15, t = c * 64 + rt;
        LAS unsigned char* BCt = lds + par * SETB; LAS unsigned char* Ft = BCt + 16 * BLK; LAS unsigned char* Qt = BCt + 32 * BLK;
        asm volatile("s_waitcnt vmcnt(4)" ::: "memory");
        __syncthreads();
        bf16x8 sfr[8]; s16x4 vlo[2][2], vhi[2][2]; u32x2 gwr[4]; f32x4 ogr[4];
#pragma unroll
        for (int ks = 0; ks < 8; ++ks) sfr[ks] = *(const bf16x8*)(STB + (((size_t)U * 4 + et) * 8 + ks) * 1024 + lane * 16);
#pragma unroll
        for (int st = 0; st < 2; ++st)
#pragma unroll
            for (int kp = 0; kp < 2; ++kp) { const bf16* vp = VT + (size_t)(h * 128 + et * 32 + tl) * S_ + c * 64 + st * 32 + 16 * kp + 4 * hf; vlo[st][kp] = *(const s16x4*)vp; vhi[st][kp] = *(const s16x4*)(vp + 8); }
#pragma unroll
        for (int rq = 0; rq < 4; ++rq) { const int e0 = h * 128 + et * 32 + 8 * rq + 4 * hf; ogr[rq] = *(const f32x4*)(ogain + e0); gwr[rq] = *(const u32x2*)(G + (size_t)t * D_ + e0); }
        EPI_FENCE();
        if (U + NG < 2048) C2_STAGE(U + NG, par ^ 1);
        EPI_FENCE();
        const LAS unsigned char* qrow = C2_ROWQ(rt) + 8 * hf; const LAS unsigned char* brow = C2_ROW4(BCt, rt) + 8 * hf; const LAS unsigned char* b31 = C2_ROW4(BCt, 31) + 8 * hf;
        bf16x8 qt[8];
#pragma unroll
        for (int ks = 0; ks < 8; ++ks) {
            const u32x2 qa = *(const LAS u32x2*)(qrow + 32 * ks), qb2 = *(const LAS u32x2*)(qrow + 32 * ks + 16);
            const float q[8] = {bf_lo(qa.x), bf_hi(qa.x), bf_lo(qa.y), bf_hi(qa.y), bf_lo(qb2.x), bf_hi(qb2.x), bf_lo(qb2.y), bf_hi(qb2.y)};
            const f32x4 b0 = C2_H4(brow + 32 * ks), b1 = C2_H4(brow + 32 * ks + 16);
            float v[8];
#pragma unroll
            for (int e = 0; e < 4; ++e) { v[e] = q[e] * __expf(b0[e]); v[4 + e] = q[4 + e] * __expf(b1[e]); }
            qt[ks] = pack8(v);
            if (ks & 1) asm volatile("" ::: "memory");
        }
        f32x16 acc;
#pragma unroll
        for (int i = 0; i < 16; ++i) acc[i] = 0.f;
#pragma unroll
        for (int ks = 0; ks < 8; ++ks) {
            acc = MFMA32(sfr[ks], qt[ks], acc);
        }
        if (et <= tt) {
            const int st = et;
            const LAS unsigned char* frow = C2_ROW4(Ft, st * 32 + tl) + 8 * hf; const LAS unsigned char* srow = C2_ROW4(BCt, st * 32 + tl) + 8 * hf;
            f32x16 X;
#pragma unroll
            for (int i = 0; i < 16; ++i) X[i] = 0.f;
#pragma unroll
            for (int ks = 0; ks < 8; ++ks) {
                const f32x4 f0 = C2_H4(frow + 32 * ks), f1 = C2_H4(frow + 32 * ks + 16);
                const f32x4 b0 = C2_H4(srow + 32 * ks), b1 = C2_H4(srow + 32 * ks + 16);
                f32x4 c0 = {0.f, 0.f, 0.f, 0.f}, c1 = {0.f, 0.f, 0.f, 0.f};
                bf16x8 qb = qt[ks];
                if (st == 1) {
                    c0 = C2_H4(b31 + 32 * ks); c1 = C2_H4(b31 + 32 * ks + 16);
                    const u32x2 qa = *(const LAS u32x2*)(qrow + 32 * ks), qb2 = *(const LAS u32x2*)(qrow + 32 * ks + 16);
                    const float q[8] = {bf_lo(qa.x), bf_hi(qa.x), bf_lo(qa.y), bf_hi(qa.y), bf_lo(qb2.x), bf_hi(qb2.x), bf_lo(qb2.y), bf_hi(qb2.y)};
                    const f32x4 t0 = C2_H4(brow + 32 * ks), t1 = C2_H4(brow + 32 * ks + 16);
                    float w[8];
#pragma unroll
                    for (int e = 0; e < 4; ++e) { w[e] = q[e] * __expf(t0[e] - c0[e]); w[4 + e] = q[4 + e] * __expf(t1[e] - c1[e]); }
                    qb = pack8(w);
                }
                float v[8];
#pragma unroll
                for (int e = 0; e < 4; ++e) { v[e] = f0[e] * __expf(c0[e] - b0[e]); v[4 + e] = f1[e] * __expf(c1[e] - b1[e]); }
                X = MFMA32(pack8(v), qb, X);
                if (ks & 1) asm volatile("" ::: "memory");
            }
            if (st == tt) {
#pragma unroll
                for (int r = 0; r < 16; ++r) { const int sl = (r & 3) + 8 * (r >> 2) + 4 * hf; X[r] = (sl <= tl) ? X[r] : 0.f; }
            }
#pragma unroll
            for (int kp = 0; kp < 2; ++kp) {
                float xv[8];
#pragma unroll
                for (int i = 0; i < 8; ++i) xv[i] = X[8 * kp + i];
                *(LAS bf16x8*)(XFt + ((st + tt) * 2 + kp) * 1024 + lane * 16) = pack8(xv);
            }
        }
        LDS_WAIT();
        __syncthreads();
#pragma unroll
        for (int st = 0; st < 2; ++st) {
            if (st <= tt) {
#pragma unroll
                for (int kp = 0; kp < 2; ++kp) {
                    const bf16x8 xb = *(const LAS bf16x8*)(XFt + ((st + tt) * 2 + kp) * 1024 + lane * 16);
                    const s16x4 lo = vlo[st][kp], hi = vhi[st][kp];
                    const bf16x8 vf = {lo[0], lo[1], lo[2], lo[3], hi[0], hi[1], hi[2], hi[3]};
                    acc = MFMA32(vf, xb, acc);
                }
            }
        }
        float ss = 0.f;
#pragma unroll
        for (int i = 0; i < 16; ++i) ss += acc[i] * acc[i];
        ss += __shfl_xor(ss, 32);
        if (hf == 0) SSt[rt * 4 + et] = ss;
        LDS_WAIT();
        __syncthreads();
        const f32x4 s4 = *(const LAS f32x4*)(SSt + rt * 4);
        const float rstd = __builtin_amdgcn_rsqf(((s4[0] + s4[1]) + (s4[2] + s4[3])) * (1.0f / 128.0f) + EPS_);
        LDS_WAIT();
        __syncthreads();
        u32x2 wo[4];
#pragma unroll
        for (int rq = 0; rq < 4; ++rq) {
            const f32x4 og = ogr[rq];
            const u32x2 gw = gwr[rq];
            const float g0 = bf_lo(gw.x), g1 = bf_hi(gw.x), g2 = bf_lo(gw.y), g3 = bf_hi(gw.y);
            wo[rq].x = pk2(acc[4 * rq] * rstd * og[0] * g0, acc[4 * rq + 1] * rstd * og[1] * g1);
            wo[rq].y = pk2(acc[4 * rq + 2] * rstd * og[2] * g2, acc[4 * rq + 3] * rstd * og[3] * g3);
        }
        { bf16* op_ = AO + (size_t)t * D_ + h * 128 + et * 32 + 4 * hf;
          asm volatile("global_store_dwordx2 %0, %1, off\n\tglobal_store_dwordx2 %0, %2, off offset:16\n\tglobal_store_dwordx2 %0, %3, off offset:32\n\tglobal_store_dwordx2 %0, %4, off offset:48"
                       :: "v"(op_), "v"(wo[0]), "v"(wo[1]), "v"(wo[2]), "v"(wo[3]) : "memory"); }
    }
#undef C2_STAGE
#undef C2_DMA
#undef C2_ROW4
#undef C2_ROWQ
#undef C2_H4
}

constexpr int N_PHASE_IDS = 41;
__global__ void __launch_bounds__(NTHREADS, 2) fwd(Args args) {
    extern __shared__ __attribute__((aligned(16))) unsigned char lds_raw[];
    LAS unsigned char* lds = (LAS unsigned char*)lds_raw;
    const int tid = threadIdx.x, lane = tid & 63, wave = __builtin_amdgcn_readfirstlane(tid >> 6);
    const int G = gridDim.x;
    const int NGW = G * NWAVES;
    unsigned char* ws_k = args.ws;
#if MK_ONE_LAUNCH
    constexpr int lo = 0, hi = N_PHASE_IDS; constexpr bool multi = true;
#else
    const int lo = args.ph_lo, hi = args.ph_hi;
    const bool multi = (hi - lo) > 1;
#endif
    volatile LAS unsigned* MISC = (volatile LAS unsigned*)(lds + LDS_MISC);
    if (tid < 4) MISC[tid] = 0u;
    __syncthreads();
    XcdBarrier bar; bar.bar = (unsigned*)(ws_k + WS_CTL) + CW_BAR; bar.x = 0; bar.st = MISC;
    if (multi) bar = xcd_barrier_post((unsigned*)(ws_k + WS_CTL) + CW_BAR, MISC);
#ifndef PH_MASK
#define PH_MASK 0xFFFF
#endif
#define IN(k) (lo <= (k) && (k) < hi)
#define EN(b) ((PH_MASK >> (b)) & 1)
#ifndef PROBE_DUP
#define PROBE_DUP 0
#endif
#ifndef PROBE_MODE
#define PROBE_MODE 0
#endif
#ifndef PROBE_BAR
#define PROBE_BAR 0
#endif
#define REP(b) for (int rep_ = ((PROBE_DUP >> (b)) & 1); rep_ >= 0; --rep_)
#define OPQ() __builtin_amdgcn_s_waitcnt(0); int tid_ = tid, bid_ = (int)blockIdx.x; GAS unsigned char* wsg_ = (GAS unsigned char*)ws_k; asm volatile("" : "+v"(tid_), "+s"(bid_), "+s"(wsg_)); unsigned char* ws = (unsigned char*)wsg_; float* X = (float*)args.out; bf16* XB = (bf16*)(ws + WS_XB); bf16* AO = (bf16*)(ws + WS_AO); float* SSQ = (float*)(ws + (sqp ? WS_SSQ1 : WS_SSQ)); float* SSQO = (float*)(ws + (sqp ? WS_SSQ : WS_SSQ1)); float* XS = (float*)(ws + WS_XS); (void)X; (void)XB; (void)AO; (void)SSQ; (void)SSQO; (void)XS; const int lane_ = tid_ & 63, wave_ = __builtin_amdgcn_readfirstlane(tid_ >> 6), gw_ = bid_ * NWAVES + wave_; (void)lane_; (void)gw_
#define SEAM(k) do { if (multi && (k) + 1 < hi) { XcdBarrier b_ = bar; GAS unsigned* bp_ = (GAS unsigned*)b_.bar; asm volatile("" : "+s"(bp_)); b_.bar = (unsigned*)bp_; xcd_barrier(b_); if (PROBE_BAR) xcd_barrier(b_); } } while (0)


    int sqp = 0;
    if (EN(0) && IN(0)) REP(0) { OPQ(); p0_prologue(args, lds, gw_, NGW, lane_, wave_); SEAM(0); }

    for (int l = 0; l < DEPTH_; ++l) {
        const int pb = 1 + 10 * l, j = l >> 1;
        for (int f = 0; f < 2; ++f) {
            const int ff = 2 * l + f, p_gu = pb + (f ? 7 : 0), p_dn = p_gu + 1;
            sqp = (3 * l + (f ? 2 : 0)) & 1;
            if (EN(1) && IN(p_gu)) REP(1) {
                OPQ();
                pg8::StaticOrder S; S.init(S_, 2 * FF_, G, bid_);
                unsigned char* Hp = ws + WS_R + R_H;
                const bool ini8 = (GUI8_MASK >> ff) & 1, in8 = !ini8 && ((GU8_MASK >> ff) & 1), out8 = (DN8_MASK >> ff) & 1;
                constexpr int G8 = GU8_MASK & ~GUI8_MASK & 0xff, G16 = ~GU8_MASK & ~GUI8_MASK & 0xff;
                constexpr int MI1 = GUI8_MASK & DN8_MASK, MI0 = GUI8_MASK & ~DN8_MASK & 0xff;
                constexpr int M11 = G8 & DN8_MASK, M10 = G8 & ~DN8_MASK & 0xff, M01 = G16 & DN8_MASK, M00 = G16 & ~DN8_MASK & 0xff;
                pg8::Gemm g8{ws + WS_X8, ws + WS_WGU + (size_t)ff * SZ_WGU, S_, 2 * FF_, D_}, g16{XB, ws + WS_WGU + (size_t)ff * SZ_WGU, S_, 2 * FF_, 2 * D_};
                if (ini8 && out8) { if constexpr (MI1 != 0) { EpiSwiglu<2, true> E{Hp, SSQ, XS}; pg8::gemm_phase<EpiSwiglu<2, true>, pg8::StaticOrder, true, true, 2>(lds, g8, S, E, tid_); } }
                else if (ini8) { if constexpr (MI0 != 0) { EpiSwiglu<2, false> E{Hp, SSQ, XS}; pg8::gemm_phase<EpiSwiglu<2, false>, pg8::StaticOrder, true, true, 2>(lds, g8, S, E, tid_); } }
                else if (in8 && out8) { if constexpr (M11 != 0) { EpiSwiglu<1, true> E{Hp, SSQ, XS}; pg8::gemm_phase<EpiSwiglu<1, true>, pg8::StaticOrder, true, true, 1>(lds, g8, S, E, tid_); } }
                else if (in8) { if constexpr (M10 != 0) { EpiSwiglu<1, false> E{Hp, SSQ, XS}; pg8::gemm_phase<EpiSwiglu<1, false>, pg8::StaticOrder, true, true, 1>(lds, g8, S, E, tid_); } }
                else if (out8) { if constexpr (M01 != 0) { EpiSwiglu<0, true> E{Hp, SSQ, XS}; pg8::gemm_phase<EpiSwiglu<0, true>, pg8::StaticOrder, true, true, 0>(lds, g16, S, E, tid_); } }
                else { if constexpr (M00 != 0) { EpiSwiglu<0, false> E{Hp, SSQ, XS}; pg8::gemm_phase<EpiSwiglu<0, false>, pg8::StaticOrder, true, true, 0>(lds, g16, S, E, tid_); } }
                if (bid_ >= G / 2 && G == 256) p0_deferred_down(args, lds, ff, (bid_ - G / 2) * NWAVES + wave_, (G / 2) * NWAVES, lane_, wave_);
                else if (G != 256) p0_deferred_down(args, lds, ff, bid_ * NWAVES + wave_, G * NWAVES, lane_, wave_);
                SEAM(p_gu);
            }
            if (EN(2) && IN(p_dn)) REP(2) {
                OPQ();
                pg8::StaticOrder S; S.init(S_, D_, G, bid_);
                EpiResid<true> E{args.in[0], X, XB, ws + WS_X8, SSQ, SSQO, XS, rep_ ? 0.0f : 0.5f, (f == 0) ? (((MIX8_MASK >> l) & 1) ? 1 : 0) : (((GUI8_MASK >> (ff + 1)) & 1) ? 1 : (((GU8_MASK >> (ff + 1)) & 1) ? 2 : 0)), ff == 0, ff == 2 * DEPTH_ - 1};
                if ((DN8_MASK >> ff) & 1) { if constexpr (DN8_MASK != 0) { pg8::Gemm g{ws + WS_R + R_H, ws + WS_WD + (size_t)ff * SZ_WD, S_, D_, FF_};
                        pg8::gemm_phase<EpiResid<true>, pg8::StaticOrder, true, true, 1, true, true>(lds, g, S, E, tid_); } }
                else { if constexpr (DN8_MASK != 0xff) { pg8::Gemm g{ws + WS_R + R_H, ws + WS_WD + (size_t)ff * SZ_WD, S_, D_, 2 * FF_};
                        pg8::gemm_phase<EpiResid<true>, pg8::StaticOrder, true, true, 0, true, true>(lds, g, S, E, tid_); } }
                SEAM(p_dn);
            }
            if (f == 0) {
                sqp = (3 * l + 1) & 1;
                if ((l & 1) == 0) {
                    if (EN(3) && IN(pb + 2)) REP(3) {
                        OPQ();
                        const bool m8 = (MIX8_MASK >> l) & 1;
                        const unsigned char* Wd = ws + WS_DWIN + (size_t)j * SZ_DWIN; const int kbp = m8 ? D_ : 2 * D_;
                        const unsigned char* xa = m8 ? (const unsigned char*)(ws + WS_X8) : (const unsigned char*)XB;
                        {
                            pg8::StaticOrder S; S.init(S_, 4096, G, bid_);
                            EpiDsaIn E{(bf16*)(ws + WS_R + R_PROJ), SSQ, XS, m8};
                            pg8::Gemm g{xa, Wd, S_, 4096, kbp};
                            if (m8) { if constexpr ((MIX8_MASK & 5) != 0) pg8::gemm_phase<EpiDsaIn, pg8::StaticOrder, true, true, 2>(lds, g, S, E, tid_); }
                            else { if constexpr ((MIX8_MASK & 5) != 5) pg8::gemm_phase<EpiDsaIn, pg8::StaticOrder, true, true, 0>(lds, g, S, E, tid_); }
                        }
                        {
                            const int ntk = kbp / 128 / 8;
                            EpiDsaEx E{(float*)(ws + WS_R + R_EX), SSQ, XS, m8};
                            for (int L = bid_; L < 256; L += G) {
                                const int pm = L >> 3, sl = L & 7;
                                pg8::Gemm g{xa + (size_t)sl * ntk * 128, Wd + (size_t)16 * 256 * kbp, S_, 256, kbp, ntk};
                                pg8::SingleOrder S1{pg8::Unit{pm, sl}};
                                if (m8) { if constexpr ((MIX8_MASK & 5) != 0) pg8::gemm_phase<EpiDsaEx, pg8::SingleOrder, true, true, 2>(lds, g, S1, E, tid_); }
                                else { if constexpr ((MIX8_MASK & 5) != 5) pg8::gemm_phase<EpiDsaEx, pg8::SingleOrder, true, true, 0>(lds, g, S1, E, tid_); }
                            }
                        }
                        SEAM(pb + 2);
                    }
                    if (EN(4) && IN(pb + 3)) REP(4) { OPQ(); dsa_prep(ws, args.in[7] + j * 128, args.in[8] + j * 128, args.in[9] + j * 64, gw_, NGW, lane_); SEAM(pb + 3); }
                    if (EN(5) && IN(pb + 4)) REP(5) { OPQ(); dsa_select(ws, lds, tid_, lane_, wave_, bid_, G, (PROBE_MODE == 3) && rep_); SEAM(pb + 4); }
                    if (EN(11) && IN(pb + 5)) REP(11) { OPQ(); dsa_attend(ws, args.in[10], lds, tid_, lane_, wave_, j + 2 * rep_); SEAM(pb + 5); }
                } else {
                    if (EN(6) && IN(pb + 2)) REP(6) {
#define HW_PTRS() const bool m8 = (MIX8_MASK >> l) & 1; const unsigned char* Wb = ws + WS_HWIN + (size_t)j * SZ_HWIN; const size_t wstep = (size_t)D_ * D_ * (m8 ? 1 : 2); const float* lbp = (const float*)(ws + WS_LB) + j * D_; const void* xa = m8 ? (const void*)(ws + WS_X8) : (const void*)XB; const int kbp = m8 ? D_ : 2 * D_; (void)lbp
#define HG_CALL(EPI, SCH, S_, G_, E_) do { if (m8) { if constexpr ((MIX8_MASK & 10) != 0) pg8::gemm_phase<EPI, SCH, true, true, 2>(lds, G_, S_, E_, tid_); } else { if constexpr ((MIX8_MASK & 10) != 10) pg8::gemm_phase<EPI, SCH, true, true, false>(lds, G_, S_, E_, tid_); } } while (0)
                        { OPQ(); HW_PTRS(); pg8::StaticOrder S; S.init(S_, D_, G, bid_);
                          pg8::Gemm g{xa, Wb, S_, D_, kbp}; EpiHgrnIn<0> E{(bf16*)(ws + WS_R + R_Q), nullptr, SSQ, lbp, XS, m8};
                          HG_CALL(EpiHgrnIn<0>, pg8::StaticOrder, S, g, E); }
                        { OPQ(); HW_PTRS(); pg8::StaticOrder S; S.init(S_, D_, G, bid_);
                          pg8::Gemm g{xa, Wb + wstep, S_, D_, kbp}; EpiHgrnIn<1> E{nullptr, (float*)(ws + WS_R + R_F), SSQ, lbp, XS, m8};
                          HG_CALL(EpiHgrnIn<1>, pg8::StaticOrder, S, g, E); }
                        { OPQ(); HW_PTRS(); pg8::StaticOrder S; S.init(S_, D_, G, bid_);
                          pg8::Gemm g{xa, Wb + 2 * wstep, S_, D_, kbp}; EpiHgrnIn<2> E{(bf16*)(ws + WS_R + R_G), nullptr, SSQ, lbp, XS, m8};
                          HG_CALL(EpiHgrnIn<2>, pg8::StaticOrder, S, g, E); }
                        {
                            OPQ(); HW_PTRS();
                            pg8::StaticOrder S; S.init(D_, S_, G, bid_);
                            pg8::Unit uu;
                            LAS float* tab = (LAS float*)(lds + LDS_TAB);
                            for (int i = 0; S.next(i, uu); ++i) {
                                __syncthreads();
                                { const int row = uu.pn * 256 + (tid_ >> 1); const f32x4* p = (const f32x4*)(SSQ + (size_t)row * 32 + 16 * (tid_ & 1));
                                  const f32x4 a = p[0], b = p[1], c = p[2], d = p[3];
                                  float s = (((a[0] + a[1]) + (a[2] + a[3])) + ((b[0] + b[1]) + (b[2] + b[3]))) + (((c[0] + c[1]) + (c[2] + c[3])) + ((d[0] + d[1]) + (d[2] + d[3])));
                                  s += __shfl_xor(s, 1);
                                  if ((tid_ & 1) == 0) tab[tid_ >> 1] = __builtin_amdgcn_rsqf(s * (1.0f / D_) + EPS_) * (m8 ? __builtin_amdgcn_rcpf(XS[row] * WI8_SCALE) : 1.0f); }
                                __syncthreads();
                                pg8::Gemm g{Wb + 3 * wstep, xa, D_, S_, kbp};
                                pg8::SingleOrder S1{uu};
                                EpiHgrnVT E{(bf16*)(ws + WS_R + R_VT), tab, m8};
                                if (m8) { if constexpr ((MIX8_MASK & 10) != 0) pg8::gemm_phase<EpiHgrnVT, pg8::SingleOrder, true, true, 2, true, false>(lds, g, S1, E, tid_); }
                                else { if constexpr ((MIX8_MASK & 10) != 10) pg8::gemm_phase<EpiHgrnVT, pg8::SingleOrder, true, true, false, true, false>(lds, g, S1, E, tid_); }
                            }
                        }
                        SEAM(pb + 2);
                    }
                    if (EN(7) && IN(pb + 3)) REP(7) { OPQ(); hgrn_a2(ws, lds, tid_, lane_, wave_, bid_, G); SEAM(pb + 3); }
                    if (EN(8) && IN(pb + 4)) REP(8) { OPQ(); hgrn_b(ws, bid_ * NTHREADS + tid_, G * NTHREADS, rep_); SEAM(pb + 4); }
                    if (EN(9) && IN(pb + 5)) REP(9) { OPQ(); hgrn_c2(ws, args.in[14] + j * D_, lds, tid_, lane_, wave_, bid_, G); SEAM(pb + 5); }
                }
                if (EN(10) && IN(pb + 6)) REP(10) {
                    OPQ();
                    const bf16* Wo = (l & 1) ? (const bf16*)(ws + WS_HWO + (size_t)j * SZ_WO) : (const bf16*)(ws + WS_DWO + (size_t)j * SZ_WO);
                    pg8::Gemm g{AO, Wo, S_, D_, 2 * D_}; pg8::StaticOrder S; S.init(S_, D_, G, bid_);
                    EpiResid<false> E{args.in[0], X, XB, ws + WS_X8, SSQ, SSQO, XS, rep_ ? 0.0f : 1.0f, ((GUI8_MASK >> (2 * l + 1)) & 1) ? 1 : (((GU8_MASK >> (2 * l + 1)) & 1) ? 2 : 0), false, false};
                    pg8::gemm_phase<EpiResid<false>, pg8::StaticOrder, true, true>(lds, g, S, E, tid_);
                    SEAM(pb + 6);
                }
            }
        }
    }
#undef IN
#undef SEAM
}

extern "C" void kernel_launch(void* const* d_in, const int* in_sizes, int n_in, void* d_out, int out_size, void* d_ws, size_t ws_size, hipStream_t stream) {
    static int grid = 0;
    if (grid == 0) {
        if (n_in != 15 || in_sizes[0] != S_ * D_ || out_size != S_ * D_ || ws_size < WS_END) {
            fprintf(stderr, "kernel_launch: unexpected shapes/workspace (n_in %d, in0 %d, out %d, ws %zu, need %zu); nothing launched\n", n_in, n_in > 0 ? in_sizes[0] : -1, out_size, ws_size, (size_t)WS_END);
            grid = -1; return; }
        int dev = 0, cus = 0, per_cu = 0;
        if (hipGetDevice(&dev) != hipSuccess || hipDeviceGetAttribute(&cus, hipDeviceAttributeMultiprocessorCount, dev) != hipSuccess) { grid = -1; return; }
        if (hipFuncSetAttribute((const void*)fwd, hipFuncAttributeMaxDynamicSharedMemorySize, LDS_BYTES) != hipSuccess) { fprintf(stderr, "kernel_launch: hipFuncSetAttribute failed\n"); grid = -1; return; }
        if (hipOccupancyMaxActiveBlocksPerMultiprocessor(&per_cu, (const void*)fwd, NTHREADS, LDS_BYTES) != hipSuccess || per_cu < 1)
            fprintf(stderr, "kernel_launch: note: occupancy query reports %d workgroups per CU\n", per_cu);
        (void)hipGetLastError();
        grid = cus;
    }
    if (grid < 0) return;
    if (hipMemsetAsync((char*)d_ws + WS_CTL, 0, CTL_ZERO_BYTES, stream) != hipSuccess) return;
    Args a{};
    for (int i = 0; i < 15; ++i) a.in[i] = (const float*)d_in[i];
    a.out = (float*)d_out; a.ws = (unsigned char*)d_ws;
#if MK_ONE_LAUNCH
    a.ph_lo = 0; a.ph_hi = N_PHASE_IDS;
    hipLaunchKernelGGL(fwd, dim3(grid), dim3(NTHREADS), LDS_BYTES, stream, a);
#else
    for (int p = 0; p < N_PHASE_IDS; ++p) {
        const int r = (p - 1) % 10, l = (p - 1) / 10;
        if (p > 0) { if (r == 9) continue; }
        a.ph_lo = p; a.ph_hi = p + 1;
        hipLaunchKernelGGL(fwd, dim3(grid), dim3(NTHREADS), LDS_BYTES, stream, a);
    }
#endif
}
```

```cpp
#include <hip/hip_runtime.h>
#include <cstdio>
#include <cstdint>

#ifndef GU8_MASK
#define GU8_MASK 0xFC
#endif
#ifndef DN8_MASK
#define DN8_MASK 0xFE
#endif
#ifndef GUI8_MASK
#define GUI8_MASK 0xFF
#endif
#ifndef MIX8_MASK
#define MIX8_MASK 0xE
#endif
#ifndef MK_ONE_LAUNCH
#define MK_ONE_LAUNCH 1
#endif

namespace pg8 {
#define PG8_LAS __attribute__((address_space(3)))
typedef unsigned short bf16_t;
typedef short bf16x8 __attribute__((ext_vector_type(8)));
typedef float f32x4 __attribute__((ext_vector_type(4)));
typedef unsigned u32x4 __attribute__((ext_vector_type(4)));
constexpr int BM = 256, BK = 64, HALF = 128, HTB = HALF * BK * 2, STAGE_BYTES = 8 * HTB, NXCD = 8, WGM = 8;

__host__ __device__ __forceinline__ int lds_byte(int r, int c) { const int st = (r >> 4) * 2 + (c >> 5), rr = r & 15, cc = c & 31, ob = rr * 64 + cc * 2; return st * 1024 + (ob ^ (((ob >> 9) & 1) << 5)); }
__host__ __device__ __forceinline__ void stage_rc(int b, int& R, int& C) { const int st = b / 1024, sb = b % 1024, swz = sb ^ (((sb >> 9) & 1) << 5); R = (st >> 1) * 16 + swz / 64; C = (st & 1) * 32 + (swz % 64) / 2; }
__host__ __device__ __forceinline__ int perm32(int rho) { const int n = rho >> 4, i = rho & 15; return 8 * (i >> 2) + 4 * n + (i & 3); }

struct Unit { int pm, pn; };
struct Gemm { const void* A; const void* Bt; int M, N, KB; int ntk = 0; };

struct StaticOrder {
    int nM, nN, nwg, G, c;
    __host__ __device__ __forceinline__ void init(int M, int N, int G_, int c_) { nM = M / BM; nN = N / BM; nwg = nM * nN; G = G_; c = c_; }
    __host__ __device__ __forceinline__ bool next(int i, Unit& u) const {
        const long L = (long)i * G + c; if (L >= nwg) return false;
        int wgid = (int)L; { const int q = nwg / NXCD, r = nwg % NXCD, xcd = wgid % NXCD, off = wgid / NXCD; wgid = (xcd < r ? xcd * (q + 1) : r * (q + 1) + (xcd - r) * q) + off; }
        const int nig = WGM * nN, gid = wgid / nig, fm = gid * WGM, gsz = (nM - fm) < WGM ? (nM - fm) : WGM;
        u.pm = fm + ((wgid % nig) % gsz); u.pn = (wgid % nig) / gsz; return true;
    }
    __device__ __forceinline__ void a_ready(const Unit&) const {}
    __device__ __forceinline__ void done(const Unit&) const {}
};
struct SingleOrder {
    Unit u0;
    __device__ __forceinline__ bool next(int i, Unit& u) const { if (i != 0) return false; u = u0; return true; }
    __device__ __forceinline__ void a_ready(const Unit&) const {}
    __device__ __forceinline__ void done(const Unit&) const {}
};

typedef int i32x8 __attribute__((ext_vector_type(8)));
typedef int i32x4v __attribute__((ext_vector_type(4)));
__device__ __forceinline__ i32x8 cat8(bf16x8 lo, bf16x8 hi) { const i32x4v a = __builtin_bit_cast(i32x4v, lo), b = __builtin_bit_cast(i32x4v, hi); return (i32x8){a[0], a[1], a[2], a[3], b[0], b[1], b[2], b[3]}; }
template <class Epi, int FP8> struct FP8SC { static constexpr int A = 0, B = 0; };
template <class Epi> struct FP8SC<Epi, 1> { static constexpr int A = Epi::SCALE_A, B = Epi::SCALE_B; };
template <class Epi, class Sched, bool ALIGN_EPI = false, bool SP2 = false, int FP8 = 0, bool TA = false, bool TB = true>
__device__ __forceinline__ void gemm_phase(PG8_LAS unsigned char* lds, const Gemm g, const Sched& S, const Epi& E, const int tid) {
    const int wid = __builtin_amdgcn_readfirstlane(tid >> 6), lane = tid & 63, wr = wid >> 2, wc = wid & 3, fr = lane & 15, fq = lane >> 4;
    const int K = g.KB, nt = g.ntk ? g.ntk : K / 128;
    unsigned voffA[2], voffB[2];
#pragma unroll
    for (int i = 0; i < 2; ++i) { int R, C; stage_rc(tid * 16 + i * 8192, R, C); const int Rb = Epi::PERM ? ((R & ~31) + perm32(R & 31)) : R;
        voffA[i] = TA ? (unsigned)(R * 128 + C * 2) : (unsigned)(R * K + C * 2); voffB[i] = TB ? (unsigned)(Rb * 128 + C * 2) : (unsigned)(Rb * K + C * 2); }
    const size_t kstepA = TA ? 32768 : 128, kstepB = TB ? 32768 : 128;
    const size_t hstepA = TA ? 16384 : (size_t)HALF * K, hstepB = TB ? 16384 : (size_t)HALF * K;
    const size_t tstepA = TA ? (size_t)32768 * nt : (size_t)256 * K, tstepB = TB ? (size_t)32768 * nt : (size_t)256 * K;
    const unsigned ldsw = (unsigned)wid * 1024u;
    const int aoff = lds_byte(wr * 64 + fr, fq * 8), boff = lds_byte(wc * 32 + fr, fq * 8);
#define PG8_SA(b, h) (((b) * 2 + (h)) * HTB)
#define PG8_SB(b, h) ((4 + (b) * 2 + (h)) * HTB)
#define PG8_STAGE(bufoff, gbase, voff) do { _Pragma("unroll") for (int _i = 0; _i < 2; ++_i) \
        __builtin_amdgcn_global_load_lds((const unsigned*)((const char*)(gbase) + (voff)[_i]), (PG8_LAS unsigned*)(lds + (bufoff) + ldsw + _i * 8192), 16, 0, 0); } while (0)
#define PG8_LD8(p) __builtin_shufflevector(*(const PG8_LAS i32x4v*)(p), *(const PG8_LAS i32x4v*)((p) + 1024), 0, 1, 2, 3, 4, 5, 6, 7)
#define PG8_LDA(dst, b, h) do { _Pragma("unroll") for (int m = 0; m < 4; ++m) { if constexpr (FP8 == 1) dst##8[m] = PG8_LD8(lds + PG8_SA(b, h) + aoff + m * 2048); else { _Pragma("unroll") for (int k = 0; k < 2; ++k) dst[m][k] = *(const PG8_LAS bf16x8*)(lds + PG8_SA(b, h) + aoff + m * 2048 + k * 1024); } } } while (0)
#define PG8_LDB(dst, b, h) do { _Pragma("unroll") for (int n = 0; n < 2; ++n) { if constexpr (FP8 == 1) dst##8[n] = PG8_LD8(lds + PG8_SB(b, h) + boff + n * 2048); else { _Pragma("unroll") for (int k = 0; k < 2; ++k) dst[n][k] = *(const PG8_LAS bf16x8*)(lds + PG8_SB(b, h) + boff + n * 2048 + k * 1024); } } } while (0)
#define PG8_MMA(ai, bj, At, Bt) do { __builtin_amdgcn_s_setprio(1); _Pragma("unroll") for (int m = 0; m < 4; ++m) _Pragma("unroll") for (int n = 0; n < 2; ++n) { \
        if constexpr (FP8 == 1) asm volatile("v_mfma_scale_f32_16x16x128_f8f6f4 %0, %1, %2, %0, %3, %4 op_sel_hi:[0,0,0]" : "+v"(acc[ai][bj][m][n]) : "v"(Bt##8[n]), "v"(At##8[m]), "v"(sc_b), "v"(sc_a)); \
        else if constexpr (FP8 == 2) { _Pragma("unroll") for (int k = 0; k < 2; ++k) asm volatile("v_mfma_i32_16x16x64_i8 %0, %1, %2, %0" : "+v"(acc[ai][bj][m][n]) : "v"(Bt[n][k]), "v"(At[m][k])); } \
        else { _Pragma("unroll") for (int k = 0; k < 2; ++k) acc[ai][bj][m][n] = __builtin_amdgcn_mfma_f32_16x16x32_bf16(Bt[n][k], At[m][k], acc[ai][bj][m][n], 0, 0, 0); } } __builtin_amdgcn_s_setprio(0); } while (0)
#define PG8_WAIT_V(n) asm volatile("s_waitcnt vmcnt(" #n ")" ::: "memory")
#define PG8_WAIT_L(n) asm volatile("s_waitcnt lgkmcnt(" #n ")" ::: "memory")
#define PG8_BAR __builtin_amdgcn_s_barrier()
#define PG8_SCHED __builtin_amdgcn_sched_barrier(0)
    Unit cur, nxt; int ui = 0;
    if (!S.next(0, cur)) return;
    f32x4 acc[2][2][4][2];
#pragma unroll
    for (int a = 0; a < 2; ++a)
#pragma unroll
        for (int b = 0; b < 2; ++b)
#pragma unroll
            for (int m = 0; m < 4; ++m)
#pragma unroll
                for (int n = 0; n < 2; ++n) acc[a][b][m][n] = (f32x4){0.f, 0.f, 0.f, 0.f};
    const int sc_a = Epi::PERM ? FP8SC<Epi, FP8>::A : FP8SC<Epi, FP8>::A, sc_b = FP8SC<Epi, FP8>::B;
    bf16x8 At[4][2], B0[2][2], B1[2][2]; i32x8 At8[4], B08[2], B18[2];
    const char* cA = (const char*)g.A + (size_t)cur.pm * tstepA; const char* cB = (const char*)g.Bt + (size_t)cur.pn * tstepB;
    S.a_ready(cur);
    if constexpr (SP2) {
        PG8_STAGE(PG8_SB(0, 0), cB, voffB); PG8_STAGE(PG8_SB(0, 1), cB + hstepB, voffB); PG8_STAGE(PG8_SA(0, 0), cA, voffA); PG8_STAGE(PG8_SA(0, 1), cA + hstepA, voffA);
        if (wr == 1) PG8_BAR;
        PG8_WAIT_V(2); PG8_BAR;
        PG8_STAGE(PG8_SB(1, 0), cB + kstepB, voffB); PG8_STAGE(PG8_SA(1, 0), cA + kstepA, voffA); PG8_STAGE(PG8_SB(1, 1), cB + hstepB + kstepB, voffB);
        PG8_WAIT_V(6); PG8_BAR;
    } else {
        PG8_STAGE(PG8_SB(0, 0), cB, voffB); PG8_STAGE(PG8_SA(0, 0), cA, voffA); PG8_STAGE(PG8_SB(0, 1), cB + hstepB, voffB); PG8_STAGE(PG8_SA(0, 1), cA + hstepA, voffA);
        if (wr == 1) PG8_BAR;
        PG8_WAIT_V(4); PG8_BAR;
        PG8_STAGE(PG8_SB(1, 0), cB + kstepB, voffB); PG8_STAGE(PG8_SA(1, 0), cA + kstepA, voffA); PG8_STAGE(PG8_SB(1, 1), cB + hstepB + kstepB, voffB);
        PG8_WAIT_V(6); PG8_BAR;
    }
    for (;;) {
        const bool has_next = S.next(ui + 1, nxt);
        const char* nA = has_next ? (const char*)g.A + (size_t)nxt.pm * tstepA : cA; const char* nB = has_next ? (const char*)g.Bt + (size_t)nxt.pn * tstepB : cB;
        for (int t = 0; t < nt; t += 2) {
            const bool last = (t == nt - 2);
            const char* a1 = cA + (size_t)(t + 1) * kstepA;
            const char* a2 = last ? nA : cA + (size_t)(t + 2) * kstepA; const char* b2 = last ? nB : cB + (size_t)(t + 2) * kstepB;
            const char* a3 = a2 + kstepA; const char* b3 = b2 + kstepB;
            if (last && has_next) S.a_ready(nxt);
            if constexpr (SP2) {
            PG8_LDB(B0, 0, 0); PG8_LDB(B1, 0, 1); PG8_SCHED; PG8_LDA(At, 0, 0); PG8_STAGE(PG8_SA(1, 1), a1 + hstepA, voffA);
            PG8_WAIT_V(8); PG8_WAIT_L(0); PG8_BAR; PG8_MMA(0, 0, At, B0); PG8_MMA(0, 1, At, B1); PG8_BAR; PG8_SCHED;
            PG8_LDA(At, 0, 1); PG8_STAGE(PG8_SB(0, 0), b2, voffB); PG8_STAGE(PG8_SB(0, 1), b2 + hstepB, voffB); PG8_STAGE(PG8_SA(0, 0), a2, voffA);
            PG8_WAIT_V(8); PG8_WAIT_L(0); PG8_BAR; PG8_MMA(1, 0, At, B0); PG8_MMA(1, 1, At, B1); PG8_BAR; PG8_SCHED;
            PG8_LDB(B0, 1, 0); PG8_LDB(B1, 1, 1); PG8_SCHED; PG8_LDA(At, 1, 0); PG8_STAGE(PG8_SA(0, 1), a2 + hstepA, voffA);
            PG8_WAIT_V(8); PG8_WAIT_L(0); PG8_BAR; PG8_MMA(0, 0, At, B0); PG8_MMA(0, 1, At, B1); PG8_BAR; PG8_SCHED;
            PG8_LDA(At, 1, 1); PG8_STAGE(PG8_SB(1, 0), b3, voffB); PG8_STAGE(PG8_SB(1, 1), b3 + hstepB, voffB); PG8_STAGE(PG8_SA(1, 0), a3, voffA);
            PG8_WAIT_V(8); PG8_WAIT_L(0); PG8_BAR; PG8_MMA(1, 0, At, B0); PG8_MMA(1, 1, At, B1); PG8_BAR; PG8_SCHED;
            } else {
            PG8_LDB(B0, 0, 0); PG8_SCHED; PG8_LDA(At, 0, 0); PG8_STAGE(PG8_SA(1, 1), a1 + hstepA, voffA);
            PG8_WAIT_L(8); PG8_BAR; PG8_WAIT_L(0); PG8_MMA(0, 0, At, B0); PG8_BAR; PG8_SCHED;
            PG8_LDB(B1, 0, 1); PG8_STAGE(PG8_SB(0, 0), b2, voffB);
            PG8_BAR; PG8_WAIT_L(0); PG8_MMA(0, 1, At, B1); PG8_BAR;
            PG8_LDA(At, 0, 1); PG8_STAGE(PG8_SA(0, 0), a2, voffA);
            PG8_BAR; PG8_WAIT_L(0); PG8_MMA(1, 0, At, B0); PG8_BAR; PG8_SCHED;
            PG8_STAGE(PG8_SB(0, 1), b2 + hstepB, voffB);
            PG8_WAIT_V(6); PG8_BAR; PG8_MMA(1, 1, At, B1); PG8_BAR;
            PG8_LDB(B0, 1, 0); PG8_SCHED; PG8_LDA(At, 1, 0); PG8_STAGE(PG8_SA(0, 1), a2 + hstepA, voffA);
            PG8_WAIT_L(8); PG8_BAR; PG8_WAIT_L(0); PG8_MMA(0, 0, At, B0); PG8_BAR; PG8_SCHED;
            PG8_LDB(B1, 1, 1); PG8_STAGE(PG8_SB(1, 0), b3, voffB);
            PG8_BAR; PG8_WAIT_L(0); PG8_MMA(0, 1, At, B1); PG8_BAR;
            PG8_LDA(At, 1, 1); PG8_STAGE(PG8_SA(1, 0), a3, voffA);
            PG8_BAR; PG8_WAIT_L(0); PG8_MMA(1, 0, At, B0); PG8_BAR; PG8_SCHED;
            PG8_STAGE(PG8_SB(1, 1), b3 + hstepB, voffB);
            PG8_WAIT_V(6); PG8_BAR; PG8_MMA(1, 1, At, B1); PG8_BAR;
            }
        }
        if constexpr (ALIGN_EPI) { if (wr == 0) PG8_BAR; }
        E(acc, cur, wr, wc, fr, fq);
        if (!has_next) break;
#pragma unroll
        for (int a = 0; a < 2; ++a)
#pragma unroll
            for (int b = 0; b < 2; ++b)
#pragma unroll
                for (int m = 0; m < 4; ++m)
#pragma unroll
                    for (int n = 0; n < 2; ++n) acc[a][b][m][n] = (f32x4){0.f, 0.f, 0.f, 0.f};
        cur = nxt; cA = nA; cB = nB; ++ui;
        if constexpr (ALIGN_EPI) { if (wr == 1) PG8_BAR; }
    }
    PG8_WAIT_V(0);
    if constexpr (!ALIGN_EPI) { if (wr == 0) PG8_BAR; }
    PG8_BAR;
#undef PG8_SA
#undef PG8_SB
#undef PG8_STAGE
#undef PG8_LDA
#undef PG8_LD8
#undef PG8_LDB
#undef PG8_MMA
#undef PG8_WAIT_V
#undef PG8_WAIT_L
#undef PG8_BAR
#undef PG8_SCHED
}
}

constexpr int S_ = 8192, D_ = 2048, FF_ = 5632, DEPTH_ = 4;
constexpr int A_IN = 4176, A_IN_PAD = 4352;
constexpr int PROJ_LD = 4096;
constexpr int EX_LD = 128;
constexpr int TOPK = 256;
constexpr float EPS_ = 1e-6f;
constexpr int NWAVES = 8, NTHREADS = 512;

typedef unsigned short bf16;
typedef short bf16x8 __attribute__((ext_vector_type(8)));
typedef short s16x4 __attribute__((ext_vector_type(4)));
typedef float f32x4 __attribute__((ext_vector_type(4)));
typedef float f32x2 __attribute__((ext_vector_type(2)));
typedef float f32x16 __attribute__((ext_vector_type(16)));
typedef unsigned u32x4 __attribute__((ext_vector_type(4)));
typedef unsigned u32x2 __attribute__((ext_vector_type(2)));
typedef int i32x4 __attribute__((ext_vector_type(4)));
typedef __bf16 bf2_t __attribute__((ext_vector_type(2)));
#define LAS __attribute__((address_space(3)))
#define GAS __attribute__((address_space(1)))
#define DI __device__ __forceinline__

DI unsigned pk2(float lo, float hi) { f32x2 v = {lo, hi}; bf2_t r = __builtin_convertvector(v, bf2_t); return __builtin_bit_cast(unsigned, r); }
DI float bf_lo(unsigned w) { return __uint_as_float(w << 16); }
DI float bf_hi(unsigned w) { return __uint_as_float(w & 0xffff0000u); }
typedef _Float16 h2_t __attribute__((ext_vector_type(2)));
DI unsigned pkh2(float a, float b) { const h2_t h = {(_Float16)a, (_Float16)b}; return __builtin_bit_cast(unsigned, h); }
DI float h_lo(unsigned w) { return (float)__builtin_bit_cast(h2_t, w)[0]; }
DI float h_hi(unsigned w) { return (float)__builtin_bit_cast(h2_t, w)[1]; }
DI bf16x8 pack8(const float* v) { u32x4 w; w.x = pk2(v[0], v[1]); w.y = pk2(v[2], v[3]); w.z = pk2(v[4], v[5]); w.w = pk2(v[6], v[7]); return __builtin_bit_cast(bf16x8, w); }
DI void unpack8(u32x4 w, float* v) { v[0] = bf_lo(w.x); v[1] = bf_hi(w.x); v[2] = bf_lo(w.y); v[3] = bf_hi(w.y); v[4] = bf_lo(w.z); v[5] = bf_hi(w.z); v[6] = bf_lo(w.w); v[7] = bf_hi(w.w); }
DI float silu_f(float g) { return g * __builtin_amdgcn_rcpf(1.0f + __expf(-g)); }
DI float sigmoid_f(float g) { return __builtin_amdgcn_rcpf(1.0f + __expf(-g)); }
#define LDS_WAIT() asm volatile("s_waitcnt lgkmcnt(0)" ::: "memory")
#define MFMA32(a, b, c) __builtin_amdgcn_mfma_f32_32x32x16_bf16((a), (b), (c), 0, 0, 0)
#define MFMA16(a, b, c) __builtin_amdgcn_mfma_f32_16x16x32_bf16((a), (b), (c), 0, 0, 0)

constexpr size_t MiB = 1u << 20;
constexpr size_t WS_CTL = 0, CTL_ZERO_BYTES = 1 * MiB;
constexpr size_t WS_LB = 1 * MiB;
constexpr size_t WS_SSQ = 2 * MiB;
constexpr size_t WS_XB = 3 * MiB;
constexpr size_t WS_AO = 35 * MiB;
constexpr size_t WS_W = 67 * MiB;
constexpr size_t SZ_WGU = 44 * MiB, SZ_WD = 22 * MiB, SZ_DWIN = 17 * MiB, SZ_WO = 8 * MiB, SZ_HWIN = 32 * MiB;
constexpr size_t WS_WGU = WS_W;
constexpr size_t WS_WD = WS_WGU + 8 * SZ_WGU;
constexpr size_t WS_DWIN = WS_WD + 8 * SZ_WD;
constexpr size_t WS_DWO = WS_DWIN + 2 * SZ_DWIN;
constexpr size_t WS_HWIN = WS_DWO + 2 * SZ_WO;
constexpr size_t WS_HWO = WS_HWIN + 2 * SZ_HWIN;
constexpr size_t WS_R = WS_HWO + 2 * SZ_WO;
constexpr size_t R_H = 0;
constexpr size_t R_PROJ = 0;
constexpr size_t R_EX = 112 * MiB;
constexpr size_t R_IKN = 72 * MiB;
constexpr size_t R_IWS = 73 * MiB;
constexpr size_t R_SEL = 74 * MiB;
constexpr size_t R_Q8 = 82 * MiB;
constexpr size_t R_K8 = 98 * MiB;
constexpr size_t R_V8 = 102 * MiB;
constexpr size_t R_Q = 0;
constexpr size_t R_F = 32 * MiB;
constexpr size_t R_G = 96 * MiB;
constexpr size_t R_VT = 128 * MiB;
constexpr size_t R_BC = 160 * MiB;
constexpr size_t R_ST = 224 * MiB;
constexpr size_t R_EBL = 352 * MiB;
constexpr size_t WS_X8 = WS_R + 353 * MiB;
constexpr size_t WS_SSQ1 = WS_X8 + 16 * MiB;
constexpr size_t WS_XS = WS_SSQ1 + 1 * MiB;
constexpr size_t WS_END = WS_XS + 1 * MiB;

constexpr int CW_BAR = 4096;
constexpr int CW_WQ = 8192;

constexpr int RING_BYTES = 131072;
constexpr int LDS_AUX = RING_BYTES;
constexpr int LDS_TAB = 161792;
constexpr int LDS_MISC = 162816;
constexpr int LDS_BYTES = 163840;

#define XB_TMO      128
#define XB_XCNT(j)  (256  + 64 * (j))
#define XB_XSUB(j)  (1280 + 64 * (j))
#define XB_XGEN(j)  (2304 + 64 * (j))
#define XB_TOP      3328
#define XB_TOPGEN   3392
#define XCD_BAR_WORDS 3456
#define XB_SPIN_CAP (1u << 18)

__device__ __forceinline__ unsigned xb_ld(unsigned* p)              { return __hip_atomic_load(p, __ATOMIC_RELAXED, __HIP_MEMORY_SCOPE_AGENT); }
__device__ __forceinline__ unsigned xb_add(unsigned* p, unsigned v) { return __hip_atomic_fetch_add(p, v, __ATOMIC_RELAXED, __HIP_MEMORY_SCOPE_AGENT); }
__device__ __forceinline__ unsigned xb_xcc_id() { return (unsigned)__builtin_amdgcn_s_getreg((3 << 11) | 20) & 0xFu; }
#define XB_SPIN(cond, bar) do { unsigned _sp = 0; while (cond) { __builtin_amdgcn_s_sleep(1); \
    if ((++_sp & 255u) == 0u) { if (xb_ld(&(bar)[XB_TMO])) break; if (_sp > XB_SPIN_CAP) { atomicAdd(&(bar)[XB_TMO], 1u); break; } } } } while (0)

struct XcdBarrier {
    unsigned* bar; unsigned x;
    volatile LAS unsigned* st;
};
__device__ __forceinline__ XcdBarrier xcd_barrier_post(unsigned* bar, volatile LAS unsigned* st) {
    XcdBarrier b; b.bar = bar; b.x = xb_xcc_id(); b.st = st;
    if (threadIdx.x == 0) (void)xb_add(&bar[XB_XCNT(b.x)], 1u);
    return b;
}
__device__ __forceinline__ void xcd_barrier_complete(unsigned* bar, unsigned x, unsigned& nloc, unsigned& nx) {
    const unsigned G = gridDim.x * gridDim.y * gridDim.z;
    unsigned sum, cnt, mine, sp = 0u;
    for (;;) {
        sum = 0u; cnt = 0u; mine = 0u;
#pragma unroll
        for (unsigned j = 0; j < 16; ++j) { const unsigned c = xb_ld(&bar[XB_XCNT(j)]); sum += c; cnt += (c > 0u) ? 1u : 0u; mine = (j == x) ? c : mine; }
        if (sum == G) break;
        __builtin_amdgcn_s_sleep(1);
        if ((++sp & 255u) == 0u) { if (xb_ld(&bar[XB_TMO])) break; if (sp > XB_SPIN_CAP) { atomicAdd(&bar[XB_TMO], 1u); break; } }
    }
    nloc = mine > 0u ? mine : 1u; nx = cnt > 0u ? cnt : 1u;
}
__device__ __forceinline__ void xcd_barrier(const XcdBarrier& b) {
    asm volatile("s_waitcnt vmcnt(0)" ::: "memory");
    __syncthreads();
    if (threadIdx.x == 0) {
        unsigned* bar = b.bar;
        __builtin_amdgcn_s_waitcnt(0);
        unsigned nloc = b.st[0], nx = b.st[1];
        if (nloc == 0u) { xcd_barrier_complete(bar, b.x, nloc, nx); b.st[0] = nloc; b.st[1] = nx; }
        const unsigned old = xb_add(&bar[XB_XSUB(b.x)], 1u);
        const unsigned gen = old / nloc;
        if (old + 1u == (gen + 1u) * nloc) {
            __builtin_amdgcn_fence(__ATOMIC_RELEASE, "agent");
            asm volatile("s_waitcnt vmcnt(0)" ::: "memory");
            const unsigned og = xb_add(&bar[XB_TOP], 1u);
            const unsigned tg = og / nx;
            if (og + 1u == (tg + 1u) * nx) xb_add(&bar[XB_TOPGEN], 1u);
            else XB_SPIN(xb_ld(&bar[XB_TOPGEN]) == tg, bar);
            __builtin_amdgcn_fence(__ATOMIC_ACQUIRE, "agent");
            xb_add(&bar[XB_XGEN(b.x)], 1u);
            asm volatile("s_waitcnt vmcnt(0)" ::: "memory");
        } else {
            XB_SPIN(xb_ld(&bar[XB_XGEN(b.x)]) == gen, bar);
            __builtin_amdgcn_fence(__ATOMIC_ACQUIRE, "agent");
            asm volatile("s_waitcnt vmcnt(0)" ::: "memory");
        }
    }
    __syncthreads();
}

DI size_t tiled_off(int r, int kb, int KB) { return (size_t)(r >> 8) * ((size_t)KB * 256) + (size_t)(kb >> 7) * 32768 + (size_t)(r & 255) * 128 + (kb & 127); }
DI float load_rstd1(const float* ssq, int row, int fq) {
    const f32x4* p = (const f32x4*)(ssq + (size_t)row * 32 + 8 * fq);
    const f32x4 a = p[0], b = p[1];
    float s = ((a[0] + a[1]) + (a[2] + a[3])) + ((b[0] + b[1]) + (b[2] + b[3]));
    s += __shfl_xor(s, 16); s += __shfl_xor(s, 32);
    return __builtin_amdgcn_rsqf(s * (1.0f / D_) + EPS_);
}
#define EPI_FENCE() asm volatile("" ::: "memory")
constexpr float WI8_SCALE = 1250.0f;
template <int NB = 1> DI void row_factors8(const float* ssq, const float* XS, const bool i8, const int row0, const int fq, float (&rq)[8]) {
    __builtin_amdgcn_s_waitcnt(0);
    constexpr int GB = 8 / NB;
#pragma unroll
    for (int b0 = 0; b0 < 8; b0 += GB) {
        f32x4 pa[GB], pb[GB]; float xv[GB], sp[GB], t[GB];
#pragma unroll
        for (int gi = 0; gi < GB; ++gi) { const int row = row0 + ((b0 + gi) >> 2) * 128 + ((b0 + gi) & 3) * 16; const f32x4* p = (const f32x4*)(ssq + (size_t)row * 32 + 8 * fq); pa[gi] = p[0]; pb[gi] = p[1]; xv[gi] = XS[row]; }
        EPI_FENCE();
#pragma unroll
        for (int gi = 0; gi < GB; ++gi) sp[gi] = ((pa[gi][0] + pa[gi][1]) + (pa[gi][2] + pa[gi][3])) + ((pb[gi][0] + pb[gi][1]) + (pb[gi][2] + pb[gi][3]));
#pragma unroll
        for (int gi = 0; gi < GB; ++gi) t[gi] = __shfl_xor(sp[gi], 16);
#pragma unroll
        for (int gi = 0; gi < GB; ++gi) sp[gi] += t[gi];
#pragma unroll
        for (int gi = 0; gi < GB; ++gi) t[gi] = __shfl_xor(sp[gi], 32);
#pragma unroll
        for (int gi = 0; gi < GB; ++gi) { const float r = __builtin_amdgcn_rsqf((sp[gi] + t[gi]) * (1.0f / D_) + EPS_); rq[b0 + gi] = i8 ? r * __builtin_amdgcn_rcpf(xv[gi] * WI8_SCALE) : r; }
        EPI_FENCE();
    }
}

DI float sat8(float v) { return __builtin_amdgcn_fmed3f(v, -448.0f, 448.0f); }
DI unsigned pk4_fp8s(float a, float b, float c, float d) { int w = 0; w = __builtin_amdgcn_cvt_pk_fp8_f32(sat8(a), sat8(b), w, false); w = __builtin_amdgcn_cvt_pk_fp8_f32(sat8(c), sat8(d), w, true); return (unsigned)w; }
DI unsigned pk4_i8(float a, float b, float c, float d) {
    const unsigned ua = __float_as_uint(__builtin_amdgcn_fmed3f(a, -127.f, 127.f) + 12582912.0f), ub = __float_as_uint(__builtin_amdgcn_fmed3f(b, -127.f, 127.f) + 12582912.0f);
    const unsigned uc = __float_as_uint(__builtin_amdgcn_fmed3f(c, -127.f, 127.f) + 12582912.0f), ud = __float_as_uint(__builtin_amdgcn_fmed3f(d, -127.f, 127.f) + 12582912.0f);
    return __builtin_amdgcn_perm(ub, ua, 0x0c0c0400u) | __builtin_amdgcn_perm(ud, uc, 0x04000c0cu); }
constexpr int SC_ONE = 0x7f7f7f7f;
constexpr int SC_W64 = 0x79797979;
constexpr int SC_H8 = 0x7c7c7c7c;

template <int IN8, bool OUT8> struct EpiSwiglu {
    static constexpr bool PERM = true; static constexpr int SCALE_A = SC_ONE, SCALE_B = SC_W64;
    unsigned char* H; const float* ssq; const float* XS;
    DI void operator()(const f32x4 (&acc)[2][2][4][2], const pg8::Unit& u, int wr, int wc, int fr_in, int fq_in) const {
        int fr = fr_in, fq = fq_in; asm volatile("" : "+v"(fr), "+v"(fq));
        const int row0 = u.pm * 256 + wr * 64 + fr;
        const int col0 = u.pn * 128 + wc * 32 + 8 * fq;
        float rqa[8];
        row_factors8(ssq, XS, IN8 == 2, row0, fq, rqa);
#pragma unroll
        for (int ai = 0; ai < 2; ++ai)
#pragma unroll
            for (int m = 0; m < 4; ++m) {
                const int row = row0 + ai * 128 + m * 16;
                const float rq = rqa[ai * 4 + m];
                const float rq_e = rq * -1.4426950408889634f, rq_h = rq * rq * (OUT8 ? 8.0f : 1.0f);
                float h[8];
#pragma unroll
                for (int n = 0; n < 2; ++n)
#pragma unroll
                    for (int e = 0; e < 4; ++e) {
                        const float ag = (IN8 == 2) ? (float)__float_as_int(acc[ai][0][m][n][e]) : acc[ai][0][m][n][e];
                        const float au = (IN8 == 2) ? (float)__float_as_int(acc[ai][1][m][n][e]) : acc[ai][1][m][n][e];
                        const float sg = __builtin_amdgcn_rcpf(1.0f + __builtin_amdgcn_exp2f(ag * rq_e));
                        h[4 * n + e] = (ag * au) * rq_h * sg; }
                if constexpr (OUT8) { u32x2 w; w.x = pk4_fp8s(h[0], h[1], h[2], h[3]); w.y = pk4_fp8s(h[4], h[5], h[6], h[7]); *(u32x2*)(H + tiled_off(row, col0, FF_)) = w; }
                else *(bf16x8*)(H + tiled_off(row, 2 * col0, 2 * FF_)) = pack8(h);
                EPI_FENCE();
            }
    }
};

constexpr float XI8_CLIP = 5.0f;
template <bool F8> struct EpiResid {
    static constexpr bool PERM = true; static constexpr int SCALE_A = SC_H8, SCALE_B = SC_W64;
    const float* base32; float* out32; bf16* XB; unsigned char* X8; const float* ssq_old; float* ssq; float* XS; float coef; int x8i; bool first, last;
    DI void operator()(const f32x4 (&acc)[2][2][4][2], const pg8::Unit& u, int wr, int wc, int fr_in, int fq_in) const {
        int fr = fr_in, fq = fq_in; asm volatile("" : "+v"(fr), "+v"(fq));
        const int row0 = u.pm * 256 + wr * 64 + fr, col0 = u.pn * 256 + wc * 32 + 8 * fq;
        float xsa[8];
        if (x8i == 1) {
            row_factors8<2>(ssq_old, ssq_old, false, row0, fq, xsa);
#pragma unroll
            for (int gi = 0; gi < 8; ++gi) { xsa[gi] *= (127.0f / XI8_CLIP); if (u.pn == 0 && wc == 0 && fq == 0) XS[row0 + (gi >> 2) * 128 + (gi & 3) * 16] = xsa[gi]; }
        } else {
            __builtin_amdgcn_s_waitcnt(0);
#pragma unroll
            for (int gi = 0; gi < 8; ++gi) xsa[gi] = 0.f;
        }
        f32x4 bq[2][2]; u32x4 bw[2];
#define RES_LOADB(gi_) do { const int row_ = row0 + ((gi_) >> 2) * 128 + ((gi_) & 3) * 16; \
            if (first) { _Pragma("unroll") for (int bj = 0; bj < 2; ++bj) _Pragma("unroll") for (int n = 0; n < 2; ++n) bq[bj][n] = *(const f32x4*)(base32 + (size_t)row_ * D_ + col0 + bj * 128 + n * 4); } \
            else { _Pragma("unroll") for (int bj = 0; bj < 2; ++bj) bw[bj] = *(const u32x4*)(XB + (size_t)row_ * D_ + col0 + bj * 128); } } while (0)
        RES_LOADB(0);
#pragma unroll
        for (int ai = 0; ai < 2; ++ai)
#pragma unroll
            for (int m = 0; m < 4; ++m) {
                const int gi = ai * 4 + m;
                const int row = row0 + ai * 128 + m * 16; float s = 0.f;
                const float xs = xsa[gi];
                f32x4 b[2][2];
#pragma unroll
                for (int bj = 0; bj < 2; ++bj) {
                    const f32x4 lo_ = {bf_lo(bw[bj].x), bf_hi(bw[bj].x), bf_lo(bw[bj].y), bf_hi(bw[bj].y)}; const f32x4 hi_ = {bf_lo(bw[bj].z), bf_hi(bw[bj].z), bf_lo(bw[bj].w), bf_hi(bw[bj].w)};
                    b[bj][0] = first ? bq[bj][0] : lo_; b[bj][1] = first ? bq[bj][1] : hi_; }
                EPI_FENCE();
                if (gi < 7) RES_LOADB(gi + 1);
                EPI_FENCE();
#pragma unroll
                for (int bj = 0; bj < 2; ++bj) {
                    const size_t off = (size_t)row * D_ + col0 + bj * 128;
                    const f32x4 v0 = b[bj][0] + coef * acc[ai][bj][m][0], v1 = b[bj][1] + coef * acc[ai][bj][m][1];
                    if (last) { *(f32x4*)(out32 + off) = v0; *(f32x4*)(out32 + off + 4) = v1; }
                    else { u32x4 w; w.x = pk2(v0[0], v0[1]); w.y = pk2(v0[2], v0[3]); w.z = pk2(v1[0], v1[1]); w.w = pk2(v1[2], v1[3]); *(u32x4*)(XB + off) = w; }
                    if (x8i != 0) { u32x2 q;
                        q.x = (x8i == 1) ? pk4_i8(v0[0] * xs, v0[1] * xs, v0[2] * xs, v0[3] * xs) : pk4_fp8s(v0[0], v0[1], v0[2], v0[3]);
                        q.y = (x8i == 1) ? pk4_i8(v1[0] * xs, v1[1] * xs, v1[2] * xs, v1[3] * xs) : pk4_fp8s(v1[0], v1[1], v1[2], v1[3]);
                        *(u32x2*)(X8 + off) = q; }
                    s += ((v0[0] * v0[0] + v0[1] * v0[1]) + (v0[2] * v0[2] + v0[3] * v0[3])) + ((v1[0] * v1[0] + v1[1] * v1[1]) + (v1[2] * v1[2] + v1[3] * v1[3]));
                }
                s += __shfl_xor(s, 16); s += __shfl_xor(s, 32);
                if (fq == 0) ssq[(size_t)row * 32 + u.pn * 4 + wc] = s;
                EPI_FENCE();
            }
#undef RES_LOADB
    }
};

DI f32x4 acc_f(const f32x4 a, const bool i8) { f32x4 o;
#pragma unroll
    for (int e = 0; e < 4; ++e) o[e] = i8 ? (float)__float_as_int(a[e]) : a[e];
    return o; }
struct EpiDsaEx {
    static constexpr bool PERM = true; static constexpr int SCALE_A = SC_ONE, SCALE_B = SC_W64;
    float* EXP; const float* ssq; const float* XS; bool i8;
    DI void operator()(const f32x4 (&acc)[2][2][4][2], const pg8::Unit& u, int wr, int wc, int fr_in, int fq_in) const {
        int fr = fr_in, fq = fq_in; asm volatile("" : "+v"(fr), "+v"(fq));
        const int row0 = u.pm * 256 + wr * 64 + fr, col0 = wc * 32 + 8 * fq;
        float rqa[8]; row_factors8<2>(ssq, XS, i8, row0, fq, rqa);
#pragma unroll
        for (int ai = 0; ai < 2; ++ai)
#pragma unroll
            for (int m = 0; m < 4; ++m) {
                const int row = row0 + ai * 128 + m * 16;
                const float r = rqa[ai * 4 + m];
                float* p = EXP + ((size_t)u.pn * S_ + row) * EX_LD + col0;
                *(f32x4*)p = acc_f(acc[ai][0][m][0], i8) * r; *(f32x4*)(p + 4) = acc_f(acc[ai][0][m][1], i8) * r;
                EPI_FENCE();
            }
    }
};
struct EpiDsaIn {
    static constexpr bool PERM = true; static constexpr int SCALE_A = SC_ONE, SCALE_B = SC_W64;
    bf16* PROJ; const float* ssq; const float* XS; bool i8;
    DI void operator()(const f32x4 (&acc)[2][2][4][2], const pg8::Unit& u, int wr, int wc, int fr_in, int fq_in) const {
        int fr = fr_in, fq = fq_in; asm volatile("" : "+v"(fr), "+v"(fq));
        const int row0 = u.pm * 256 + wr * 64 + fr;
        const int col0 = u.pn * 256 + wc * 32 + 8 * fq;
        float rqa[8]; row_factors8<2>(ssq, XS, i8, row0, fq, rqa);
#pragma unroll
        for (int ai = 0; ai < 2; ++ai)
#pragma unroll
            for (int m = 0; m < 4; ++m) {
                const int row = row0 + ai * 128 + m * 16;
                const float r = rqa[ai * 4 + m];
#pragma unroll
                for (int bj = 0; bj < 2; ++bj) {
                    const f32x4 v0 = acc_f(acc[ai][bj][m][0], i8) * r, v1 = acc_f(acc[ai][bj][m][1], i8) * r;
                    float h[8] = {v0[0], v0[1], v0[2], v0[3], v1[0], v1[1], v1[2], v1[3]};
                    *(bf16x8*)(PROJ + (size_t)row * PROJ_LD + col0 + bj * 128) = pack8(h);
                }
                EPI_FENCE();
            }
    }
};

template <int T> struct EpiHgrnIn {
    static constexpr bool PERM = true; static constexpr int SCALE_A = SC_ONE, SCALE_B = SC_W64;
    bf16* O; float* F; const float* ssq; const float* lb; const float* XS; bool i8;
    DI void operator()(const f32x4 (&acc)[2][2][4][2], const pg8::Unit& u, int wr, int wc, int fr_in, int fq_in) const {
        int fr = fr_in, fq = fq_in; asm volatile("" : "+v"(fr), "+v"(fq));
        const int row0 = u.pm * 256 + wr * 64 + fr;
        const int col0 = u.pn * 256 + wc * 32 + 8 * fq;
        float rqa[8]; row_factors8<2>(ssq, XS, i8, row0, fq, rqa);
#pragma unroll
        for (int ai = 0; ai < 2; ++ai)
#pragma unroll
            for (int m = 0; m < 4; ++m) {
                const int row = row0 + ai * 128 + m * 16;
                const float r = rqa[ai * 4 + m];
#pragma unroll
                for (int bj = 0; bj < 2; ++bj) {
                    float v[8]; const f32x4 a0 = acc_f(acc[ai][bj][m][0], i8), a1 = acc_f(acc[ai][bj][m][1], i8);
#pragma unroll
                    for (int e = 0; e < 4; ++e) { v[e] = a0[e] * r; v[4 + e] = a1[e] * r; }
                    const int col = col0 + bj * 128;
                    if constexpr (T == 1) {
                        const f32x4 l0 = *(const f32x4*)(lb + col), l1 = *(const f32x4*)(lb + col + 4);
                        float kq[8];
#pragma unroll
                        for (int e = 0; e < 4; ++e) { kq[e] = (1.0f - l0[e]) * sigmoid_f(-v[e]); kq[4 + e] = (1.0f - l1[e]) * sigmoid_f(-v[4 + e]); }
                        u32x4 w; w.x = pkh2(kq[0], kq[1]); w.y = pkh2(kq[2], kq[3]); w.z = pkh2(kq[4], kq[5]); w.w = pkh2(kq[6], kq[7]);
                        *(u32x4*)((unsigned short*)F + (size_t)row * D_ + col) = w;
                    } else {
#pragma unroll
                        for (int e = 0; e < 8; ++e) v[e] = (T == 0) ? v[e] * 0.08838834764831845f : silu_f(v[e]);
                        *(bf16x8*)(O + (size_t)row * D_ + col) = pack8(v);
                    }
                }
                EPI_FENCE();
            }
    }
};

struct EpiHgrnVT {
    static constexpr bool PERM = true; static constexpr int SCALE_A = SC_W64, SCALE_B = SC_ONE;
    bf16* VT; const LAS float* tab; bool i8;
    DI void operator()(const f32x4 (&acc)[2][2][4][2], const pg8::Unit& u, int wr, int wc, int fr_in, int fq_in) const {
        int fr = fr_in, fq = fq_in; asm volatile("" : "+v"(fr), "+v"(fq));
        const int row0 = u.pm * 256 + wr * 64 + fr, cl = wc * 32 + 8 * fq;
#pragma unroll
        for (int bj = 0; bj < 2; ++bj) {
            const f32x4 r0 = *(const LAS f32x4*)(tab + cl + bj * 128), r1 = *(const LAS f32x4*)(tab + cl + bj * 128 + 4);
#pragma unroll
            for (int ai = 0; ai < 2; ++ai)
#pragma unroll
                for (int m = 0; m < 4; ++m) {
                    float h[8];
                    const f32x4 a0 = acc_f(acc[ai][bj][m][0], i8), a1 = acc_f(acc[ai][bj][m][1], i8);
#pragma unroll
                    for (int e = 0; e < 4; ++e) { h[e] = a0[e] * r0[e]; h[4 + e] = a1[e] * r1[e]; }
                    *(bf16x8*)(VT + (size_t)(row0 + ai * 128 + m * 16) * S_ + u.pn * 256 + cl + bj * 128) = pack8(h);
                }
        }
    }
};

DI float wave_sum(float v) {
#pragma unroll
    for (int o = 1; o < 64; o <<= 1) v += __shfl_xor(v, o);
    return v;
}
template <int MAP> DI int map_row(int n) {
    if (MAP == 1) return 256 * (n >> 7) + (n & 127);
    if (MAP == 2) return 256 * (n >> 7) + (n & 127) + 128;
    if (MAP == 3) return n < 4096 ? n : (n < 6144 ? n + 2048 : n - 2048);
    return n;
}
constexpr int P0_PITCH = 66;
template <int MAP, int F8> DI void cvt_tile(const float* __restrict__ W, int ldw, int ncols, const float* __restrict__ gain, unsigned char* __restrict__ WT, int K, int n0, int k0, int lane, LAS unsigned short* scr) {
    constexpr int KT = F8 ? 128 : 64;
    const int q = lane & 15, kr = lane >> 4;
    int nc = n0 + 4 * q; nc = nc < ncols - 4 ? nc : ncols - 4;
    const float* src = W + (size_t)(k0 + kr) * ldw + nc;
    const float gs = F8 == 1 ? 64.0f : (F8 == 2 ? WI8_SCALE : 1.0f);
#pragma unroll
    for (int h = 0; h < KT / 64; ++h) {
        f32x4 v[16];
#pragma unroll
        for (int i = 0; i < 16; ++i) v[i] = __builtin_nontemporal_load((const f32x4*)(src + (size_t)(64 * h + 4 * i) * ldw));
#pragma unroll
        for (int i = 0; i < 16; ++i) {
            const int k = 64 * h + 4 * i + kr;
            const float gk = gain ? gain[k0 + k] * gs : gs;
            LAS unsigned* d = (LAS unsigned*)(scr + k * P0_PITCH + 4 * q);
            d[0] = pk2(v[i][0] * gk, v[i][1] * gk); d[1] = pk2(v[i][2] * gk, v[i][3] * gk);
        }
    }
    LDS_WAIT();
    const int nl = lane >> 3, c = lane & 7;
#pragma unroll
    for (int jj = 0; jj < 8; ++jj) {
        const int n = 8 * jj + nl;
        const int row = map_row<MAP>(n0 + n);
        if constexpr (F8) {
            const LAS unsigned short* sp = scr + (16 * c) * P0_PITCH + n;
            float f[16];
#pragma unroll
            for (int i = 0; i < 16; ++i) f[i] = __uint_as_float((unsigned)sp[i * P0_PITCH] << 16);
            u32x4 o;
            if constexpr (F8 == 2) { o.x = pk4_i8(f[0], f[1], f[2], f[3]); o.y = pk4_i8(f[4], f[5], f[6], f[7]); o.z = pk4_i8(f[8], f[9], f[10], f[11]); o.w = pk4_i8(f[12], f[13], f[14], f[15]); }
            else { o.x = pk4_fp8s(f[0], f[1], f[2], f[3]); o.y = pk4_fp8s(f[4], f[5], f[6], f[7]); o.z = pk4_fp8s(f[8], f[9], f[10], f[11]); o.w = pk4_fp8s(f[12], f[13], f[14], f[15]); }
            *(u32x4*)(WT + tiled_off(row, k0 + 16 * c, K)) = o;
        } else {
            const LAS unsigned short* sp = scr + (8 * c) * P0_PITCH + n;
            unsigned e[8];
#pragma unroll
            for (int i = 0; i < 8; ++i) e[i] = sp[i * P0_PITCH];
            u32x4 o; o.x = e[0] | (e[1] << 16); o.y = e[2] | (e[3] << 16); o.z = e[4] | (e[5] << 16); o.w = e[6] | (e[7] << 16);
            *(u32x4*)(WT + tiled_off(row, (k0 + 8 * c) * 2, K * 2)) = o;
        }
    }
    LDS_WAIT();
}

struct Args {
    const float* in[15]; float* out; unsigned char* ws; int ph_lo, ph_hi;
};

constexpr int DEF8 = 1024, DEF16 = 2048;
DI void p0_deferred_down(const Args& a, LAS unsigned char* lds, int f, int widx, int nw, int lane, int wave) {
    LAS unsigned short* scr = (LAS unsigned short*)(lds + wave * 17408);
    const bool f8 = ((DN8_MASK >> f) & 1) != 0;
    const int cnt = f8 ? 1408 : 2816, def = f8 ? DEF8 : DEF16;
    const float* W = a.in[4] + (size_t)f * FF_ * D_; unsigned char* WT = a.ws + WS_WD + (size_t)f * SZ_WD;
    for (int r = cnt - def + widx; r < cnt; r += nw) {
        const int kb = r / 32, nb = r % 32;
        if (f8) cvt_tile<0, 1>(W, D_, D_, nullptr, WT, FF_, nb * 64, kb * 128, lane, scr);
        else cvt_tile<0, 0>(W, D_, D_, nullptr, WT, FF_, nb * 64, kb * 64, lane, scr);
    }
}
DI void p0_prologue(const Args& a, LAS unsigned char* lds, int gw, int NGW, int lane, int wave) {
    unsigned char* ws = a.ws;
    const float* ng = a.in[1];
    LAS unsigned short* scr = (LAS unsigned short*)(lds + wave * 17408);
    constexpr int NT_DIN = 66 * 32, NT_O = 32 * 32, NT_HIN = 128 * 32;
    int n_ffn = 0;
#pragma unroll
    for (int m = 0; m < 24; ++m) { const bool f8m = ((((m >> 3) < 2 ? (GU8_MASK | GUI8_MASK) : DN8_MASK) >> (m & 7)) & 1) != 0; n_ffn += (f8m ? 1408 : 2816) - ((m >> 3) == 2 ? (f8m ? DEF8 : DEF16) : 0); }
    const int NITEMS = n_ffn + 2 * (NT_DIN + NT_O + NT_HIN + NT_O);
    for (int it = gw; it < NITEMS; it += NGW) {
        int r = it;
        if (r < n_ffn) {
            int m = 0; bool f8 = false;
            for (; m < 24; ++m) { f8 = ((((m >> 3) < 2 ? (GU8_MASK | GUI8_MASK) : DN8_MASK) >> (m & 7)) & 1) != 0; const int cnt = (f8 ? 1408 : 2816) - ((m >> 3) == 2 ? (f8 ? DEF8 : DEF16) : 0); if (r < cnt) break; r -= cnt; }
            const int f = m & 7, kind = m >> 3;
            if (kind < 2) {
                const int kb = r / 88, nb = r % 88;
                const float* W = a.in[2 + kind] + (size_t)f * D_ * FF_;
                const float* gain = ng + (size_t)((f >> 1) * 3 + ((f & 1) ? 2 : 0)) * D_;
                unsigned char* WT = ws + WS_WGU + (size_t)f * SZ_WGU;
                if (f8 && ((GUI8_MASK >> f) & 1)) { if (kind == 0) cvt_tile<1, 2>(W, FF_, FF_, gain, WT, D_, nb * 64, kb * 128, lane, scr); else cvt_tile<2, 2>(W, FF_, FF_, gain, WT, D_, nb * 64, kb * 128, lane, scr); }
                else if (f8) { if (kind == 0) cvt_tile<1, 1>(W, FF_, FF_, gain, WT, D_, nb * 64, kb * 128, lane, scr); else cvt_tile<2, 1>(W, FF_, FF_, gain, WT, D_, nb * 64, kb * 128, lane, scr); }
                else { if (kind == 0) cvt_tile<1, 0>(W, FF_, FF_, gain, WT, D_, nb * 64, kb * 64, lane, scr); else cvt_tile<2, 0>(W, FF_, FF_, gain, WT, D_, nb * 64, kb * 64, lane, scr); }
            } else {
                const int kb = r / 32, nb = r % 32;
                const float* W = a.in[4] + (size_t)f * FF_ * D_; unsigned char* WT = ws + WS_WD + (size_t)f * SZ_WD;
                if (f8) cvt_tile<0, 1>(W, D_, D_, nullptr, WT, FF_, nb * 64, kb * 128, lane, scr);
                else cvt_tile<0, 0>(W, D_, D_, nullptr, WT, FF_, nb * 64, kb * 64, lane, scr);
            }
            continue;
        }
        r -= n_ffn;
        if (r < 2 * NT_DIN) { const int j = r / NT_DIN; r %= NT_DIN; const int kb = r / 66, nb = r % 66;
            if ((MIX8_MASK >> (2 * j)) & 1) { if ((kb & 1) == 0) cvt_tile<0, 2>(a.in[5] + (size_t)j * D_ * A_IN, A_IN, A_IN, ng + (size_t)((2 * j) * 3 + 1) * D_, ws + WS_DWIN + (size_t)j * SZ_DWIN, D_, nb * 64, kb * 64, lane, scr); }
            else cvt_tile<0, 0>(a.in[5] + (size_t)j * D_ * A_IN, A_IN, A_IN, ng + (size_t)((2 * j) * 3 + 1) * D_, ws + WS_DWIN + (size_t)j * SZ_DWIN, D_, nb * 64, kb * 64, lane, scr);
            continue; }
        r -= 2 * NT_DIN;
        if (r < 2 * NT_O) { const int j = r / NT_O; r %= NT_O; const int kb = r / 32, nb = r % 32;
            cvt_tile<0, 0>(a.in[6] + (size_t)j * D_ * D_, D_, D_, nullptr, ws + WS_DWO + (size_t)j * SZ_WO, D_, nb * 64, kb * 64, lane, scr); continue; }
        r -= 2 * NT_O;
        if (r < 2 * NT_HIN) { const int j = r / NT_HIN; r %= NT_HIN; const int kb = r / 128, nb = r % 128;
            if ((MIX8_MASK >> (2 * j + 1)) & 1) { if ((kb & 1) == 0) cvt_tile<3, 2>(a.in[11] + (size_t)j * D_ * 4 * D_, 4 * D_, 4 * D_, ng + (size_t)((2 * j + 1) * 3 + 1) * D_, ws + WS_HWIN + (size_t)j * SZ_HWIN, D_, nb * 64, kb * 64, lane, scr); }
            else cvt_tile<3, 0>(a.in[11] + (size_t)j * D_ * 4 * D_, 4 * D_, 4 * D_, ng + (size_t)((2 * j + 1) * 3 + 1) * D_, ws + WS_HWIN + (size_t)j * SZ_HWIN, D_, nb * 64, kb * 64, lane, scr);
            continue; }
        r -= 2 * NT_HIN;
        { const int j = r / NT_O; r %= NT_O; const int kb = r / 32, nb = r % 32;
            cvt_tile<0, 0>(a.in[12] + (size_t)j * D_ * D_, D_, D_, nullptr, ws + WS_HWO + (size_t)j * SZ_WO, D_, nb * 64, kb * 64, lane, scr); }
    }
    const float* x = a.in[0]; bf16* XB = (bf16*)(ws + WS_XB); float* ssq = (float*)(ws + WS_SSQ); float* XS = (float*)(ws + WS_XS);
    for (int m = gw; m < S_; m += NGW) {
        const f32x4* xr = (const f32x4*)(x + (size_t)m * D_) + lane; float s = 0.f;
        u32x2* o8 = (u32x2*)(XB + (size_t)m * D_) + lane; unsigned* o4 = (unsigned*)(ws + WS_X8 + (size_t)m * D_) + lane;
        f32x4 v[8];
#pragma unroll
        for (int j = 0; j < 8; ++j) { v[j] = xr[64 * j]; s += (v[j][0] * v[j][0] + v[j][1] * v[j][1]) + (v[j][2] * v[j][2] + v[j][3] * v[j][3]); }
        s = wave_sum(s);
        const float xs = __builtin_amdgcn_rsqf(s * (1.0f / D_) + EPS_) * (127.0f / XI8_CLIP);
#pragma unroll
        for (int j = 0; j < 8; ++j) {
            if (((GUI8_MASK | GU8_MASK) & 1) == 0) { u32x2 w; w.x = pk2(v[j][0], v[j][1]); w.y = pk2(v[j][2], v[j][3]); o8[64 * j] = w; }
            else o4[64 * j] = (GUI8_MASK & 1) ? pk4_i8(v[j][0] * xs, v[j][1] * xs, v[j][2] * xs, v[j][3] * xs) : pk4_fp8s(v[j][0], v[j][1], v[j][2], v[j][3]); }
        if (lane < 32) ssq[(size_t)m * 32 + lane] = (lane == 0) ? s : 0.f;
        if (lane == 0) XS[m] = xs;
    }
    const float* lg = a.in[13]; float* LB = (float*)(ws + WS_LB);
    for (int c = gw * 64 + lane; c < D_; c += NGW * 64) {
        const float l0 = lg[c], l1 = lg[D_ + c], l2 = lg[2 * D_ + c], l3 = lg[3 * D_ + c];
        const float mx = fmaxf(fmaxf(l0, l1), fmaxf(l2, l3));
        const float e0 = expf(l0 - mx), e1 = expf(l1 - mx), e2 = expf(l2 - mx), e3 = expf(l3 - mx), inv = 1.0f / (e0 + e1 + e2 + e3);
        LB[c] = e1 * inv; LB[D_ + c] = (e1 + e2 + e3) * inv;
    }
}

DI unsigned pk4_fp8(float a, float b, float c, float d) { int w = 0; w = __builtin_amdgcn_cvt_pk_fp8_f32(a, b, w, false); w = __builtin_amdgcn_cvt_pk_fp8_f32(c, d, w, true); return (unsigned)w; }
DI void dsa_prep(unsigned char* ws, const float* qg, const float* kg, const float* ikg, int gw, int NGW, int lane) {
    const bf16* PROJ = (const bf16*)(ws + WS_R + R_PROJ); const float* EX = (const float*)(ws + WS_R + R_EX);
    bf16* IKN = (bf16*)(ws + WS_R + R_IKN); float* IWS = (float*)(ws + WS_R + R_IWS);
    unsigned char* Q8 = ws + WS_R + R_Q8; unsigned char* K8 = ws + WS_R + R_K8; unsigned char* V8 = ws + WS_R + R_V8;
    for (int t = gw; t < S_; t += NGW) {
        const bf16* row = PROJ + (size_t)t * PROJ_LD;
        {
            u32x4 w[4]; float v[32]; float s = 0.f;
#pragma unroll
            for (int i = 0; i < 4; ++i) { w[i] = *(const u32x4*)(row + lane * 32 + 8 * i); unpack8(w[i], v + 8 * i); }
#pragma unroll
            for (int i = 0; i < 32; ++i) s += v[i] * v[i];
            s += __shfl_xor(s, 1); s += __shfl_xor(s, 2);
            const float r = __builtin_amdgcn_rsqf(s * (1.0f / 128.0f) + EPS_);
            const int d0 = (lane & 3) * 32;
#pragma unroll
            for (int i = 0; i < 32; ++i) v[i] = v[i] * r * qg[d0 + i];
#pragma unroll
            for (int i = 0; i < 2; ++i) { u32x4 o; o.x = pk4_fp8(v[16 * i], v[16 * i + 1], v[16 * i + 2], v[16 * i + 3]); o.y = pk4_fp8(v[16 * i + 4], v[16 * i + 5], v[16 * i + 6], v[16 * i + 7]);
                o.z = pk4_fp8(v[16 * i + 8], v[16 * i + 9], v[16 * i + 10], v[16 * i + 11]); o.w = pk4_fp8(v[16 * i + 12], v[16 * i + 13], v[16 * i + 14], v[16 * i + 15]);
                *(u32x4*)(Q8 + (size_t)t * 2048 + lane * 32 + 16 * i) = o; }
        }
        {
            float v[8]; float s = 0.f; unpack8(*(const u32x4*)(row + 2048 + lane * 8), v);
#pragma unroll
            for (int i = 0; i < 8; ++i) s += v[i] * v[i];
            s += __shfl_xor(s, 1); s += __shfl_xor(s, 2); s += __shfl_xor(s, 4); s += __shfl_xor(s, 8);
            const float r = __builtin_amdgcn_rsqf(s * (1.0f / 128.0f) + EPS_);
            const int d0 = (lane & 15) * 8;
#pragma unroll
            for (int i = 0; i < 8; ++i) v[i] = v[i] * r * kg[d0 + i];
            u32x2 o; o.x = pk4_fp8(v[0], v[1], v[2], v[3]); o.y = pk4_fp8(v[4], v[5], v[6], v[7]);
            *(u32x2*)(K8 + (size_t)t * 512 + lane * 8) = o;
        }
        {
            float v[8]; unpack8(*(const u32x4*)(row + 2560 + lane * 8), v);
            u32x2 o; o.x = pk4_fp8(v[0], v[1], v[2], v[3]); o.y = pk4_fp8(v[4], v[5], v[6], v[7]);
            *(u32x2*)(V8 + (size_t)t * 512 + lane * 8) = o;
        }
        {
            float v = 0.f, wv = 0.f;
#pragma unroll
            for (int sl = 0; sl < 8; ++sl) { const float* ex = EX + ((size_t)sl * S_ + t) * EX_LD; v += ex[lane]; if (lane < 16) wv += ex[64 + lane]; }
            const float s = wave_sum(v * v);
            const float r = __builtin_amdgcn_rsqf(s * (1.0f / 64.0f) + EPS_);
            const float o = v * r * ikg[lane]; const float o2 = __shfl_xor(o, 1);
            if ((lane & 1) == 0) *(unsigned*)(IKN + (size_t)(t >> 5) * 2048 + (lane >> 4) * 512 + ((lane >> 3) & 1) * 256 + (t & 31) * 8 + (lane & 7)) = pk2(o, o2);
            if (lane < 16) IWS[(size_t)t * 16 + lane] = wv * 0.03125f;
        }
    }
}

DI unsigned okey(float f) { const unsigned u = __float_as_uint(f); return (u & 0x80000000u) ? ~u : (u | 0x80000000u); }

DI unsigned short okey16(float f) { const _Float16 h = (_Float16)f; const unsigned short u = __builtin_bit_cast(unsigned short, h); return (unsigned short)((u & 0x8000u) ? ~u : (u | 0x8000u)); }
constexpr int HCOPY = 2;
DI void digit_search(LAS unsigned* hist, unsigned need, int lane, unsigned& dig, unsigned& nn) {
    unsigned c[4]; unsigned s4 = 0u;
#pragma unroll
    for (int i = 0; i < 4; ++i) { c[i] = 0u;
#pragma unroll
        for (int k = 0; k < HCOPY; ++k) c[i] += hist[(255 - (4 * lane + i)) * HCOPY + k];
        s4 += c[i]; }
    unsigned incl = s4;
#pragma unroll
    for (int d = 1; d < 64; d <<= 1) { const unsigned x = __shfl_up(incl, d); if (lane >= d) incl += x; }
    const unsigned excl = incl - s4;
    const bool hit = excl < need && need <= incl;
    unsigned run = excl, dd = 0u, n2 = 0u; bool found = false;
#pragma unroll
    for (int i = 0; i < 4; ++i) { if (!found && run + c[i] >= need) { dd = 255u - (unsigned)(4 * lane + i); n2 = need - run; found = true; } run += c[i]; }
    const unsigned long long hb = __ballot(hit);
    const int src = hb ? (__ffsll((long long)hb) - 1) : 0;
    dig = (unsigned)__builtin_amdgcn_readlane((int)dd, src); nn = (unsigned)__builtin_amdgcn_readlane((int)n2, src);
}
DI float relu_i(float x) { const int xi = __builtin_bit_cast(int, x); return __builtin_bit_cast(float, xi > 0 ? xi : 0); }
DI void dsa_select(unsigned char* ws, LAS unsigned char* lds, int tid, int lane, int wave, int bid, int G, int score_only) {
    const bf16* PROJ = (const bf16*)(ws + WS_R + R_PROJ); const bf16* IKN = (const bf16*)(ws + WS_R + R_IKN); const float* IWS = (const float*)(ws + WS_R + R_IWS);
    int* SELG = (int*)(ws + WS_R + R_SEL);
    LAS unsigned short* SC = (LAS unsigned short*)lds;
    LAS unsigned* HIST = (LAS unsigned*)(lds + LDS_AUX);
    for (int wi = bid; wi < S_ / 8; wi += G) {
        const int rr = wi >> 8, ww = wi & 255, u = (rr << 8) + ((rr & 1) ? 255 - ww : ww);
        const int t0 = 8 * u;
        {
            const int rho = lane & 31, hf = lane >> 5, qq = (rho >> 2) & 1, hh = (rho & 3) + 4 * (rho >> 3);
            bf16x8 afr[4][4];
#pragma unroll
            for (int rt = 0; rt < 4; ++rt)
#pragma unroll
                for (int ks = 0; ks < 4; ++ks) afr[rt][ks] = *(const bf16x8*)(PROJ + (size_t)(t0 + 2 * rt + qq) * PROJ_LD + 3072 + hh * 64 + 16 * ks + 8 * hf);
            f32x4 wv[4][4];
#pragma unroll
            for (int rt = 0; rt < 4; ++rt)
#pragma unroll
                for (int i4 = 0; i4 < 4; ++i4) wv[rt][i4] = *(const f32x4*)(IWS + (size_t)(t0 + 2 * rt + hf) * 16 + 4 * i4);
            const int ntiles = (t0 + 8 + 31) >> 5;
            const bf16* ikb = IKN + lane * 8;
            bf16x8 b0[4], b1[4], b2[4];
#define SEL_LOADB(B, KT) do { int k_ = (KT); k_ = k_ < ntiles ? k_ : ntiles - 1; _Pragma("unroll") for (int ks = 0; ks < 4; ++ks) B[ks] = *(const bf16x8*)(ikb + (size_t)k_ * 2048 + ks * 512); } while (0)
#define SEL_FMA(S, W, R) asm("v_fma_f32 %0, %1, %2, %0" : "+v"(S) : "v"(W), "v"(R))
#define SEL_TILE(B, KT) do { const int key = 32 * (KT) + (lane & 31); float sc4[4]; \
                _Pragma("unroll") for (int rt = 0; rt < 4; ++rt) { f32x16 acc; \
                    _Pragma("unroll") for (int i = 0; i < 16; ++i) acc[i] = 0.f; \
                    _Pragma("unroll") for (int ks = 0; ks < 4; ++ks) acc = MFMA32(afr[rt][ks], B[ks], acc); \
                    float s0 = 0.f, s1 = 0.f; \
                    _Pragma("unroll") for (int i4 = 0; i4 < 4; ++i4) { \
                        SEL_FMA(s0, wv[rt][i4][0], relu_i(acc[4 * i4])); SEL_FMA(s1, wv[rt][i4][1], relu_i(acc[4 * i4 + 1])); \
                        SEL_FMA(s0, wv[rt][i4][2], relu_i(acc[4 * i4 + 2])); SEL_FMA(s1, wv[rt][i4][3], relu_i(acc[4 * i4 + 3])); } \
                    sc4[rt] = s0 + s1; } \
                _Pragma("unroll") for (int rt = 0; rt < 4; ++rt) SC[(2 * rt + hf) * 8192 + key] = okey16(sc4[rt]); } while (0)
            EPI_FENCE();
            SEL_LOADB(b0, wave); EPI_FENCE(); SEL_LOADB(b1, wave + 8); EPI_FENCE(); SEL_LOADB(b2, wave + 16); EPI_FENCE();
            int kt = wave;
            for (; kt + 16 < ntiles; kt += 24) {
                SEL_TILE(b0, kt); EPI_FENCE(); SEL_LOADB(b0, kt + 24); EPI_FENCE();
                SEL_TILE(b1, kt + 8); EPI_FENCE(); SEL_LOADB(b1, kt + 32); EPI_FENCE();
                SEL_TILE(b2, kt + 16); EPI_FENCE(); SEL_LOADB(b2, kt + 40); EPI_FENCE();
            }
            if (kt < ntiles) { SEL_TILE(b0, kt); EPI_FENCE(); if (kt + 8 < ntiles) { SEL_TILE(b1, kt + 8); } }
        }
        __syncthreads();
        if (!score_only) {
            const int t = t0 + wave, n = t + 1;
            LAS unsigned short* sc = SC + wave * 8192; LAS unsigned* hist = HIST + wave * 256 * HCOPY; LAS unsigned* histc = hist + (lane & (HCOPY - 1));
            const LAS unsigned* sc2 = (const LAS unsigned*)sc;
            int* selg = SELG + (size_t)t * TOPK;
            if (n <= TOPK) {
#pragma unroll
                for (int i = 0; i < 4; ++i) { const int p = lane + 64 * i; selg[p] = p < n ? p : 0; }
            } else {
                const int nw2 = (n + 1) >> 1;
#pragma unroll
                for (int i = 0; i < 4 * HCOPY; ++i) hist[lane + 64 * i] = 0u;
                for (int i0 = 0; i0 < nw2; i0 += 64) { const int i = i0 + lane; if (i < nw2) { const unsigned wd = sc2[i];
                        __hip_atomic_fetch_add(&histc[((wd >> 8) & 255u) * HCOPY], 1u, __ATOMIC_RELAXED, __HIP_MEMORY_SCOPE_WORKGROUP);
                        if (2 * i + 1 < n) __hip_atomic_fetch_add(&histc[(wd >> 24) * HCOPY], 1u, __ATOMIC_RELAXED, __HIP_MEMORY_SCOPE_WORKGROUP); } }
                LDS_WAIT();
                unsigned dA, need; digit_search(hist, TOPK, lane, dA, need);
#pragma unroll
                for (int i = 0; i < 4 * HCOPY; ++i) hist[lane + 64 * i] = 0u;
                for (int i0 = 0; i0 < nw2; i0 += 64) { const int i = i0 + lane; if (i < nw2) { const unsigned wd = sc2[i];
                        if (((wd >> 8) & 255u) == dA) __hip_atomic_fetch_add(&histc[(wd & 255u) * HCOPY], 1u, __ATOMIC_RELAXED, __HIP_MEMORY_SCOPE_WORKGROUP);
                        if (2 * i + 1 < n && (wd >> 24) == dA) __hip_atomic_fetch_add(&histc[((wd >> 16) & 255u) * HCOPY], 1u, __ATOMIC_RELAXED, __HIP_MEMORY_SCOPE_WORKGROUP); } }
                LDS_WAIT();
                unsigned dB, need_eq; digit_search(hist, need, lane, dB, need_eq);
                const unsigned T = (dA << 8) | dB;
                unsigned goff = 0u, eoff = 0u; const unsigned gtot = TOPK - need_eq;
                LAS int* rowb = (LAS int*)(lds + LDS_AUX + 8192 * HCOPY) + wave * 256;
                const unsigned long long ltm = (1ull << lane) - 1ull;
                for (int i0 = 0; i0 < nw2; i0 += 64) { const int i = i0 + lane; const bool v0 = i < nw2, v1 = v0 && (2 * i + 1 < n); const unsigned wd = v0 ? sc2[i] : 0u;
                    const unsigned k0 = wd & 0xffffu, k1 = wd >> 16;
                    const bool g0 = v0 && k0 > T, g1 = v1 && k1 > T, e0 = v0 && k0 == T, e1 = v1 && k1 == T;
                    const unsigned long long bg0 = __ballot(g0), bg1 = __ballot(g1), be0 = __ballot(e0), be1 = __ballot(e1);
                    const unsigned pg = goff + (unsigned)__popcll(bg0 & ltm) + (unsigned)__popcll(bg1 & ltm);
                    if (g0) rowb[pg] = 2 * i;
                    if (g1) rowb[pg + (g0 ? 1u : 0u)] = 2 * i + 1;
                    const unsigned pe = eoff + (unsigned)__popcll(be0 & ltm) + (unsigned)__popcll(be1 & ltm);
                    if (e0 && pe < need_eq) rowb[gtot + pe] = 2 * i;
                    if (e1 && pe + (e0 ? 1u : 0u) < need_eq) rowb[gtot + pe + (e0 ? 1u : 0u)] = 2 * i + 1;
                    goff += (unsigned)__popcll(bg0) + (unsigned)__popcll(bg1); eoff += (unsigned)__popcll(be0) + (unsigned)__popcll(be1); }
                LDS_WAIT();
                *(i32x4*)(selg + 4 * lane) = *(const LAS i32x4*)(rowb + 4 * lane);
            }
        }
        __syncthreads();
    }
}

DI bf16x8 tr_read2(unsigned a0, unsigned a1) {
    s16x4 lo, hi;
    asm volatile("ds_read_b64_tr_b16 %0, %2\n\tds_read_b64_tr_b16 %1, %3\n\ts_waitcnt lgkmcnt(0)" : "=&v"(lo), "=&v"(hi) : "v"(a0), "v"(a1) : "memory");
    return (bf16x8){lo[0], lo[1], lo[2], lo[3], hi[0], hi[1], hi[2], hi[3]};
}
DI void dsa_attend(unsigned char* ws, const float* relb, LAS unsigned char* lds, int tid, int lane, int wave, int jl) {
    const unsigned char* Q8 = ws + WS_R + R_Q8; const unsigned char* K8 = ws + WS_R + R_K8; const unsigned char* V8 = ws + WS_R + R_V8;
    const int* SELG = (const int*)(ws + WS_R + R_SEL);
    bf16* AO = (bf16*)(ws + WS_AO);
    unsigned* wq = (unsigned*)(ws + WS_CTL) + CW_WQ + 256 * jl;
    LAS int* SELL = (LAS int*)lds;
    LAS unsigned char* VBUF = lds + 8192;
    LAS float* BIAS = (LAS float*)(lds + 8192 + 131072);
    for (int i = tid; i < 129 * 16; i += NTHREADS) { const int d = i >> 4; int b = d; if (d >= 16) { b = 16 + (int)(logf((float)d * (1.0f / 16.0f)) / 2.0794415416798357f * 16.0f); b = b < 31 ? b : 31; }
        BIAS[i] = relb[b * 16 + (i & 15)]; }
    __syncthreads();
    LAS int* sel = SELL + wave * 256; LAS unsigned char* vbuf = VBUF + wave * 16384;
    const int g = lane & 15, kg = lane >> 4;
    LAS int* selg = sel + g; LAS int* selk = sel + 4 * kg;
    const int vrow = lane >> 3;
    LAS int* selv = sel + vrow;
    const int tq = (lane & 15) >> 2, tp = lane & 3;
    const int j0 = (int)(xb_xcc_id() >> 1) & 3;
    for (int dj = 0; dj < 4; ++dj) {
        const int j = (j0 + dj) & 3;
        const int hcol = 4 * j + (g & 3);
        const unsigned char* Vb = V8 + j * 128;
        for (;;) {
            unsigned it = 0u;
            if (lane == 0) it = __hip_atomic_fetch_add(wq + 64 * j, 1u, __ATOMIC_RELAXED, __HIP_MEMORY_SCOPE_AGENT);
            it = (unsigned)__builtin_amdgcn_readfirstlane((int)it);
            if (it >= (unsigned)S_) break;
            const int t = (int)it, cnt = (t + 1) < TOPK ? (t + 1) : TOPK;
            *(LAS i32x4*)(sel + 4 * lane) = *(const i32x4*)(SELG + (size_t)t * TOPK + 4 * lane);
            u32x4 qf[2];
#pragma unroll
            for (int p = 0; p < 2; ++p) qf[p] = *(const u32x4*)(Q8 + (size_t)t * 2048 + hcol * 128 + 64 * p + 16 * kg);
            LDS_WAIT();
#define ATT_VIDX(S, c) do { _Pragma("unroll") for (int m_ = 0; m_ < 8; ++m_) S[m_] = selv[64 * (c) + 8 * m_] & 8191; } while (0)
#define ATT_VDMA(S, bufi) do { _Pragma("unroll") for (int m_ = 0; m_ < 8; ++m_) { const int row_ = 8 * m_ + vrow; \
                const int ch_ = (lane & 7) ^ (((row_ >> 1) & 3) << 1); \
                __builtin_amdgcn_global_load_lds((const unsigned*)(Vb + (size_t)S[m_] * 512 + 16 * ch_), (LAS unsigned*)(vbuf + (bufi) * 8192 + m_ * 1024), 16, 0, 0); } } while (0)
            int vs0[8], vs1[8], ksel[16];
            ATT_VIDX(vs0, 0); ATT_VIDX(vs1, 1);
#pragma unroll
            for (int i = 0; i < 16; ++i) ksel[i] = selg[16 * i] & 8191;
            ATT_VDMA(vs0, 0); ATT_VDMA(vs1, 1);
            __builtin_amdgcn_s_waitcnt(0xC07F);
            __builtin_amdgcn_sched_barrier(0);
            f32x4 lg[16];
            const unsigned char* Kb = K8 + j * 128 + 16 * kg;
            u32x4 kb[8][2];
#pragma unroll
            for (int i = 0; i < 8; ++i) { const unsigned char* kp = Kb + (size_t)ksel[i] * 512;
#pragma unroll
                for (int p = 0; p < 2; ++p) kb[i][p] = *(const u32x4*)(kp + 64 * p); }
            __builtin_amdgcn_sched_barrier(0);
#pragma unroll
            for (int kt = 0; kt < 16; ++kt) {
                f32x4 a4 = {0.f, 0.f, 0.f, 0.f};
#pragma unroll
                for (int p = 0; p < 2; ++p) {
                    const u32x4 kk = kb[kt & 7][p];
                    const long a0 = (long)(((unsigned long long)kk.y << 32) | kk.x), a1 = (long)(((unsigned long long)kk.w << 32) | kk.z);
                    const long b0 = (long)(((unsigned long long)qf[p].y << 32) | qf[p].x), b1 = (long)(((unsigned long long)qf[p].w << 32) | qf[p].z);
                    a4 = __builtin_amdgcn_mfma_f32_16x16x32_fp8_fp8(a0, b0, a4, 0, 0, 0);
                    a4 = __builtin_amdgcn_mfma_f32_16x16x32_fp8_fp8(a1, b1, a4, 0, 0, 0);
                }
                lg[kt] = a4;
                if (kt + 8 < 16) { const unsigned char* kp = Kb + (size_t)ksel[kt + 8] * 512;
#pragma unroll
                    for (int p = 0; p < 2; ++p) kb[kt & 7][p] = *(const u32x4*)(kp + 64 * p); }
                __builtin_amdgcn_sched_barrier(0);
            }
            const int cq = g >> 2;
            float mx = -INFINITY;
            const int cntk = cnt - 4 * kg;
            float pw[4][4];
#pragma unroll
            for (int i = 0; i < 4; ++i) {
                f32x4 lgi = (cq == 0) ? lg[i] : (cq == 1) ? lg[4 + i] : (cq == 2) ? lg[8 + i] : lg[12 + i];
                const int kt = 4 * cq + i;
                const i32x4 s4 = *(const LAS i32x4*)(selk + 16 * kt);
#pragma unroll
                for (int r = 0; r < 4; ++r) {
                    int dist = t - s4[r]; dist = dist < 0 ? 0 : (dist > 128 ? 128 : dist);
                    float v = lgi[r] * 0.08838834764831845f + BIAS[dist * 16 + hcol];
                    v = (16 * kt + r < cntk) ? v : -INFINITY;
                    pw[i][r] = v; mx = fmaxf(mx, v);
                }
            }
            mx = fmaxf(mx, __shfl_xor(mx, 4)); mx = fmaxf(mx, __shfl_xor(mx, 8)); mx = fmaxf(mx, __shfl_xor(mx, 16)); mx = fmaxf(mx, __shfl_xor(mx, 32));
            float sum = 0.f;
#pragma unroll
            for (int i = 0; i < 4; ++i)
#pragma unroll
                for (int r = 0; r < 4; ++r) { const float e = __expf(pw[i][r] - mx); pw[i][r] = e; sum += e; }
            sum += __shfl_xor(sum, 4); sum += __shfl_xor(sum, 8); sum += __shfl_xor(sum, 16); sum += __shfl_xor(sum, 32);
            const float inv = __builtin_amdgcn_rcpf(sum) * 128.0f;
            const unsigned pA0 = pk4_fp8(pw[0][0] * inv, pw[0][1] * inv, pw[0][2] * inv, pw[0][3] * inv), pB0 = pk4_fp8(pw[1][0] * inv, pw[1][1] * inv, pw[1][2] * inv, pw[1][3] * inv);
            const unsigned pA1 = pk4_fp8(pw[2][0] * inv, pw[2][1] * inv, pw[2][2] * inv, pw[2][3] * inv), pB1 = pk4_fp8(pw[3][0] * inv, pw[3][1] * inv, pw[3][2] * inv, pw[3][3] * inv);
            f32x4 o[8];
#pragma unroll
            for (int dt = 0; dt < 8; ++dt) o[dt] = (f32x4){0.f, 0.f, 0.f, 0.f};
#pragma unroll
            for (int c = 0; c < 4; ++c) {
                if (c < 3) asm volatile("s_waitcnt vmcnt(8)" ::: "memory"); else asm volatile("s_waitcnt vmcnt(0)" ::: "memory");
                const unsigned base = (unsigned)(size_t)(vbuf + (c & 1) * 8192);
#pragma unroll
                for (int s2 = 0; s2 < 2; ++s2) {
                    const int ks = 2 * c + s2;
                    const int rA = 32 * s2 + 4 * kg + tq, rB = rA + 16;
                    const bool mine = (ks >> 1) == cq;
                    const unsigned pa = mine ? ((ks & 1) ? pA1 : pA0) : 0u, pb = mine ? ((ks & 1) ? pB1 : pB0) : 0u;
                    const long pf = (long)(((unsigned long long)pb << 32) | pa);
                    u32x2 vl[4], vh[4];
#pragma unroll
                    for (int mp = 0; mp < 4; ++mp) {
                        const unsigned a0 = base + 128u * rA + 16u * ((2 * mp + (tp >> 1)) ^ (((rA >> 1) & 3) << 1)) + 8u * (tp & 1);
                        const unsigned a1 = base + 128u * rB + 16u * ((2 * mp + (tp >> 1)) ^ (((rB >> 1) & 3) << 1)) + 8u * (tp & 1);
                        asm volatile("ds_read_b64_tr_b16 %0, %2\n\tds_read_b64_tr_b16 %1, %3" : "=&v"(vl[mp]), "=&v"(vh[mp]) : "v"(a0), "v"(a1) : "memory");
                    }
                    asm volatile("s_waitcnt lgkmcnt(0)" : "+v"(vl[0]), "+v"(vl[1]), "+v"(vl[2]), "+v"(vl[3]), "+v"(vh[0]), "+v"(vh[1]), "+v"(vh[2]), "+v"(vh[3]) :: "memory");
#pragma unroll
                    for (int mp = 0; mp < 4; ++mp) {
                        const unsigned e0 = __builtin_amdgcn_perm(vl[mp].y, vl[mp].x, 0x06040200u), e1 = __builtin_amdgcn_perm(vh[mp].y, vh[mp].x, 0x06040200u);
                        const unsigned o0 = __builtin_amdgcn_perm(vl[mp].y, vl[mp].x, 0x07050301u), o1 = __builtin_amdgcn_perm(vh[mp].y, vh[mp].x, 0x07050301u);
                        const long fe = (long)(((unsigned long long)e1 << 32) | e0), fo = (long)(((unsigned long long)o1 << 32) | o0);
                        o[2 * mp] = __builtin_amdgcn_mfma_f32_16x16x32_fp8_fp8(fe, pf, o[2 * mp], 0, 0, 0);
                        o[2 * mp + 1] = __builtin_amdgcn_mfma_f32_16x16x32_fp8_fp8(fo, pf, o[2 * mp + 1], 0, 0, 0);
                    }
                }
                if (c + 2 < 4) { int vsn[8]; ATT_VIDX(vsn, c + 2); ATT_VDMA(vsn, c & 1); }
            }
#undef ATT_VDMA
#undef ATT_VIDX
#pragma unroll
            for (int dt = 0; dt < 8; ++dt)
#pragma unroll
                for (int r = 0; r < 4; ++r) { float x = o[dt][r];
                    x += __builtin_bit_cast(float, __builtin_amdgcn_update_dpp(0, __builtin_bit_cast(int, x), 0x128, 0xf, 0xf, false));
                    x += __builtin_bit_cast(float, __builtin_amdgcn_update_dpp(0, __builtin_bit_cast(int, x), 0x124, 0xf, 0xf, false)); o[dt][r] = x; }
            if (g < 4) {
#pragma unroll
                for (int mp = 0; mp < 4; ++mp) { const f32x4 ev = o[2 * mp] * (1.0f / 128.0f), ov = o[2 * mp + 1] * (1.0f / 128.0f);
                    const float h8[8] = {ev[0], ov[0], ev[1], ov[1], ev[2], ov[2], ev[3], ov[3]};
                    *(bf16x8*)(AO + (size_t)t * D_ + (4 * j + g) * 128 + 32 * mp + 8 * kg) = pack8(h8); }
            }
            LDS_WAIT();
        }
    }
}

DI void hgrn_a(unsigned char* ws, int lane, int wave, int bid, int G) {
    const float* F = (const float*)(ws + WS_R + R_F); const bf16* VT = (const bf16*)(ws + WS_R + R_VT);
    float* BC = (float*)(ws + WS_R + R_BC); unsigned char* STB = ws + WS_R + R_ST; float* EBL = (float*)(ws + WS_R + R_EBL);
    const int u2 = wave >> 2, dt = wave & 3, dl = lane & 31, hf = lane >> 5;
    for (int U = bid * 2 + u2; U < 2048; U += 2 * G) {
        const int c = U >> 4, h = U & 15, d = h * 128 + dt * 32 + dl;
        float b[4][8], kd[4][8], tot[4];
#pragma unroll
        for (int i = 0; i < 4; ++i) {
            float run = 0.f;
#pragma unroll
            for (int jj = 0; jj < 8; ++jj) { const float f = F[(size_t)(c * 64 + 8 * (2 * i + hf) + jj) * D_ + d]; kd[i][jj] = 1.0f - f; run += logf(f); b[i][jj] = run; }
            tot[i] = run;
        }
        float pre = 0.f;
#pragma unroll
        for (int i = 0; i < 4; ++i) {
            const float pt = __shfl_xor(tot[i], 32);
            const float mypre = pre + (hf ? pt : 0.f);
#pragma unroll
            for (int jj = 0; jj < 8; ++jj) b[i][jj] += mypre;
            pre += tot[i] + pt;
        }
        const float blast = pre;
#pragma unroll
        for (int i = 0; i < 4; ++i)
#pragma unroll
            for (int jj = 0; jj < 8; ++jj) { BC[(size_t)(c * 64 + 8 * (2 * i + hf) + jj) * D_ + d] = b[i][jj]; kd[i][jj] *= __expf(blast - b[i][jj]); }
        if (hf == 0) EBL[(size_t)U * 128 + dt * 32 + dl] = __expf(blast);
        f32x16 acc[4];
#pragma unroll
        for (int et = 0; et < 4; ++et)
#pragma unroll
            for (int i = 0; i < 16; ++i) acc[et][i] = 0.f;
#pragma unroll
        for (int ks = 0; ks < 4; ++ks) {
            const bf16x8 bfr = pack8(kd[ks]);
#pragma unroll
            for (int et = 0; et < 4; ++et) {
                const bf16x8 afr = *(const bf16x8*)(VT + (size_t)(h * 128 + et * 32 + dl) * S_ + c * 64 + 16 * ks + 8 * hf);
                acc[et] = MFMA32(bfr, afr, acc[et]);
            }
        }
#pragma unroll
        for (int et = 0; et < 4; ++et)
#pragma unroll
            for (int s2 = 0; s2 < 2; ++s2) {
                float v[8];
#pragma unroll
                for (int i = 0; i < 8; ++i) v[i] = acc[et][8 * s2 + i];
                *(bf16x8*)(STB + (((size_t)U * 4 + et) * 8 + 2 * dt + s2) * 1024 + lane * 16) = pack8(v);
            }
    }
}
DI void hgrn_b(unsigned char* ws, int gtid, int nthreads, int dummy) {
    unsigned char* STB = ws + WS_R + R_ST; const float* EBL = (const float*)(ws + WS_R + R_EBL);
    for (int p = gtid; p < 131072; p += nthreads) {
        const int h = p >> 13, rem = p & 8191, ks = (rem >> 8) & 7, ln = (rem >> 2) & 63, wsel = rem & 3;
        const int d0 = 16 * ks + 8 * (wsel >> 1) + 4 * (ln >> 5) + 2 * (wsel & 1);
        float r0 = 0.f, r1 = 0.f;
#pragma unroll 8
        for (int c = 0; c < 128; ++c) {
            unsigned* ptr = (unsigned*)(STB + (size_t)(c * 16 + h) * 32768 + (size_t)rem * 4);
            const unsigned loc = *ptr; const f32x2 eb = *(const f32x2*)(EBL + (size_t)(c * 16 + h) * 128 + d0);
            *ptr = dummy ? loc : pk2(r0, r1);
            r0 = r0 * eb[0] + bf_lo(loc); r1 = r1 * eb[1] + bf_hi(loc);
        }
    }
}
DI void hgrn_c(unsigned char* ws, const float* ogain, int lane, int wave, int bid, int NG) {
    const bf16* Q = (const bf16*)(ws + WS_R + R_Q); const float* F = (const float*)(ws + WS_R + R_F); const bf16* G = (const bf16*)(ws + WS_R + R_G);
    const bf16* VT = (const bf16*)(ws + WS_R + R_VT); const float* BC = (const float*)(ws + WS_R + R_BC); const unsigned char* STB = ws + WS_R + R_ST;
    bf16* AO = (bf16*)(ws + WS_AO);
    const int u4 = wave >> 1, tt = wave & 1, tl = lane & 31, hf = lane >> 5;
    for (int U = bid * 4 + u4; U < 2048; U += 4 * NG) {
        const int c = U >> 4, h = U & 15, t = c * 64 + tt * 32 + tl;
        const size_t cb = (size_t)h * 128 + 4 * hf;
        bf16x8 qt[8];
        const bf16* qrow = Q + (size_t)t * D_ + cb; const float* brow = BC + (size_t)t * D_ + cb; const float* b31 = BC + (size_t)(c * 64 + 31) * D_ + cb;
#pragma unroll
        for (int ks = 0; ks < 8; ++ks) {
            const u32x2 qa = *(const u32x2*)(qrow + 16 * ks), qb2 = *(const u32x2*)(qrow + 16 * ks + 8);
            const float q[8] = {bf_lo(qa.x), bf_hi(qa.x), bf_lo(qa.y), bf_hi(qa.y), bf_lo(qb2.x), bf_hi(qb2.x), bf_lo(qb2.y), bf_hi(qb2.y)};
            const f32x4 b0 = *(const f32x4*)(brow + 16 * ks), b1 = *(const f32x4*)(brow + 16 * ks + 8);
            float v[8];
#pragma unroll
            for (int e = 0; e < 4; ++e) { v[e] = q[e] * __expf(b0[e]); v[4 + e] = q[4 + e] * __expf(b1[e]); }
            qt[ks] = pack8(v);
        }
        f32x16 acc[4];
#pragma unroll
        for (int et = 0; et < 4; ++et)
#pragma unroll
            for (int i = 0; i < 16; ++i) acc[et][i] = 0.f;
#pragma unroll
        for (int ks = 0; ks < 8; ++ks) {
#pragma unroll
            for (int et = 0; et < 4; ++et) {
                const bf16x8 sf = *(const bf16x8*)(STB + (((size_t)U * 4 + et) * 8 + ks) * 1024 + lane * 16);
                acc[et] = MFMA32(sf, qt[ks], acc[et]);
            }
            if ((ks & 3) == 3) asm volatile("" ::: "memory");
        }
        for (int st = 0; st <= tt; ++st) {
            const int sa = c * 64 + st * 32 + tl;
            const float* frow = F + (size_t)sa * D_ + cb; const float* srow = BC + (size_t)sa * D_ + cb;
            f32x16 X;
#pragma unroll
            for (int i = 0; i < 16; ++i) X[i] = 0.f;
#pragma unroll
            for (int ks = 0; ks < 8; ++ks) {
                const f32x4 f0 = *(const f32x4*)(frow + 16 * ks), f1 = *(const f32x4*)(frow + 16 * ks + 8);
                const f32x4 b0 = *(const f32x4*)(srow + 16 * ks), b1 = *(const f32x4*)(srow + 16 * ks + 8);
                f32x4 c0 = {0.f, 0.f, 0.f, 0.f}, c1 = {0.f, 0.f, 0.f, 0.f};
                bf16x8 qb = qt[ks];
                if (st == 1) {
                    c0 = *(const f32x4*)(b31 + 16 * ks); c1 = *(const f32x4*)(b31 + 16 * ks + 8);
                    const u32x2 qa = *(const u32x2*)(qrow + 16 * ks), qb2 = *(const u32x2*)(qrow + 16 * ks + 8);
                    const float q[8] = {bf_lo(qa.x), bf_hi(qa.x), bf_lo(qa.y), bf_hi(qa.y), bf_lo(qb2.x), bf_hi(qb2.x), bf_lo(qb2.y), bf_hi(qb2.y)};
                    const f32x4 t0 = *(const f32x4*)(brow + 16 * ks), t1 = *(const f32x4*)(brow + 16 * ks + 8);
                    float w[8];
#pragma unroll
                    for (int e = 0; e < 4; ++e) { w[e] = q[e] * __expf(t0[e] - c0[e]); w[4 + e] = q[4 + e] * __expf(t1[e] - c1[e]); }
                    qb = pack8(w);
                }
                float v[8];
#pragma unroll
                for (int e = 0; e < 4; ++e) { v[e] = (1.0f - f0[e]) * __expf(c0[e] - b0[e]); v[4 + e] = (1.0f - f1[e]) * __expf(c1[e] - b1[e]); }
                X = MFMA32(pack8(v), qb, X);
                if (ks & 1) asm volatile("" ::: "memory");
            }
            if (st == tt) {
#pragma unroll
                for (int r = 0; r < 16; ++r) { const int sl = (r & 3) + 8 * (r >> 2) + 4 * hf; X[r] = (sl <= tl) ? X[r] : 0.f; }
            }
#pragma unroll
            for (int kp = 0; kp < 2; ++kp) {
                float xv[8];
#pragma unroll
                for (int i = 0; i < 8; ++i) xv[i] = X[8 * kp + i];
                const bf16x8 xb = pack8(xv);
#pragma unroll
                for (int et = 0; et < 4; ++et) {
                    const bf16* vp = VT + (size_t)(h * 128 + et * 32 + tl) * S_ + c * 64 + st * 32 + 16 * kp + 4 * hf;
                    const s16x4 lo = *(const s16x4*)vp, hi = *(const s16x4*)(vp + 8);
                    const bf16x8 vf = {lo[0], lo[1], lo[2], lo[3], hi[0], hi[1], hi[2], hi[3]};
                    acc[et] = MFMA32(vf, xb, acc[et]);
                }
            }
        }
        float ss = 0.f;
#pragma unroll
        for (int et = 0; et < 4; ++et)
#pragma unroll
            for (int i = 0; i < 16; ++i) ss += acc[et][i] * acc[et][i];
        ss += __shfl_xor(ss, 32);
        const float rstd = __builtin_amdgcn_rsqf(ss * (1.0f / 128.0f) + EPS_);
#pragma unroll
        for (int et = 0; et < 4; ++et)
#pragma unroll
            for (int rq = 0; rq < 4; ++rq) {
                const int e0 = h * 128 + et * 32 + 8 * rq + 4 * hf;
                const f32x4 og = *(const f32x4*)(ogain + e0);
                const u32x2 gw = *(const u32x2*)(G + (size_t)t * D_ + e0);
                const float g0 = bf_lo(gw.x), g1 = bf_hi(gw.x), g2 = bf_lo(gw.y), g3 = bf_hi(gw.y);
                u32x2 w;
                w.x = pk2(acc[et][4 * rq] * rstd * og[0] * g0, acc[et][4 * rq + 1] * rstd * og[1] * g1);
                w.y = pk2(acc[et][4 * rq + 2] * rstd * og[2] * g2, acc[et][4 * rq + 3] * rstd * og[3] * g3);
                *(u32x2*)(AO + (size_t)t * D_ + e0) = w;
            }
    }
}

DI void hgrn_a2(unsigned char* ws, LAS unsigned char* lds, int tid, int lane, int wave, int bid, int NG) {
    const unsigned short* K1 = (const unsigned short*)(ws + WS_R + R_F); const bf16* VT = (const bf16*)(ws + WS_R + R_VT);
    unsigned short* BC = (unsigned short*)(ws + WS_R + R_BC); unsigned char* STB = ws + WS_R + R_ST; float* EBL = (float*)(ws + WS_R + R_EBL);
    constexpr int BLK = 1040;
    LAS unsigned char* Ft = lds;
    LAS float* QT = (LAS float*)(lds + 32 * BLK);
    LAS unsigned char* KDT = lds + 32 * BLK + 2048;
    LAS unsigned char* BCT = lds + 65536;
    const int d = tid & 127, tq = tid >> 7;
    const int dt = wave & 3, ep = wave >> 2, dl = lane & 31, hf = lane >> 5;
#define A2_STAGE(U_) do { const int c_ = (U_) >> 4, h_ = (U_) & 15; \
        _Pragma("unroll") for (int i_ = 0; i_ < 2; ++i_) { const int m_ = wave * 2 + i_; \
            __builtin_amdgcn_global_load_lds((const unsigned*)(K1 + (size_t)(c_ * 64 + 4 * m_ + (lane >> 4)) * D_ + h_ * 128 + (lane & 15) * 8), (LAS unsigned*)(Ft + m_ * BLK), 16, 0, 0); } } while (0)
    int U = bid;
    if (U < 2048) A2_STAGE(U);
    for (; U < 2048; U += NG) {
        const int c = U >> 4, h = U & 15;
        bf16x8 vf[2][4];
#pragma unroll
        for (int e2 = 0; e2 < 2; ++e2)
#pragma unroll
            for (int ks = 0; ks < 4; ++ks) vf[e2][ks] = *(const bf16x8*)(VT + (size_t)(h * 128 + (2 * ep + e2) * 32 + dl) * S_ + c * 64 + 16 * ks + 8 * hf);
        asm volatile("s_waitcnt vmcnt(0)" ::: "memory");
        __syncthreads();
        float f[16], b[16];
        float run = 0.f;
#pragma unroll
        for (int i = 0; i < 16; ++i) { const int r = 16 * tq + i; f[i] = (float)*(const LAS _Float16*)(Ft + (r >> 2) * BLK + (r & 3) * 256 + d * 2); run += __logf(1.0f - f[i]); b[i] = run; }
        QT[tq * 128 + d] = run;
        LDS_WAIT();
        __syncthreads();
        if (U + NG < 2048) A2_STAGE(U + NG);
        const float q0 = QT[d], q1 = QT[128 + d], q2 = QT[256 + d], q3 = QT[384 + d];
        const float pre = (tq > 0 ? q0 : 0.f) + (tq > 1 ? q1 : 0.f) + (tq > 2 ? q2 : 0.f);
        const float blast = (q0 + q1) + (q2 + q3);
        float kd[16];
#pragma unroll
        for (int i = 0; i < 16; ++i) { b[i] += pre; *(LAS unsigned short*)(BCT + (16 * tq + i) * 272 + d * 2) = __builtin_bit_cast(unsigned short, (_Float16)b[i]); kd[i] = f[i] * __expf(blast - b[i]); }
        if (tq == 0) EBL[(size_t)U * 128 + d] = __expf(blast);
        *(LAS bf16x8*)(KDT + d * 144 + 32 * tq) = pack8(kd); *(LAS bf16x8*)(KDT + d * 144 + 32 * tq + 16) = pack8(kd + 8);
        LDS_WAIT();
        __syncthreads();
#pragma unroll
        for (int i = 0; i < 2; ++i) { const int q = tid + NTHREADS * i, r = q >> 4, cc = q & 15;
            *(u32x4*)(BC + (size_t)(c * 64 + r) * D_ + h * 128 + cc * 8) = *(const LAS u32x4*)(BCT + r * 272 + cc * 16); }
        f32x16 acc[2];
#pragma unroll
        for (int e2 = 0; e2 < 2; ++e2)
#pragma unroll
            for (int i = 0; i < 16; ++i) acc[e2][i] = 0.f;
#pragma unroll
        for (int ks = 0; ks < 4; ++ks) {
            const bf16x8 af = *(const LAS bf16x8*)(KDT + (dt * 32 + dl) * 144 + 32 * ks + 16 * hf);
#pragma unroll
            for (int e2 = 0; e2 < 2; ++e2) acc[e2] = MFMA32(af, vf[e2][ks], acc[e2]);
        }
#pragma unroll
        for (int e2 = 0; e2 < 2; ++e2)
#pragma unroll
            for (int s2 = 0; s2 < 2; ++s2) {
                float v[8];
#pragma unroll
                for (int i = 0; i < 8; ++i) v[i] = acc[e2][8 * s2 + i];
                *(bf16x8*)(STB + (((size_t)U * 4 + 2 * ep + e2) * 8 + 2 * dt + s2) * 1024 + lane * 16) = pack8(v);
            }
    }
#undef A2_STAGE
}

DI void hgrn_c2(unsigned char* ws, const float* ogain, LAS unsigned char* lds, int tid, int lane, int wave, int bid, int NG) {
    const bf16* Q = (const bf16*)(ws + WS_R + R_Q); const unsigned short* K1 = (const unsigned short*)(ws + WS_R + R_F); const bf16* G = (const bf16*)(ws + WS_R + R_G);
    const bf16* VT = (const bf16*)(ws + WS_R + R_VT); const unsigned short* BC = (const unsigned short*)(ws + WS_R + R_BC); const unsigned char* STB = ws + WS_R + R_ST;
    bf16* AO = (bf16*)(ws + WS_AO);
    constexpr int BLK = 1040;
    constexpr int SETB = 48 * BLK;
    LAS float* SSt = (LAS float*)(lds + 2 * SETB);
    LAS unsigned char* XFt = lds + 2 * SETB + 1024;
    const int et = wave & 3, tt = wave >> 2, tl = lane & 31, hf = lane >> 5;
    const int rt = tt * 32 + tl;
#define C2_DMA(G_, L_) do { const unsigned la_ = (unsigned)(size_t)(L_); asm volatile("s_mov_b32 m0, %1\n\ts_nop 0\n\tglobal_load_lds_dwordx4 %0, off" :: "v"(G_), "s"(la_) : "memory", "m0"); } while (0)
#define C2_STAGE(U_, S_) do { const int c_ = (U_) >> 4, h_ = (U_) & 15; LAS unsigned char* sb_ = lds + (S_) * SETB; \
        _Pragma("unroll") for (int i_ = 0; i_ < 2; ++i_) { const int m_ = wave * 2 + i_; const size_t ro_ = (size_t)(c_ * 64 + 4 * m_ + (lane >> 4)) * D_ + h_ * 128 + (lane & 15) * 8; \
            C2_DMA(BC + ro_, sb_ + m_ * BLK); C2_DMA(K1 + ro_, sb_ + (16 + m_) * BLK); C2_DMA(Q + ro_, sb_ + (32 + m_) * BLK); } } while (0)
#define C2_ROW4(T, r) ((T) + ((r) >> 2) * BLK + ((r) & 3) * 256)
#define C2_ROWQ(r) C2_ROW4(Qt, r)
#define C2_H4(p_) ({ const u32x2 w_ = *(const LAS u32x2*)(p_); (f32x4){h_lo(w_.x), h_hi(w_.x), h_lo(w_.y), h_hi(w_.y)}; })
    int U = bid;
    if (U < 2048) C2_STAGE(U, 0);
    asm volatile("s_waitcnt vmcnt(0)" ::: "memory");
    for (int iter = 0; U < 2048; U += NG, ++iter) {
        const int par = iter & 1;
        const int c = U >> 4, h = U & 15, t = c * 64 + rt;
        LAS unsigned char* BCt = lds + par * SETB; LAS unsigned char* Ft = BCt + 16 * BLK; LAS unsigned char* Qt = BCt + 32 * BLK;
        asm volatile("s_waitcnt vmcnt(4)" ::: "memory");
        __syncthreads();
        bf16x8 sfr[8]; s16x4 vlo[2][2], vhi[2][2]; u32x2 gwr[4]; f32x4 ogr[4];
#pragma unroll
        for (int ks = 0; ks < 8; ++ks) sfr[ks] = *(const bf16x8*)(STB + (((size_t)U * 4 + et) * 8 + ks) * 1024 + lane * 16);
#pragma unroll
        for (int st = 0; st < 2; ++st)
#pragma unroll
            for (int kp = 0; kp < 2; ++kp) { const bf16* vp = VT + (size_t)(h * 128 + et * 32 + tl) * S_ + c * 64 + st * 32 + 16 * kp + 4 * hf; vlo[st][kp] = *(const s16x4*)vp; vhi[st][kp] = *(const s16x4*)(vp + 8); }
#pragma unroll
        for (int rq = 0; rq < 4; ++rq) { const int e0 = h * 128 + et * 32 + 8 * rq + 4 * hf; ogr[rq] = *(const f32x4*)(ogain + e0); gwr[rq] = *(const u32x2*)(G + (size_t)t * D_ + e0); }
        EPI_FENCE();
        if (U + NG < 2048) C2_STAGE(U + NG, par ^ 1);
        EPI_FENCE();
        const LAS unsigned char* qrow = C2_ROWQ(rt) + 8 * hf; const LAS unsigned char* brow = C2_ROW4(BCt, rt) + 8 * hf; const LAS unsigned char* b31 = C2_ROW4(BCt, 31) + 8 * hf;
        bf16x8 qt[8];
#pragma unroll
        for (int ks = 0; ks < 8; ++ks) {
            const u32x2 qa = *(const LAS u32x2*)(qrow + 32 * ks), qb2 = *(const LAS u32x2*)(qrow + 32 * ks + 16);
            const float q[8] = {bf_lo(qa.x), bf_hi(qa.x), bf_lo(qa.y), bf_hi(qa.y), bf_lo(qb2.x), bf_hi(qb2.x), bf_lo(qb2.y), bf_hi(qb2.y)};
            const f32x4 b0 = C2_H4(brow + 32 * ks), b1 = C2_H4(brow + 32 * ks + 16);
            float v[8];
#pragma unroll
            for (int e = 0; e < 4; ++e) { v[e] = q[e] * __expf(b0[e]); v[4 + e] = q[4 + e] * __expf(b1[e]); }
            qt[ks] = pack8(v);
            if (ks & 1) asm volatile("" ::: "memory");
        }
        f32x16 acc;
#pragma unroll
        for (int i = 0; i < 16; ++i) acc[i] = 0.f;
#pragma unroll
        for (int ks = 0; ks < 8; ++ks) {
            acc = MFMA32(sfr[ks], qt[ks], acc);
        }
        if (et <= tt) {
            const int st = et;
            const LAS unsigned char* frow = C2_ROW4(Ft, st * 32 + tl) + 8 * hf; const LAS unsigned char* srow = C2_ROW4(BCt, st * 32 + tl) + 8 * hf;
            f32x16 X;
#pragma unroll
            for (int i = 0; i < 16; ++i) X[i] = 0.f;
#pragma unroll
            for (int ks = 0; ks < 8; ++ks) {
                const f32x4 f0 = C2_H4(frow + 32 * ks), f1 = C2_H4(frow + 32 * ks + 16);
                const f32x4 b0 = C2_H4(srow + 32 * ks), b1 = C2_H4(srow + 32 * ks + 16);
                f32x4 c0 = {0.f, 0.f, 0.f, 0.f}, c1 = {0.f, 0.f, 0.f, 0.f};
                bf16x8 qb = qt[ks];
                if (st == 1) {
                    c0 = C2_H4(b31 + 32 * ks); c1 = C2_H4(b31 + 32 * ks + 16);
                    const u32x2 qa = *(const LAS u32x2*)(qrow + 32 * ks), qb2 = *(const LAS u32x2*)(qrow + 32 * ks + 16);
                    const float q[8] = {bf_lo(qa.x), bf_hi(qa.x), bf_lo(qa.y), bf_hi(qa.y), bf_lo(qb2.x), bf_hi(qb2.x), bf_lo(qb2.y), bf_hi(qb2.y)};
                    const f32x4 t0 = C2_H4(brow + 32 * ks), t1 = C2_H4(brow + 32 * ks + 16);
                    float w[8];
#pragma unroll
                    for (int e = 0; e < 4; ++e) { w[e] = q[e] * __expf(t0[e] - c0[e]); w[4 + e] = q[4 + e] * __expf(t1[e] - c1[e]); }
                    qb = pack8(w);
                }
                float v[8];
#pragma unroll
                for (int e = 0; e < 4; ++e) { v[e] = f0[e] * __expf(c0[e] - b0[e]); v[4 + e] = f1[e] * __expf(c1[e] - b1[e]); }
                X = MFMA32(pack8(v), qb, X);
                if (ks & 1) asm volatile("" ::: "memory");
            }
            if (st == tt) {
#pragma unroll
                for (int r = 0; r < 16; ++r) { const int sl = (r & 3) + 8 * (r >> 2) + 4 * hf; X[r] = (sl <= tl) ? X[r] : 0.f; }
            }
#pragma unroll
            for (int kp = 0; kp < 2; ++kp) {
                float xv[8];
#pragma unroll
                for (int i = 0; i < 8; ++i) xv[i] = X[8 * kp + i];
                *(LAS bf16x8*)(XFt + ((st + tt) * 2 + kp) * 1024 + lane * 16) = pack8(xv);
            }
        }
        LDS_WAIT();
        __syncthreads();
#pragma unroll
        for (int st = 0; st < 2; ++st) {
            if (st <= tt) {
#pragma unroll
                for (int kp = 0; kp < 2; ++kp) {
                    const bf16x8 xb = *(const LAS bf16x8*)(XFt + ((st + tt) * 2 + kp) * 1024 + lane * 16);
                    const s16x4 lo = vlo[st][kp], hi = vhi[st][kp];
                    const bf16x8 vf = {lo[0], lo[1], lo[2], lo[3], hi[0], hi[1], hi[2], hi[3]};
                    acc = MFMA32(vf, xb, acc);
                }
            }
        }
        float ss = 0.f;
#pragma unroll
        for (int i = 0; i < 16; ++i) ss += acc[i] * acc[i];
        ss += __shfl_xor(ss, 32);
        if (hf == 0) SSt[rt * 4 + et] = ss;
        LDS_WAIT();
        __syncthreads();
        const f32x4 s4 = *(const LAS f32x4*)(SSt + rt * 4);
        const float rstd = __builtin_amdgcn_rsqf(((s4[0] + s4[1]) + (s4[2] + s4[3])) * (1.0f / 128.0f) + EPS_);
        LDS_WAIT();
        __syncthreads();
        u32x2 wo[4];
#pragma unroll
        for (int rq = 0; rq < 4; ++rq) {
            const f32x4 og = ogr[rq];
            const u32x2 gw = gwr[rq];
            const float g0 = bf_lo(gw.x), g1 = bf_hi(gw.x), g2 = bf_lo(gw.y), g3 = bf_hi(gw.y);
            wo[rq].x = pk2(acc[4 * rq] * rstd * og[0] * g0, acc[4 * rq + 1] * rstd * og[1] * g1);
            wo[rq].y = pk2(acc[4 * rq + 2] * rstd * og[2] * g2, acc[4 * rq + 3] * rstd * og[3] * g3);
        }
        { bf16* op_ = AO + (size_t)t * D_ + h * 128 + et * 32 + 4 * hf;
          asm volatile("global_store_dwordx2 %0, %1, off\n\tglobal_store_dwordx2 %0, %2, off offset:16\n\tglobal_store_dwordx2 %0, %3, off offset:32\n\tglobal_store_dwordx2 %0, %4, off offset:48"
                       :: "v"(op_), "v"(wo[0]), "v"(wo[1]), "v"(wo[2]), "v"(wo[3]) : "memory"); }
    }
#undef C2_STAGE
#undef C2_DMA
#undef C2_ROW4
#undef C2_ROWQ
#undef C2_H4
}

constexpr int N_PHASE_IDS = 41;
__global__ void __launch_bounds__(NTHREADS, 2) fwd(Args args) {
    extern __shared__ __attribute__((aligned(16))) unsigned char lds_raw[];
    LAS unsigned char* lds = (LAS unsigned char*)lds_raw;
    const int tid = threadIdx.x, lane = tid & 63, wave = __builtin_amdgcn_readfirstlane(tid >> 6);
    const int G = gridDim.x;
    const int NGW = G * NWAVES;
    unsigned char* ws_k = args.ws;
#if MK_ONE_LAUNCH
    constexpr int lo = 0, hi = N_PHASE_IDS; constexpr bool multi = true;
#else
    const int lo = args.ph_lo, hi = args.ph_hi;
    const bool multi = (hi - lo) > 1;
#endif
    volatile LAS unsigned* MISC = (volatile LAS unsigned*)(lds + LDS_MISC);
    if (tid < 4) MISC[tid] = 0u;
    __syncthreads();
    XcdBarrier bar; bar.bar = (unsigned*)(ws_k + WS_CTL) + CW_BAR; bar.x = 0; bar.st = MISC;
    if (multi) bar = xcd_barrier_post((unsigned*)(ws_k + WS_CTL) + CW_BAR, MISC);
#ifndef PH_MASK
#define PH_MASK 0xFFFF
#endif
#define IN(k) (lo <= (k) && (k) < hi)
#define EN(b) ((PH_MASK >> (b)) & 1)
#ifndef PROBE_DUP
#define PROBE_DUP 0
#endif
#ifndef PROBE_MODE
#define PROBE_MODE 0
#endif
#ifndef PROBE_BAR
#define PROBE_BAR 0
#endif
#define REP(b) for (int rep_ = ((PROBE_DUP >> (b)) & 1); rep_ >= 0; --rep_)
#define OPQ() __builtin_amdgcn_s_waitcnt(0); int tid_ = tid, bid_ = (int)blockIdx.x; GAS unsigned char* wsg_ = (GAS unsigned char*)ws_k; asm volatile("" : "+v"(tid_), "+s"(bid_), "+s"(wsg_)); unsigned char* ws = (unsigned char*)wsg_; float* X = (float*)args.out; bf16* XB = (bf16*)(ws + WS_XB); bf16* AO = (bf16*)(ws + WS_AO); float* SSQ = (float*)(ws + (sqp ? WS_SSQ1 : WS_SSQ)); float* SSQO = (float*)(ws + (sqp ? WS_SSQ : WS_SSQ1)); float* XS = (float*)(ws + WS_XS); (void)X; (void)XB; (void)AO; (void)SSQ; (void)SSQO; (void)XS; const int lane_ = tid_ & 63, wave_ = __builtin_amdgcn_readfirstlane(tid_ >> 6), gw_ = bid_ * NWAVES + wave_; (void)lane_; (void)gw_
#define SEAM(k) do { if (multi && (k) + 1 < hi) { XcdBarrier b_ = bar; GAS unsigned* bp_ = (GAS unsigned*)b_.bar; asm volatile("" : "+s"(bp_)); b_.bar = (unsigned*)bp_; xcd_barrier(b_); if (PROBE_BAR) xcd_barrier(b_); } } while (0)


    int sqp = 0;
    if (EN(0) && IN(0)) REP(0) { OPQ(); p0_prologue(args, lds, gw_, NGW, lane_, wave_); SEAM(0); }

    for (int l = 0; l < DEPTH_; ++l) {
        const int pb = 1 + 10 * l, j = l >> 1;
        for (int f = 0; f < 2; ++f) {
            const int ff = 2 * l + f, p_gu = pb + (f ? 7 : 0), p_dn = p_gu + 1;
            sqp = (3 * l + (f ? 2 : 0)) & 1;
            if (EN(1) && IN(p_gu)) REP(1) {
                OPQ();
                pg8::StaticOrder S; S.init(S_, 2 * FF_, G, bid_);
                unsigned char* Hp = ws + WS_R + R_H;
                const bool ini8 = (GUI8_MASK >> ff) & 1, in8 = !ini8 && ((GU8_MASK >> ff) & 1), out8 = (DN8_MASK >> ff) & 1;
                constexpr int G8 = GU8_MASK & ~GUI8_MASK & 0xff, G16 = ~GU8_MASK & ~GUI8_MASK & 0xff;
                constexpr int MI1 = GUI8_MASK & DN8_MASK, MI0 = GUI8_MASK & ~DN8_MASK & 0xff;
                constexpr int M11 = G8 & DN8_MASK, M10 = G8 & ~DN8_MASK & 0xff, M01 = G16 & DN8_MASK, M00 = G16 & ~DN8_MASK & 0xff;
                pg8::Gemm g8{ws + WS_X8, ws + WS_WGU + (size_t)ff * SZ_WGU, S_, 2 * FF_, D_}, g16{XB, ws + WS_WGU + (size_t)ff * SZ_WGU, S_, 2 * FF_, 2 * D_};
                if (ini8 && out8) { if constexpr (MI1 != 0) { EpiSwiglu<2, true> E{Hp, SSQ, XS}; pg8::gemm_phase<EpiSwiglu<2, true>, pg8::StaticOrder, true, true, 2>(lds, g8, S, E, tid_); } }
                else if (ini8) { if constexpr (MI0 != 0) { EpiSwiglu<2, false> E{Hp, SSQ, XS}; pg8::gemm_phase<EpiSwiglu<2, false>, pg8::StaticOrder, true, true, 2>(lds, g8, S, E, tid_); } }
                else if (in8 && out8) { if constexpr (M11 != 0) { EpiSwiglu<1, true> E{Hp, SSQ, XS}; pg8::gemm_phase<EpiSwiglu<1, true>, pg8::StaticOrder, true, true, 1>(lds, g8, S, E, tid_); } }
                else if (in8) { if constexpr (M10 != 0) { EpiSwiglu<1, false> E{Hp, SSQ, XS}; pg8::gemm_phase<EpiSwiglu<1, false>, pg8::StaticOrder, true, true, 1>(lds, g8, S, E, tid_); } }
                else if (out8) { if constexpr (M01 != 0) { EpiSwiglu<0, true> E{Hp, SSQ, XS}; pg8::gemm_phase<EpiSwiglu<0, true>, pg8::StaticOrder, true, true, 0>(lds, g16, S, E, tid_); } }
                else { if constexpr (M00 != 0) { EpiSwiglu<0, false> E{Hp, SSQ, XS}; pg8::gemm_phase<EpiSwiglu<0, false>, pg8::StaticOrder, true, true, 0>(lds, g16, S, E, tid_); } }
                if (bid_ >= G / 2 && G == 256) p0_deferred_down(args, lds, ff, (bid_ - G / 2) * NWAVES + wave_, (G / 2) * NWAVES, lane_, wave_);
                else if (G != 256) p0_deferred_down(args, lds, ff, bid_ * NWAVES + wave_, G * NWAVES, lane_, wave_);
                SEAM(p_gu);
            }
            if (EN(2) && IN(p_dn)) REP(2) {
                OPQ();
                pg8::StaticOrder S; S.init(S_, D_, G, bid_);
                EpiResid<true> E{args.in[0], X, XB, ws + WS_X8, SSQ, SSQO, XS, rep_ ? 0.0f : 0.5f, (f == 0) ? (((MIX8_MASK >> l) & 1) ? 1 : 0) : (((GUI8_MASK >> (ff + 1)) & 1) ? 1 : (((GU8_MASK >> (ff + 1)) & 1) ? 2 : 0)), ff == 0, ff == 2 * DEPTH_ - 1};
                if ((DN8_MASK >> ff) & 1) { if constexpr (DN8_MASK != 0) { pg8::Gemm g{ws + WS_R + R_H, ws + WS_WD + (size_t)ff * SZ_WD, S_, D_, FF_};
                        pg8::gemm_phase<EpiResid<true>, pg8::StaticOrder, true, true, 1, true, true>(lds, g, S, E, tid_); } }
                else { if constexpr (DN8_MASK != 0xff) { pg8::Gemm g{ws + WS_R + R_H, ws + WS_WD + (size_t)ff * SZ_WD, S_, D_, 2 * FF_};
                        pg8::gemm_phase<EpiResid<true>, pg8::StaticOrder, true, true, 0, true, true>(lds, g, S, E, tid_); } }
                SEAM(p_dn);
            }
            if (f == 0) {
                sqp = (3 * l + 1) & 1;
                if ((l & 1) == 0) {
                    if (EN(3) && IN(pb + 2)) REP(3) {
                        OPQ();
                        const bool m8 = (MIX8_MASK >> l) & 1;
                        const unsigned char* Wd = ws + WS_DWIN + (size_t)j * SZ_DWIN; const int kbp = m8 ? D_ : 2 * D_;
                        const unsigned char* xa = m8 ? (const unsigned char*)(ws + WS_X8) : (const unsigned char*)XB;
                        {
                            pg8::StaticOrder S; S.init(S_, 4096, G, bid_);
                            EpiDsaIn E{(bf16*)(ws + WS_R + R_PROJ), SSQ, XS, m8};
                            pg8::Gemm g{xa, Wd, S_, 4096, kbp};
                            if (m8) { if constexpr ((MIX8_MASK & 5) != 0) pg8::gemm_phase<EpiDsaIn, pg8::StaticOrder, true, true, 2>(lds, g, S, E, tid_); }
                            else { if constexpr ((MIX8_MASK & 5) != 5) pg8::gemm_phase<EpiDsaIn, pg8::StaticOrder, true, true, 0>(lds, g, S, E, tid_); }
                        }
                        {
                            const int ntk = kbp / 128 / 8;
                            EpiDsaEx E{(float*)(ws + WS_R + R_EX), SSQ, XS, m8};
                            for (int L = bid_; L < 256; L += G) {
                                const int pm = L >> 3, sl = L & 7;
                                pg8::Gemm g{xa + (size_t)sl * ntk * 128, Wd + (size_t)16 * 256 * kbp, S_, 256, kbp, ntk};
                                pg8::SingleOrder S1{pg8::Unit{pm, sl}};
                                if (m8) { if constexpr ((MIX8_MASK & 5) != 0) pg8::gemm_phase<EpiDsaEx, pg8::SingleOrder, true, true, 2>(lds, g, S1, E, tid_); }
                                else { if constexpr ((MIX8_MASK & 5) != 5) pg8::gemm_phase<EpiDsaEx, pg8::SingleOrder, true, true, 0>(lds, g, S1, E, tid_); }
                            }
                        }
                        SEAM(pb + 2);
                    }
                    if (EN(4) && IN(pb + 3)) REP(4) { OPQ(); dsa_prep(ws, args.in[7] + j * 128, args.in[8] + j * 128, args.in[9] + j * 64, gw_, NGW, lane_); SEAM(pb + 3); }
                    if (EN(5) && IN(pb + 4)) REP(5) { OPQ(); dsa_select(ws, lds, tid_, lane_, wave_, bid_, G, (PROBE_MODE == 3) && rep_); SEAM(pb + 4); }
                    if (EN(11) && IN(pb + 5)) REP(11) { OPQ(); dsa_attend(ws, args.in[10], lds, tid_, lane_, wave_, j + 2 * rep_); SEAM(pb + 5); }
                } else {
                    if (EN(6) && IN(pb + 2)) REP(6) {
#define HW_PTRS() const bool m8 = (MIX8_MASK >> l) & 1; const unsigned char* Wb = ws + WS_HWIN + (size_t)j * SZ_HWIN; const size_t wstep = (size_t)D_ * D_ * (m8 ? 1 : 2); const float* lbp = (const float*)(ws + WS_LB) + j * D_; const void* xa = m8 ? (const void*)(ws + WS_X8) : (const void*)XB; const int kbp = m8 ? D_ : 2 * D_; (void)lbp
#define HG_CALL(EPI, SCH, S_, G_, E_) do { if (m8) { if constexpr ((MIX8_MASK & 10) != 0) pg8::gemm_phase<EPI, SCH, true, true, 2>(lds, G_, S_, E_, tid_); } else { if constexpr ((MIX8_MASK & 10) != 10) pg8::gemm_phase<EPI, SCH, true, true, false>(lds, G_, S_, E_, tid_); } } while (0)
                        { OPQ(); HW_PTRS(); pg8::StaticOrder S; S.init(S_, D_, G, bid_);
                          pg8::Gemm g{xa, Wb, S_, D_, kbp}; EpiHgrnIn<0> E{(bf16*)(ws + WS_R + R_Q), nullptr, SSQ, lbp, XS, m8};
                          HG_CALL(EpiHgrnIn<0>, pg8::StaticOrder, S, g, E); }
                        { OPQ(); HW_PTRS(); pg8::StaticOrder S; S.init(S_, D_, G, bid_);
                          pg8::Gemm g{xa, Wb + wstep, S_, D_, kbp}; EpiHgrnIn<1> E{nullptr, (float*)(ws + WS_R + R_F), SSQ, lbp, XS, m8};
                          HG_CALL(EpiHgrnIn<1>, pg8::StaticOrder, S, g, E); }
                        { OPQ(); HW_PTRS(); pg8::StaticOrder S; S.init(S_, D_, G, bid_);
                          pg8::Gemm g{xa, Wb + 2 * wstep, S_, D_, kbp}; EpiHgrnIn<2> E{(bf16*)(ws + WS_R + R_G), nullptr, SSQ, lbp, XS, m8};
                          HG_CALL(EpiHgrnIn<2>, pg8::StaticOrder, S, g, E); }
                        {
                            OPQ(); HW_PTRS();
                            pg8::StaticOrder S; S.init(D_, S_, G, bid_);
                            pg8::Unit uu;
                            LAS float* tab = (LAS float*)(lds + LDS_TAB);
                            for (int i = 0; S.next(i, uu); ++i) {
                                __syncthreads();
                                { const int row = uu.pn * 256 + (tid_ >> 1); const f32x4* p = (const f32x4*)(SSQ + (size_t)row * 32 + 16 * (tid_ & 1));
                                  const f32x4 a = p[0], b = p[1], c = p[2], d = p[3];
                                  float s = (((a[0] + a[1]) + (a[2] + a[3])) + ((b[0] + b[1]) + (b[2] + b[3]))) + (((c[0] + c[1]) + (c[2] + c[3])) + ((d[0] + d[1]) + (d[2] + d[3])));
                                  s += __shfl_xor(s, 1);
                                  if ((tid_ & 1) == 0) tab[tid_ >> 1] = __builtin_amdgcn_rsqf(s * (1.0f / D_) + EPS_) * (m8 ? __builtin_amdgcn_rcpf(XS[row] * WI8_SCALE) : 1.0f); }
                                __syncthreads();
                                pg8::Gemm g{Wb + 3 * wstep, xa, D_, S_, kbp};
                                pg8::SingleOrder S1{uu};
                                EpiHgrnVT E{(bf16*)(ws + WS_R + R_VT), tab, m8};
                                if (m8) { if constexpr ((MIX8_MASK & 10) != 0) pg8::gemm_phase<EpiHgrnVT, pg8::SingleOrder, true, true, 2, true, false>(lds, g, S1, E, tid_); }
                                else { if constexpr ((MIX8_MASK & 10) != 10) pg8::gemm_phase<EpiHgrnVT, pg8::SingleOrder, true, true, false, true, false>(lds, g, S1, E, tid_); }
                            }
                        }
                        SEAM(pb + 2);
                    }
                    if (EN(7) && IN(pb + 3)) REP(7) { OPQ(); hgrn_a2(ws, lds, tid_, lane_, wave_, bid_, G); SEAM(pb + 3); }
                    if (EN(8) && IN(pb + 4)) REP(8) { OPQ(); hgrn_b(ws, bid_ * NTHREADS + tid_, G * NTHREADS, rep_); SEAM(pb + 4); }
                    if (EN(9) && IN(pb + 5)) REP(9) { OPQ(); hgrn_c2(ws, args.in[14] + j * D_, lds, tid_, lane_, wave_, bid_, G); SEAM(pb + 5); }
                }
                if (EN(10) && IN(pb + 6)) REP(10) {
                    OPQ();
                    const bf16* Wo = (l & 1) ? (const bf16*)(ws + WS_HWO + (size_t)j * SZ_WO) : (const bf16*)(ws + WS_DWO + (size_t)j * SZ_WO);
                    pg8::Gemm g{AO, Wo, S_, D_, 2 * D_}; pg8::StaticOrder S; S.init(S_, D_, G, bid_);
                    EpiResid<false> E{args.in[0], X, XB, ws + WS_X8, SSQ, SSQO, XS, rep_ ? 0.0f : 1.0f, ((GUI8_MASK >> (2 * l + 1)) & 1) ? 1 : (((GU8_MASK >> (2 * l + 1)) & 1) ? 2 : 0), false, false};
                    pg8::gemm_phase<EpiResid<false>, pg8::StaticOrder, true, true>(lds, g, S, E, tid_);
                    SEAM(pb + 6);
                }
            }
        }
    }
#undef IN
#undef SEAM
}

extern "C" void kernel_launch(void* const* d_in, const int* in_sizes, int n_in, void* d_out, int out_size, void* d_ws, size_t ws_size, hipStream_t stream) {
    static int grid = 0;
    if (grid == 0) {
        if (n_in != 15 || in_sizes[0] != S_ * D_ || out_size != S_ * D_ || ws_size < WS_END) {
            fprintf(stderr, "kernel_launch: unexpected shapes/workspace (n_in %d, in0 %d, out %d, ws %zu, need %zu); nothing launched\n", n_in, n_in > 0 ? in_sizes[0] : -1, out_size, ws_size, (size_t)WS_END);
            grid = -1; return; }
        int dev = 0, cus = 0, per_cu = 0;
        if (hipGetDevice(&dev) != hipSuccess || hipDeviceGetAttribute(&cus, hipDeviceAttributeMultiprocessorCount, dev) != hipSuccess) { grid = -1; return; }
        if (hipFuncSetAttribute((const void*)fwd, hipFuncAttributeMaxDynamicSharedMemorySize, LDS_BYTES) != hipSuccess) { fprintf(stderr, "kernel_launch: hipFuncSetAttribute failed\n"); grid = -1; return; }
        if (hipOccupancyMaxActiveBlocksPerMultiprocessor(&per_cu, (const void*)fwd, NTHREADS, LDS_BYTES) != hipSuccess || per_cu < 1)
            fprintf(stderr, "kernel_launch: note: occupancy query reports %d workgroups per CU\n", per_cu);
        (void)hipGetLastError();
        grid = cus;
    }
    if (grid < 0) return;
    if (hipMemsetAsync((char*)d_ws + WS_CTL, 0, CTL_ZERO_BYTES, stream) != hipSuccess) return;
    Args a{};
    for (int i = 0; i < 15; ++i) a.in[i] = (const float*)d_in[i];
    a.out = (float*)d_out; a.ws = (unsigned char*)d_ws;
#if MK_ONE_LAUNCH
    a.ph_lo = 0; a.ph_hi = N_PHASE_IDS;
    hipLaunchKernelGGL(fwd, dim3(grid), dim3(NTHREADS), LDS_BYTES, stream, a);
#else
    for (int p = 0; p < N_PHASE_IDS; ++p) {
        const int r = (p - 1) % 10, l = (p - 1) / 10;
        if (p > 0) { if (r == 9) continue; }
        a.ph_lo = p; a.ph_hi = p + 1;
        hipLaunchKernelGGL(fwd, dim3(grid), dim3(NTHREADS), LDS_BYTES, stream, a);
    }
#endif
}
```

```cpp
#include <hip/hip_runtime.h>
#include <cstdio>
#include <cstdint>

#ifndef GU8_MASK
#define GU8_MASK 0xFC
#endif
#ifndef DN8_MASK
#define DN8_MASK 0xFE
#endif
#ifndef GUI8_MASK
#define GUI8_MASK 0xFF
#endif
#ifndef MIX8_MASK
#define MIX8_MASK 0xE
#endif
#ifndef MK_ONE_LAUNCH
#define MK_ONE_LAUNCH 1
#endif

namespace pg8 {
#define PG8_LAS __attribute__((address_space(3)))
typedef unsigned short bf16_t;
typedef short bf16x8 __attribute__((ext_vector_type(8)));
typedef float f32x4 __attribute__((ext_vector_type(4)));
typedef unsigned u32x4 __attribute__((ext_vector_type(4)));
constexpr int BM = 256, BK = 64, HALF = 128, HTB = HALF * BK * 2, STAGE_BYTES = 8 * HTB, NXCD = 8, WGM = 8;

__host__ __device__ __forceinline__ int lds_byte(int r, int c) { const int st = (r >> 4) * 2 + (c >> 5), rr = r & 15, cc = c & 31, ob = rr * 64 + cc * 2; return st * 1024 + (ob ^ (((ob >> 9) & 1) << 5)); }
__host__ __device__ __forceinline__ void stage_rc(int b, int& R, int& C) { const int st = b / 1024, sb = b % 1024, swz = sb ^ (((sb >> 9) & 1) << 5); R = (st >> 1) * 16 + swz / 64; C = (st & 1) * 32 + (swz % 64) / 2; }
__host__ __device__ __forceinline__ int perm32(int rho) { const int n = rho >> 4, i = rho & 15; return 8 * (i >> 2) + 4 * n + (i & 3); }

struct Unit { int pm, pn; };
struct Gemm { const void* A; const void* Bt; int M, N, KB; int ntk = 0; };

struct StaticOrder {
    int nM, nN, nwg, G, c;
    __host__ __device__ __forceinline__ void init(int M, int N, int G_, int c_) { nM = M / BM; nN = N / BM; nwg = nM * nN; G = G_; c = c_; }
    __host__ __device__ __forceinline__ bool next(int i, Unit& u) const {
        const long L = (long)i * G + c; if (L >= nwg) return false;
        int wgid = (int)L; { const int q = nwg / NXCD, r = nwg % NXCD, xcd = wgid % NXCD, off = wgid / NXCD; wgid = (xcd < r ? xcd * (q + 1) : r * (q + 1) + (xcd - r) * q) + off; }
        const int nig = WGM * nN, gid = wgid / nig, fm = gid * WGM, gsz = (nM - fm) < WGM ? (nM - fm) : WGM;
        u.pm = fm + ((wgid % nig) % gsz); u.pn = (wgid % nig) / gsz; return true;
    }
    __device__ __forceinline__ void a_ready(const Unit&) const {}
    __device__ __forceinline__ void done(const Unit&) const {}
};
struct SingleOrder {
    Unit u0;
    __device__ __forceinline__ bool next(int i, Unit& u) const { if (i != 0) return false; u = u0; return true; }
    __device__ __forceinline__ void a_ready(const Unit&) const {}
    __device__ __forceinline__ void done(const Unit&) const {}
};

typedef int i32x8 __attribute__((ext_vector_type(8)));
typedef int i32x4v __attribute__((ext_vector_type(4)));
__device__ __forceinline__ i32x8 cat8(bf16x8 lo, bf16x8 hi) { const i32x4v a = __builtin_bit_cast(i32x4v, lo), b = __builtin_bit_cast(i32x4v, hi); return (i32x8){a[0], a[1], a[2], a[3], b[0], b[1], b[2], b[3]}; }
template <class Epi, int FP8> struct FP8SC { static constexpr int A = 0, B = 0; };
template <class Epi> struct FP8SC<Epi, 1> { static constexpr int A = Epi::SCALE_A, B = Epi::SCALE_B; };
template <class Epi, class Sched, bool ALIGN_EPI = false, bool SP2 = false, int FP8 = 0, bool TA = false, bool TB = true>
__device__ __forceinline__ void gemm_phase(PG8_LAS unsigned char* lds, const Gemm g, const Sched& S, const Epi& E, const int tid) {
    const int wid = __builtin_amdgcn_readfirstlane(tid >> 6), lane = tid & 63, wr = wid >> 2, wc = wid & 3, fr = lane & 15, fq = lane >> 4;
    const int K = g.KB, nt = g.ntk ? g.ntk : K / 128;
    unsigned voffA[2], voffB[2];
#pragma unroll
    for (int i = 0; i < 2; ++i) { int R, C; stage_rc(tid * 16 + i * 8192, R, C); const int Rb = Epi::PERM ? ((R & ~31) + perm32(R & 31)) : R;
        voffA[i] = TA ? (unsigned)(R * 128 + C * 2) : (unsigned)(R * K + C * 2); voffB[i] = TB ? (unsigned)(Rb * 128 + C * 2) : (unsigned)(Rb * K + C * 2); }
    const size_t kstepA = TA ? 32768 : 128, kstepB = TB ? 32768 : 128;
    const size_t hstepA = TA ? 16384 : (size_t)HALF * K, hstepB = TB ? 16384 : (size_t)HALF * K;
    const size_t tstepA = TA ? (size_t)32768 * nt : (size_t)256 * K, tstepB = TB ? (size_t)32768 * nt : (size_t)256 * K;
    const unsigned ldsw = (unsigned)wid * 1024u;
    const int aoff = lds_byte(wr * 64 + fr, fq * 8), boff = lds_byte(wc * 32 + fr, fq * 8);
#define PG8_SA(b, h) (((b) * 2 + (h)) * HTB)
#define PG8_SB(b, h) ((4 + (b) * 2 + (h)) * HTB)
#define PG8_STAGE(bufoff, gbase, voff) do { _Pragma("unroll") for (int _i = 0; _i < 2; ++_i) \
        __builtin_amdgcn_global_load_lds((const unsigned*)((const char*)(gbase) + (voff)[_i]), (PG8_LAS unsigned*)(lds + (bufoff) + ldsw + _i * 8192), 16, 0, 0); } while (0)
#define PG8_LD8(p) __builtin_shufflevector(*(const PG8_LAS i32x4v*)(p), *(const PG8_LAS i32x4v*)((p) + 1024), 0, 1, 2, 3, 4, 5, 6, 7)
#define PG8_LDA(dst, b, h) do { _Pragma("unroll") for (int m = 0; m < 4; ++m) { if constexpr (FP8 == 1) dst##8[m] = PG8_LD8(lds + PG8_SA(b, h) + aoff + m * 2048); else { _Pragma("unroll") for (int k = 0; k < 2; ++k) dst[m][k] = *(const PG8_LAS bf16x8*)(lds + PG8_SA(b, h) + aoff + m * 2048 + k * 1024); } } } while (0)
#define PG8_LDB(dst, b, h) do { _Pragma("unroll") for (int n = 0; n < 2; ++n) { if constexpr (FP8 == 1) dst##8[n] = PG8_LD8(lds + PG8_SB(b, h) + boff + n * 2048); else { _Pragma("unroll") for (int k = 0; k < 2; ++k) dst[n][k] = *(const PG8_LAS bf16x8*)(lds + PG8_SB(b, h) + boff + n * 2048 + k * 1024); } } } while (0)
#define PG8_MMA(ai, bj, At, Bt) do { __builtin_amdgcn_s_setprio(1); _Pragma("unroll") for (int m = 0; m < 4; ++m) _Pragma("unroll") for (int n = 0; n < 2; ++n) { \
        if constexpr (FP8 == 1) asm volatile("v_mfma_scale_f32_16x16x128_f8f6f4 %0, %1, %2, %0, %3, %4 op_sel_hi:[0,0,0]" : "+v"(acc[ai][bj][m][n]) : "v"(Bt##8[n]), "v"(At##8[m]), "v"(sc_b), "v"(sc_a)); \
        else if constexpr (FP8 == 2) { _Pragma("unroll") for (int k = 0; k < 2; ++k) asm volatile("v_mfma_i32_16x16x64_i8 %0, %1, %2, %0" : "+v"(acc[ai][bj][m][n]) : "v"(Bt[n][k]), "v"(At[m][k])); } \
        else { _Pragma("unroll") for (int k = 0; k < 2; ++k) acc[ai][bj][m][n] = __builtin_amdgcn_mfma_f32_16x16x32_bf16(Bt[n][k], At[m][k], acc[ai][bj][m][n], 0, 0, 0); } } __builtin_amdgcn_s_setprio(0); } while (0)
#define PG8_WAIT_V(n) asm volatile("s_waitcnt vmcnt(" #n ")" ::: "memory")
#define PG8_WAIT_L(n) asm volatile("s_waitcnt lgkmcnt(" #n ")" ::: "memory")
#define PG8_BAR __builtin_amdgcn_s_barrier()
#define PG8_SCHED __builtin_amdgcn_sched_barrier(0)
    Unit cur, nxt; int ui = 0;
    if (!S.next(0, cur)) return;
    f32x4 acc[2][2][4][2];
#pragma unroll
    for (int a = 0; a < 2; ++a)
#pragma unroll
        for (int b = 0; b < 2; ++b)
#pragma unroll
            for (int m = 0; m < 4; ++m)
#pragma unroll
                for (int n = 0; n < 2; ++n) acc[a][b][m][n] = (f32x4){0.f, 0.f, 0.f, 0.f};
    const int sc_a = Epi::PERM ? FP8SC<Epi, FP8>::A : FP8SC<Epi, FP8>::A, sc_b = FP8SC<Epi, FP8>::B;
    bf16x8 At[4][2], B0[2][2], B1[2][2]; i32x8 At8[4], B08[2], B18[2];
    const char* cA = (const char*)g.A + (size_t)cur.pm * tstepA; const char* cB = (const char*)g.Bt + (size_t)cur.pn * tstepB;
    S.a_ready(cur);
    if constexpr (SP2) {
        PG8_STAGE(PG8_SB(0, 0), cB, voffB); PG8_STAGE(PG8_SB(0, 1), cB + hstepB, voffB); PG8_STAGE(PG8_SA(0, 0), cA, voffA); PG8_STAGE(PG8_SA(0, 1), cA + hstepA, voffA);
        if (wr == 1) PG8_BAR;
        PG8_WAIT_V(2); PG8_BAR;
        PG8_STAGE(PG8_SB(1, 0), cB + kstepB, voffB); PG8_STAGE(PG8_SA(1, 0), cA + kstepA, voffA); PG8_STAGE(PG8_SB(1, 1), cB + hstepB + kstepB, voffB);
        PG8_WAIT_V(6); PG8_BAR;
    } else {
        PG8_STAGE(PG8_SB(0, 0), cB, voffB); PG8_STAGE(PG8_SA(0, 0), cA, voffA); PG8_STAGE(PG8_SB(0, 1), cB + hstepB, voffB); PG8_STAGE(PG8_SA(0, 1), cA + hstepA, voffA);
        if (wr == 1) PG8_BAR;
        PG8_WAIT_V(4); PG8_BAR;
        PG8_STAGE(PG8_SB(1, 0), cB + kstepB, voffB); PG8_STAGE(PG8_SA(1, 0), cA + kstepA, voffA); PG8_STAGE(PG8_SB(1, 1), cB + hstepB + kstepB, voffB);
        PG8_WAIT_V(6); PG8_BAR;
    }
    for (;;) {
        const bool has_next = S.next(ui + 1, nxt);
        const char* nA = has_next ? (const char*)g.A + (size_t)nxt.pm * tstepA : cA; const char* nB = has_next ? (const char*)g.Bt + (size_t)nxt.pn * tstepB : cB;
        for (int t = 0; t < nt; t += 2) {
            const bool last = (t == nt - 2);
            const char* a1 = cA + (size_t)(t + 1) * kstepA;
            const char* a2 = last ? nA : cA + (size_t)(t + 2) * kstepA; const char* b2 = last ? nB : cB + (size_t)(t + 2) * kstepB;
            const char* a3 = a2 + kstepA; const char* b3 = b2 + kstepB;
            if (last && has_next) S.a_ready(nxt);
            if constexpr (SP2) {
            PG8_LDB(B0, 0, 0); PG8_LDB(B1, 0, 1); PG8_SCHED; PG8_LDA(At, 0, 0); PG8_STAGE(PG8_SA(1, 1), a1 + hstepA, voffA);
            PG8_WAIT_V(8); PG8_WAIT_L(0); PG8_BAR; PG8_MMA(0, 0, At, B0); PG8_MMA(0, 1, At, B1); PG8_BAR; PG8_SCHED;
            PG8_LDA(At, 0, 1); PG8_STAGE(PG8_SB(0, 0), b2, voffB); PG8_STAGE(PG8_SB(0, 1), b2 + hstepB, voffB); PG8_STAGE(PG8_SA(0, 0), a2, voffA);
            PG8_WAIT_V(8); PG8_WAIT_L(0); PG8_BAR; PG8_MMA(1, 0, At, B0); PG8_MMA(1, 1, At, B1); PG8_BAR; PG8_SCHED;
            PG8_LDB(B0, 1, 0); PG8_LDB(B1, 1, 1); PG8_SCHED; PG8_LDA(At, 1, 0); PG8_STAGE(PG8_SA(0, 1), a2 + hstepA, voffA);
            PG8_WAIT_V(8); PG8_WAIT_L(0); PG8_BAR; PG8_MMA(0, 0, At, B0); PG8_MMA(0, 1, At, B1); PG8_BAR; PG8_SCHED;
            PG8_LDA(At, 1, 1); PG8_STAGE(PG8_SB(1, 0), b3, voffB); PG8_STAGE(PG8_SB(1, 1), b3 + hstepB, voffB); PG8_STAGE(PG8_SA(1, 0), a3, voffA);
            PG8_WAIT_V(8); PG8_WAIT_L(0); PG8_BAR; PG8_MMA(1, 0, At, B0); PG8_MMA(1, 1, At, B1); PG8_BAR; PG8_SCHED;
            } else {
            PG8_LDB(B0, 0, 0); PG8_SCHED; PG8_LDA(At, 0, 0); PG8_STAGE(PG8_SA(1, 1), a1 + hstepA, voffA);
            PG8_WAIT_L(8); PG8_BAR; PG8_WAIT_L(0); PG8_MMA(0, 0, At, B0); PG8_BAR; PG8_SCHED;
            PG8_LDB(B1, 0, 1); PG8_STAGE(PG8_SB(0, 0), b2, voffB);
            PG8_BAR; PG8_WAIT_L(0); PG8_MMA(0, 1, At, B1); PG8_BAR;
            PG8_LDA(At, 0, 1); PG8_STAGE(PG8_SA(0, 0), a2, voffA);
            PG8_BAR; PG8_WAIT_L(0); PG8_MMA(1, 0, At, B0); PG8_BAR; PG8_SCHED;
            PG8_STAGE(PG8_SB(0, 1), b2 + hstepB, voffB);
            PG8_WAIT_V(6); PG8_BAR; PG8_MMA(1, 1, At, B1); PG8_BAR;
            PG8_LDB(B0, 1, 0); PG8_SCHED; PG8_LDA(At, 1, 0); PG8_STAGE(PG8_SA(0, 1), a2 + hstepA, voffA);
            PG8_WAIT_L(8); PG8_BAR; PG8_WAIT_L(0); PG8_MMA(0, 0, At, B0); PG8_BAR; PG8_SCHED;
            PG8_LDB(B1, 1, 1); PG8_STAGE(PG8_SB(1, 0), b3, voffB);
            PG8_BAR; PG8_WAIT_L(0); PG8_MMA(0, 1, At, B1); PG8_BAR;
            PG8_LDA(At, 1, 1); PG8_STAGE(PG8_SA(1, 0), a3, voffA);
            PG8_BAR; PG8_WAIT_L(0); PG8_MMA(1, 0, At, B0); PG8_BAR; PG8_SCHED;
            PG8_STAGE(PG8_SB(1, 1), b3 + hstepB, voffB);
            PG8_WAIT_V(6); PG8_BAR; PG8_MMA(1, 1, At, B1); PG8_BAR;
            }
        }
        if constexpr (ALIGN_EPI) { if (wr == 0) PG8_BAR; }
        E(acc, cur, wr, wc, fr, fq);
        if (!has_next) break;
#pragma unroll
        for (int a = 0; a < 2; ++a)
#pragma unroll
            for (int b = 0; b < 2; ++b)
#pragma unroll
                for (int m = 0; m < 4; ++m)
#pragma unroll
                    for (int n = 0; n < 2; ++n) acc[a][b][m][n] = (f32x4){0.f, 0.f, 0.f, 0.f};
        cur = nxt; cA = nA; cB = nB; ++ui;
        if constexpr (ALIGN_EPI) { if (wr == 1) PG8_BAR; }
    }
    PG8_WAIT_V(0);
    if constexpr (!ALIGN_EPI) { if (wr == 0) PG8_BAR; }
    PG8_BAR;
#undef PG8_SA
#undef PG8_SB
#undef PG8_STAGE
#undef PG8_LDA
#undef PG8_LD8
#undef PG8_LDB
#undef PG8_MMA
#undef PG8_WAIT_V
#undef PG8_WAIT_L
#undef PG8_BAR
#undef PG8_SCHED
}
}

constexpr int S_ = 8192, D_ = 2048, FF_ = 5632, DEPTH_ = 4;
constexpr int A_IN = 4176, A_IN_PAD = 4352;
constexpr int PROJ_LD = 4096;
constexpr int EX_LD = 128;
constexpr int TOPK = 256;
constexpr float EPS_ = 1e-6f;
constexpr int NWAVES = 8, NTHREADS = 512;

typedef unsigned short bf16;
typedef short bf16x8 __attribute__((ext_vector_type(8)));
typedef short s16x4 __attribute__((ext_vector_type(4)));
typedef float f32x4 __attribute__((ext_vector_type(4)));
typedef float f32x2 __attribute__((ext_vector_type(2)));
typedef float f32x16 __attribute__((ext_vector_type(16)));
typedef unsigned u32x4 __attribute__((ext_vector_type(4)));
typedef unsigned u32x2 __attribute__((ext_vector_type(2)));
typedef int i32x4 __attribute__((ext_vector_type(4)));
typedef __bf16 bf2_t __attribute__((ext_vector_type(2)));
#define LAS __attribute__((address_space(3)))
#define GAS __attribute__((address_space(1)))
#define DI __device__ __forceinline__

DI unsigned pk2(float lo, float hi) { f32x2 v = {lo, hi}; bf2_t r = __builtin_convertvector(v, bf2_t); return __builtin_bit_cast(unsigned, r); }
DI float bf_lo(unsigned w) { return __uint_as_float(w << 16); }
DI float bf_hi(unsigned w) { return __uint_as_float(w & 0xffff0000u); }
typedef _Float16 h2_t __attribute__((ext_vector_type(2)));
DI unsigned pkh2(float a, float b) { const h2_t h = {(_Float16)a, (_Float16)b}; return __builtin_bit_cast(unsigned, h); }
DI float h_lo(unsigned w) { return (float)__builtin_bit_cast(h2_t, w)[0]; }
DI float h_hi(unsigned w) { return (float)__builtin_bit_cast(h2_t, w)[1]; }
DI bf16x8 pack8(const float* v) { u32x4 w; w.x = pk2(v[0], v[1]); w.y = pk2(v[2], v[3]); w.z = pk2(v[4], v[5]); w.w = pk2(v[6], v[7]); return __builtin_bit_cast(bf16x8, w); }
DI void unpack8(u32x4 w, float* v) { v[0] = bf_lo(w.x); v[1] = bf_hi(w.x); v[2] = bf_lo(w.y); v[3] = bf_hi(w.y); v[4] = bf_lo(w.z); v[5] = bf_hi(w.z); v[6] = bf_lo(w.w); v[7] = bf_hi(w.w); }
DI float silu_f(float g) { return g * __builtin_amdgcn_rcpf(1.0f + __expf(-g)); }
DI float sigmoid_f(float g) { return __builtin_amdgcn_rcpf(1.0f + __expf(-g)); }
#define LDS_WAIT() asm volatile("s_waitcnt lgkmcnt(0)" ::: "memory")
#define MFMA32(a, b, c) __builtin_amdgcn_mfma_f32_32x32x16_bf16((a), (b), (c), 0, 0, 0)
#define MFMA16(a, b, c) __builtin_amdgcn_mfma_f32_16x16x32_bf16((a), (b), (c), 0, 0, 0)

constexpr size_t MiB = 1u << 20;
constexpr size_t WS_CTL = 0, CTL_ZERO_BYTES = 1 * MiB;
constexpr size_t WS_LB = 1 * MiB;
constexpr size_t WS_SSQ = 2 * MiB;
constexpr size_t WS_XB = 3 * MiB;
constexpr size_t WS_AO = 35 * MiB;
constexpr size_t WS_W = 67 * MiB;
constexpr size_t SZ_WGU = 44 * MiB, SZ_WD = 22 * MiB, SZ_DWIN = 17 * MiB, SZ_WO = 8 * MiB, SZ_HWIN = 32 * MiB;
constexpr size_t WS_WGU = WS_W;
constexpr size_t WS_WD = WS_WGU + 8 * SZ_WGU;
constexpr size_t WS_DWIN = WS_WD + 8 * SZ_WD;
constexpr size_t WS_DWO = WS_DWIN + 2 * SZ_DWIN;
constexpr size_t WS_HWIN = WS_DWO + 2 * SZ_WO;
constexpr size_t WS_HWO = WS_HWIN + 2 * SZ_HWIN;
constexpr size_t WS_R = WS_HWO + 2 * SZ_WO;
constexpr size_t R_H = 0;
constexpr size_t R_PROJ = 0;
constexpr size_t R_EX = 112 * MiB;
constexpr size_t R_IKN = 72 * MiB;
constexpr size_t R_IWS = 73 * MiB;
constexpr size_t R_SEL = 74 * MiB;
constexpr size_t R_Q8 = 82 * MiB;
constexpr size_t R_K8 = 98 * MiB;
constexpr size_t R_V8 = 102 * MiB;
constexpr size_t R_Q = 0;
constexpr size_t R_F = 32 * MiB;
constexpr size_t R_G = 96 * MiB;
constexpr size_t R_VT = 128 * MiB;
constexpr size_t R_BC = 160 * MiB;
constexpr size_t R_ST = 224 * MiB;
constexpr size_t R_EBL = 352 * MiB;
constexpr size_t WS_X8 = WS_R + 353 * MiB;
constexpr size_t WS_SSQ1 = WS_X8 + 16 * MiB;
constexpr size_t WS_XS = WS_SSQ1 + 1 * MiB;
constexpr size_t WS_END = WS_XS + 1 * MiB;

constexpr int CW_BAR = 4096;
constexpr int CW_WQ = 8192;

constexpr int RING_BYTES = 131072;
constexpr int LDS_AUX = RING_BYTES;
constexpr int LDS_TAB = 161792;
constexpr int LDS_MISC = 162816;
constexpr int LDS_BYTES = 163840;

#define XB_TMO      128
#define XB_XCNT(j)  (256  + 64 * (j))
#define XB_XSUB(j)  (1280 + 64 * (j))
#define XB_XGEN(j)  (2304 + 64 * (j))
#define XB_TOP      3328
#define XB_TOPGEN   3392
#define XCD_BAR_WORDS 3456
#define XB_SPIN_CAP (1u << 18)

__device__ __forceinline__ unsigned xb_ld(unsigned* p)              { return __hip_atomic_load(p, __ATOMIC_RELAXED, __HIP_MEMORY_SCOPE_AGENT); }
__device__ __forceinline__ unsigned xb_add(unsigned* p, unsigned v) { return __hip_atomic_fetch_add(p, v, __ATOMIC_RELAXED, __HIP_MEMORY_SCOPE_AGENT); }
__device__ __forceinline__ unsigned xb_xcc_id() { return (unsigned)__builtin_amdgcn_s_getreg((3 << 11) | 20) & 0xFu; }
#define XB_SPIN(cond, bar) do { unsigned _sp = 0; while (cond) { __builtin_amdgcn_s_sleep(1); \
    if ((++_sp & 255u) == 0u) { if (xb_ld(&(bar)[XB_TMO])) break; if (_sp > XB_SPIN_CAP) { atomicAdd(&(bar)[XB_TMO], 1u); break; } } } } while (0)

struct XcdBarrier {
    unsigned* bar; unsigned x;
    volatile LAS unsigned* st;
};
__device__ __forceinline__ XcdBarrier xcd_barrier_post(unsigned* bar, volatile LAS unsigned* st) {
    XcdBarrier b; b.bar = bar; b.x = xb_xcc_id(); b.st = st;
    if (threadIdx.x == 0) (void)xb_add(&bar[XB_XCNT(b.x)], 1u);
    return b;
}
__device__ __forceinline__ void xcd_barrier_complete(unsigned* bar, unsigned x, unsigned& nloc, unsigned& nx) {
    const unsigned G = gridDim.x * gridDim.y * gridDim.z;
    unsigned sum, cnt, mine, sp = 0u;
    for (;;) {
        sum = 0u; cnt = 0u; mine = 0u;
#pragma unroll
        for (unsigned j = 0; j < 16; ++j) { const unsigned c = xb_ld(&bar[XB_XCNT(j)]); sum += c; cnt += (c > 0u) ? 1u : 0u; mine = (j == x) ? c : mine; }
        if (sum == G) break;
        __builtin_amdgcn_s_sleep(1);
        if ((++sp & 255u) == 0u) { if (xb_ld(&bar[XB_TMO])) break; if (sp > XB_SPIN_CAP) { atomicAdd(&bar[XB_TMO], 1u); break; } }
    }
    nloc = mine > 0u ? mine : 1u; nx = cnt > 0u ? cnt : 1u;
}
__device__ __forceinline__ void xcd_barrier(const XcdBarrier& b) {
    asm volatile("s_waitcnt vmcnt(0)" ::: "memory");
    __syncthreads();
    if (threadIdx.x == 0) {
        unsigned* bar = b.bar;
        __builtin_amdgcn_s_waitcnt(0);
        unsigned nloc = b.st[0], nx = b.st[1];
        if (nloc == 0u) { xcd_barrier_complete(bar, b.x, nloc, nx); b.st[0] = nloc; b.st[1] = nx; }
        const unsigned old = xb_add(&bar[XB_XSUB(b.x)], 1u);
        const unsigned gen = old / nloc;
        if (old + 1u == (gen + 1u) * nloc) {
            __builtin_amdgcn_fence(__ATOMIC_RELEASE, "agent");
            asm volatile("s_waitcnt vmcnt(0)" ::: "memory");
            const unsigned og = xb_add(&bar[XB_TOP], 1u);
            const unsigned tg = og / nx;
            if (og + 1u == (tg + 1u) * nx) xb_add(&bar[XB_TOPGEN], 1u);
            else XB_SPIN(xb_ld(&bar[XB_TOPGEN]) == tg, bar);
            __builtin_amdgcn_fence(__ATOMIC_ACQUIRE, "agent");
            xb_add(&bar[XB_XGEN(b.x)], 1u);
            asm volatile("s_waitcnt vmcnt(0)" ::: "memory");
        } else {
            XB_SPIN(xb_ld(&bar[XB_XGEN(b.x)]) == gen, bar);
            __builtin_amdgcn_fence(__ATOMIC_ACQUIRE, "agent");
            asm volatile("s_waitcnt vmcnt(0)" ::: "memory");
        }
    }
    __syncthreads();
}

DI size_t tiled_off(int r, int kb, int KB) { return (size_t)(r >> 8) * ((size_t)KB * 256) + (size_t)(kb >> 7) * 32768 + (size_t)(r & 255) * 128 + (kb & 127); }
DI float load_rstd1(const float* ssq, int row, int fq) {
    const f32x4* p = (const f32x4*)(ssq + (size_t)row * 32 + 8 * fq);
    const f32x4 a = p[0], b = p[1];
    float s = ((a[0] + a[1]) + (a[2] + a[3])) + ((b[0] + b[1]) + (b[2] + b[3]));
    s += __shfl_xor(s, 16); s += __shfl_xor(s, 32);
    return __builtin_amdgcn_rsqf(s * (1.0f / D_) + EPS_);
}
#define EPI_FENCE() asm volatile("" ::: "memory")
constexpr float WI8_SCALE = 1250.0f;
template <int NB = 1> DI void row_factors8(const float* ssq, const float* XS, const bool i8, const int row0, const int fq, float (&rq)[8]) {
    __builtin_amdgcn_s_waitcnt(0);
    constexpr int GB = 8 / NB;
#pragma unroll
    for (int b0 = 0; b0 < 8; b0 += GB) {
        f32x4 pa[GB], pb[GB]; float xv[GB], sp[GB], t[GB];
#pragma unroll
        for (int gi = 0; gi < GB; ++gi) { const int row = row0 + ((b0 + gi) >> 2) * 128 + ((b0 + gi) & 3) * 16; const f32x4* p = (const f32x4*)(ssq + (size_t)row * 32 + 8 * fq); pa[gi] = p[0]; pb[gi] = p[1]; xv[gi] = XS[row]; }
        EPI_FENCE();
#pragma unroll
        for (int gi = 0; gi < GB; ++gi) sp[gi] = ((pa[gi][0] + pa[gi][1]) + (pa[gi][2] + pa[gi][3])) + ((pb[gi][0] + pb[gi][1]) + (pb[gi][2] + pb[gi][3]));
#pragma unroll
        for (int gi = 0; gi < GB; ++gi) t[gi] = __shfl_xor(sp[gi], 16);
#pragma unroll
        for (int gi = 0; gi < GB; ++gi) sp[gi] += t[gi];
#pragma unroll
        for (int gi = 0; gi < GB; ++gi) t[gi] = __shfl_xor(sp[gi], 32);
#pragma unroll
        for (int gi = 0; gi < GB; ++gi) { const float r = __builtin_amdgcn_rsqf((sp[gi] + t[gi]) * (1.0f / D_) + EPS_); rq[b0 + gi] = i8 ? r * __builtin_amdgcn_rcpf(xv[gi] * WI8_SCALE) : r; }
        EPI_FENCE();
    }
}

DI float sat8(float v) { return __builtin_amdgcn_fmed3f(v, -448.0f, 448.0f); }
DI unsigned pk4_fp8s(float a, float b, float c, float d) { int w = 0; w = __builtin_amdgcn_cvt_pk_fp8_f32(sat8(a), sat8(b), w, false); w = __builtin_amdgcn_cvt_pk_fp8_f32(sat8(c), sat8(d), w, true); return (unsigned)w; }
DI unsigned pk4_i8(float a, float b, float c, float d) {
    const unsigned ua = __float_as_uint(__builtin_amdgcn_fmed3f(a, -127.f, 127.f) + 12582912.0f), ub = __float_as_uint(__builtin_amdgcn_fmed3f(b, -127.f, 127.f) + 12582912.0f);
    const unsigned uc = __float_as_uint(__builtin_amdgcn_fmed3f(c, -127.f, 127.f) + 12582912.0f), ud = __float_as_uint(__builtin_amdgcn_fmed3f(d, -127.f, 127.f) + 12582912.0f);
    return __builtin_amdgcn_perm(ub, ua, 0x0c0c0400u) | __builtin_amdgcn_perm(ud, uc, 0x04000c0cu); }
constexpr int SC_ONE = 0x7f7f7f7f;
constexpr int SC_W64 = 0x79797979;
constexpr int SC_H8 = 0x7c7c7c7c;

template <int IN8, bool OUT8> struct EpiSwiglu {
    static constexpr bool PERM = true; static constexpr int SCALE_A = SC_ONE, SCALE_B = SC_W64;
    unsigned char* H; const float* ssq; const float* XS;
    DI void operator()(const f32x4 (&acc)[2][2][4][2], const pg8::Unit& u, int wr, int wc, int fr_in, int fq_in) const {
        int fr = fr_in, fq = fq_in; asm volatile("" : "+v"(fr), "+v"(fq));
        const int row0 = u.pm * 256 + wr * 64 + fr;
        const int col0 = u.pn * 128 + wc * 32 + 8 * fq;
        float rqa[8];
        row_factors8(ssq, XS, IN8 == 2, row0, fq, rqa);
#pragma unroll
        for (int ai = 0; ai < 2; ++ai)
#pragma unroll
            for (int m = 0; m < 4; ++m) {
                const int row = row0 + ai * 128 + m * 16;
                const float rq = rqa[ai * 4 + m];
                const float rq_e = rq * -1.4426950408889634f, rq_h = rq * rq * (OUT8 ? 8.0f : 1.0f);
                float h[8];
#pragma unroll
                for (int n = 0; n < 2; ++n)
#pragma unroll
                    for (int e = 0; e < 4; ++e) {
                        const float ag = (IN8 == 2) ? (float)__float_as_int(acc[ai][0][m][n][e]) : acc[ai][0][m][n][e];
                        const float au = (IN8 == 2) ? (float)__float_as_int(acc[ai][1][m][n][e]) : acc[ai][1][m][n][e];
                        const float sg = __builtin_amdgcn_rcpf(1.0f + __builtin_amdgcn_exp2f(ag * rq_e));
                        h[4 * n + e] = (ag * au) * rq_h * sg; }
                if constexpr (OUT8) { u32x2 w; w.x = pk4_fp8s(h[0], h[1], h[2], h[3]); w.y = pk4_fp8s(h[4], h[5], h[6], h[7]); *(u32x2*)(H + tiled_off(row, col0, FF_)) = w; }
                else *(bf16x8*)(H + tiled_off(row, 2 * col0, 2 * FF_)) = pack8(h);
                EPI_FENCE();
            }
    }
};

constexpr float XI8_CLIP = 5.0f;
template <bool F8> struct EpiResid {
    static constexpr bool PERM = true; static constexpr int SCALE_A = SC_H8, SCALE_B = SC_W64;
    const float* base32; float* out32; bf16* XB; unsigned char* X8; const float* ssq_old; float* ssq; float* XS; float coef; int x8i; bool first, last;
    DI void operator()(const f32x4 (&acc)[2][2][4][2], const pg8::Unit& u, int wr, int wc, int fr_in, int fq_in) const {
        int fr = fr_in, fq = fq_in; asm volatile("" : "+v"(fr), "+v"(fq));
        const int row0 = u.pm * 256 + wr * 64 + fr, col0 = u.pn * 256 + wc * 32 + 8 * fq;
        float xsa[8];
        if (x8i == 1) {
            row_factors8<2>(ssq_old, ssq_old, false, row0, fq, xsa);
#pragma unroll
            for (int gi = 0; gi < 8; ++gi) { xsa[gi] *= (127.0f / XI8_CLIP); if (u.pn == 0 && wc == 0 && fq == 0) XS[row0 + (gi >> 2) * 128 + (gi & 3) * 16] = xsa[gi]; }
        } else {
            __builtin_amdgcn_s_waitcnt(0);
#pragma unroll
            for (int gi = 0; gi < 8; ++gi) xsa[gi] = 0.f;
        }
        f32x4 bq[2][2]; u32x4 bw[2];
#define RES_LOADB(gi_) do { const int row_ = row0 + ((gi_) >> 2) * 128 + ((gi_) & 3) * 16; \
            if (first) { _Pragma("unroll") for (int bj = 0; bj < 2; ++bj) _Pragma("unroll") for (int n = 0; n < 2; ++n) bq[bj][n] = *(const f32x4*)(base32 + (size_t)row_ * D_ + col0 + bj * 128 + n * 4); } \
            else { _Pragma("unroll") for (int bj = 0; bj < 2; ++bj) bw[bj] = *(const u32x4*)(XB + (size_t)row_ * D_ + col0 + bj * 128); } } while (0)
        RES_LOADB(0);
#pragma unroll
        for (int ai = 0; ai < 2; ++ai)
#pragma unroll
            for (int m = 0; m < 4; ++m) {
                const int gi = ai * 4 + m;
                const int row = row0 + ai * 128 + m * 16; float s = 0.f;
                const float xs = xsa[gi];
                f32x4 b[2][2];
#pragma unroll
                for (int bj = 0; bj < 2; ++bj) {
                    const f32x4 lo_ = {bf_lo(bw[bj].x), bf_hi(bw[bj].x), bf_lo(bw[bj].y), bf_hi(bw[bj].y)}; const f32x4 hi_ = {bf_lo(bw[bj].z), bf_hi(bw[bj].z), bf_lo(bw[bj].w), bf_hi(bw[bj].w)};
                    b[bj][0] = first ? bq[bj][0] : lo_; b[bj][1] = first ? bq[bj][1] : hi_; }
                EPI_FENCE();
                if (gi < 7) RES_LOADB(gi + 1);
                EPI_FENCE();
#pragma unroll
                for (int bj = 0; bj < 2; ++bj) {
                    const size_t off = (size_t)row * D_ + col0 + bj * 128;
                    const f32x4 v0 = b[bj][0] + coef * acc[ai][bj][m][0], v1 = b[bj][1] + coef * acc[ai][bj][m][1];
                    if (last) { *(f32x4*)(out32 + off) = v0; *(f32x4*)(out32 + off + 4) = v1; }
                    else { u32x4 w; w.x = pk2(v0[0], v0[1]); w.y = pk2(v0[2], v0[3]); w.z = pk2(v1[0], v1[1]); w.w = pk2(v1[2], v1[3]); *(u32x4*)(XB + off) = w; }
                    if (x8i != 0) { u32x2 q;
                        q.x = (x8i == 1) ? pk4_i8(v0[0] * xs, v0[1] * xs, v0[2] * xs, v0[3] * xs) : pk4_fp8s(v0[0], v0[1], v0[2], v0[3]);
                        q.y = (x8i == 1) ? pk4_i8(v1[0] * xs, v1[1] * xs, v1[2] * xs, v1[3] * xs) : pk4_fp8s(v1[0], v1[1], v1[2], v1[3]);
                        *(u32x2*)(X8 + off) = q; }
                    s += ((v0[0] * v0[0] + v0[1] * v0[1]) + (v0[2] * v0[2] + v0[3] * v0[3])) + ((v1[0] * v1[0] + v1[1] * v1[1]) + (v1[2] * v1[2] + v1[3] * v1[3]));
                }
                s += __shfl_xor(s, 16); s += __shfl_xor(s, 32);
                if (fq == 0) ssq[(size_t)row * 32 + u.pn * 4 + wc] = s;
                EPI_FENCE();
            }
#undef RES_LOADB
    }
};

DI f32x4 acc_f(const f32x4 a, const bool i8) { f32x4 o;
#pragma unroll
    for (int e = 0; e < 4; ++e) o[e] = i8 ? (float)__float_as_int(a[e]) : a[e];
    return o; }
struct EpiDsaEx {
    static constexpr bool PERM = true; static constexpr int SCALE_A = SC_ONE, SCALE_B = SC_W64;
    float* EXP; const float* ssq; const float* XS; bool i8;
    DI void operator()(const f32x4 (&acc)[2][2][4][2], const pg8::Unit& u, int wr, int wc, int fr_in, int fq_in) const {
        int fr = fr_in, fq = fq_in; asm volatile("" : "+v"(fr), "+v"(fq));
        const int row0 = u.pm * 256 + wr * 64 + fr, col0 = wc * 32 + 8 * fq;
        float rqa[8]; row_factors8<2>(ssq, XS, i8, row0, fq, rqa);
#pragma unroll
        for (int ai = 0; ai < 2; ++ai)
#pragma unroll
            for (int m = 0; m < 4; ++m) {
                const int row = row0 + ai * 128 + m * 16;
                const float r = rqa[ai * 4 + m];
                float* p = EXP + ((size_t)u.pn * S_ + row) * EX_LD + col0;
                *(f32x4*)p = acc_f(acc[ai][0][m][0], i8) * r; *(f32x4*)(p + 4) = acc_f(acc[ai][0][m][1], i8) * r;
                EPI_FENCE();
            }
    }
};
struct EpiDsaIn {
    static constexpr bool PERM = true; static constexpr int SCALE_A = SC_ONE, SCALE_B = SC_W64;
    bf16* PROJ; const float* ssq; const float* XS; bool i8;
    DI void operator()(const f32x4 (&acc)[2][2][4][2], const pg8::Unit& u, int wr, int wc, int fr_in, int fq_in) const {
        int fr = fr_in, fq = fq_in; asm volatile("" : "+v"(fr), "+v"(fq));
        const int row0 = u.pm * 256 + wr * 64 + fr;
        const int col0 = u.pn * 256 + wc * 32 + 8 * fq;
        float rqa[8]; row_factors8<2>(ssq, XS, i8, row0, fq, rqa);
#pragma unroll
        for (int ai = 0; ai < 2; ++ai)
#pragma unroll
            for (int m = 0; m < 4; ++m) {
                const int row = row0 + ai * 128 + m * 16;
                const float r = rqa[ai * 4 + m];
#pragma unroll
                for (int bj = 0; bj < 2; ++bj) {
                    const f32x4 v0 = acc_f(acc[ai][bj][m][0], i8) * r, v1 = acc_f(acc[ai][bj][m][1], i8) * r;
                    float h[8] = {v0[0], v0[1], v0[2], v0[3], v1[0], v1[1], v1[2], v1[3]};
                    *(bf16x8*)(PROJ + (size_t)row * PROJ_LD + col0 + bj * 128) = pack8(h);
                }
                EPI_FENCE();
            }
    }
};

template <int T> struct EpiHgrnIn {
    static constexpr bool PERM = true; static constexpr int SCALE_A = SC_ONE, SCALE_B = SC_W64;
    bf16* O; float* F; const float* ssq; const float* lb; const float* XS; bool i8;
    DI void operator()(const f32x4 (&acc)[2][2][4][2], const pg8::Unit& u, int wr, int wc, int fr_in, int fq_in) const {
        int fr = fr_in, fq = fq_in; asm volatile("" : "+v"(fr), "+v"(fq));
        const int row0 = u.pm * 256 + wr * 64 + fr;
        const int col0 = u.pn * 256 + wc * 32 + 8 * fq;
        float rqa[8]; row_factors8<2>(ssq, XS, i8, row0, fq, rqa);
#pragma unroll
        for (int ai = 0; ai < 2; ++ai)
#pragma unroll
            for (int m = 0; m < 4; ++m) {
                const int row = row0 + ai * 128 + m * 16;
                const float r = rqa[ai * 4 + m];
#pragma unroll
                for (int bj = 0; bj < 2; ++bj) {
                    float v[8]; const f32x4 a0 = acc_f(acc[ai][bj][m][0], i8), a1 = acc_f(acc[ai][bj][m][1], i8);
#pragma unroll
                    for (int e = 0; e < 4; ++e) { v[e] = a0[e] * r; v[4 + e] = a1[e] * r; }
                    const int col = col0 + bj * 128;
                    if constexpr (T == 1) {
                        const f32x4 l0 = *(const f32x4*)(lb + col), l1 = *(const f32x4*)(lb + col + 4);
                        float kq[8];
#pragma unroll
                        for (int e = 0; e < 4; ++e) { kq[e] = (1.0f - l0[e]) * sigmoid_f(-v[e]); kq[4 + e] = (1.0f - l1[e]) * sigmoid_f(-v[4 + e]); }
                        u32x4 w; w.x = pkh2(kq[0], kq[1]); w.y = pkh2(kq[2], kq[3]); w.z = pkh2(kq[4], kq[5]); w.w = pkh2(kq[6], kq[7]);
                        *(u32x4*)((unsigned short*)F + (size_t)row * D_ + col) = w;
                    } else {
#pragma unroll
                        for (int e = 0; e < 8; ++e) v[e] = (T == 0) ? v[e] * 0.08838834764831845f : silu_f(v[e]);
                        *(bf16x8*)(O + (size_t)row * D_ + col) = pack8(v);
                    }
                }
                EPI_FENCE();
            }
    }
};

struct EpiHgrnVT {
    static constexpr bool PERM = true; static constexpr int SCALE_A = SC_W64, SCALE_B = SC_ONE;
    bf16* VT; const LAS float* tab; bool i8;
    DI void operator()(const f32x4 (&acc)[2][2][4][2], const pg8::Unit& u, int wr, int wc, int fr_in, int fq_in) const {
        int fr = fr_in, fq = fq_in; asm volatile("" : "+v"(fr), "+v"(fq));
        const int row0 = u.pm * 256 + wr * 64 + fr, cl = wc * 32 + 8 * fq;
#pragma unroll
        for (int bj = 0; bj < 2; ++bj) {
            const f32x4 r0 = *(const LAS f32x4*)(tab + cl + bj * 128), r1 = *(const LAS f32x4*)(tab + cl + bj * 128 + 4);
#pragma unroll
            for (int ai = 0; ai < 2; ++ai)
#pragma unroll
                for (int m = 0; m < 4; ++m) {
                    float h[8];
                    const f32x4 a0 = acc_f(acc[ai][bj][m][0], i8), a1 = acc_f(acc[ai][bj][m][1], i8);
#pragma unroll
                    for (int e = 0; e < 4; ++e) { h[e] = a0[e] * r0[e]; h[4 + e] = a1[e] * r1[e]; }
                    *(bf16x8*)(VT + (size_t)(row0 + ai * 128 + m * 16) * S_ + u.pn * 256 + cl + bj * 128) = pack8(h);
                }
        }
    }
};

DI float wave_sum(float v) {
#pragma unroll
    for (int o = 1; o < 64; o <<= 1) v += __shfl_xor(v, o);
    return v;
}
template <int MAP> DI int map_row(int n) {
    if (MAP == 1) return 256 * (n >> 7) + (n & 127);
    if (MAP == 2) return 256 * (n >> 7) + (n & 127) + 128;
    if (MAP == 3) return n < 4096 ? n : (n < 6144 ? n + 2048 : n - 2048);
    return n;
}
constexpr int P0_PITCH = 66;
template <int MAP, int F8> DI void cvt_tile(const float* __restrict__ W, int ldw, int ncols, const float* __restrict__ gain, unsigned char* __restrict__ WT, int K, int n0, int k0, int lane, LAS unsigned short* scr) {
    constexpr int KT = F8 ? 128 : 64;
    const int q = lane & 15, kr = lane >> 4;
    int nc = n0 + 4 * q; nc = nc < ncols - 4 ? nc : ncols - 4;
    const float* src = W + (size_t)(k0 + kr) * ldw + nc;
    const float gs = F8 == 1 ? 64.0f : (F8 == 2 ? WI8_SCALE : 1.0f);
#pragma unroll
    for (int h = 0; h < KT / 64; ++h) {
        f32x4 v[16];
#pragma unroll
        for (int i = 0; i < 16; ++i) v[i] = __builtin_nontemporal_load((const f32x4*)(src + (size_t)(64 * h + 4 * i) * ldw));
#pragma unroll
        for (int i = 0; i < 16; ++i) {
            const int k = 64 * h + 4 * i + kr;
            const float gk = gain ? gain[k0 + k] * gs : gs;
            LAS unsigned* d = (LAS unsigned*)(scr + k * P0_PITCH + 4 * q);
            d[0] = pk2(v[i][0] * gk, v[i][1] * gk); d[1] = pk2(v[i][2] * gk, v[i][3] * gk);
        }
    }
    LDS_WAIT();
    const int nl = lane >> 3, c = lane & 7;
#pragma unroll
    for (int jj = 0; jj < 8; ++jj) {
        const int n = 8 * jj + nl;
        const int row = map_row<MAP>(n0 + n);
        if constexpr (F8) {
            const LAS unsigned short* sp = scr + (16 * c) * P0_PITCH + n;
            float f[16];
#pragma unroll
            for (int i = 0; i < 16; ++i) f[i] = __uint_as_float((unsigned)sp[i * P0_PITCH] << 16);
            u32x4 o;
            if constexpr (F8 == 2) { o.x = pk4_i8(f[0], f[1], f[2], f[3]); o.y = pk4_i8(f[4], f[5], f[6], f[7]); o.z = pk4_i8(f[8], f[9], f[10], f[11]); o.w = pk4_i8(f[12], f[13], f[14], f[15]); }
            else { o.x = pk4_fp8s(f[0], f[1], f[2], f[3]); o.y = pk4_fp8s(f[4], f[5], f[6], f[7]); o.z = pk4_fp8s(f[8], f[9], f[10], f[11]); o.w = pk4_fp8s(f[12], f[13], f[14], f[15]); }
            *(u32x4*)(WT + tiled_off(row, k0 + 16 * c, K)) = o;
        } else {
            const LAS unsigned short* sp = scr + (8 * c) * P0_PITCH + n;
            unsigned e[8];
#pragma unroll
            for (int i = 0; i < 8; ++i) e[i] = sp[i * P0_PITCH];
            u32x4 o; o.x = e[0] | (e[1] << 16); o.y = e[2] | (e[3] << 16); o.z = e[4] | (e[5] << 16); o.w = e[6] | (e[7] << 16);
            *(u32x4*)(WT + tiled_off(row, (k0 + 8 * c) * 2, K * 2)) = o;
        }
    }
    LDS_WAIT();
}

struct Args {
    const float* in[15]; float* out; unsigned char* ws; int ph_lo, ph_hi;
};

constexpr int DEF8 = 1024, DEF16 = 2048;
DI void p0_deferred_down(const Args& a, LAS unsigned char* lds, int f, int widx, int nw, int lane, int wave) {
    LAS unsigned short* scr = (LAS unsigned short*)(lds + wave * 17408);
    const bool f8 = ((DN8_MASK >> f) & 1) != 0;
    const int cnt = f8 ? 1408 : 2816, def = f8 ? DEF8 : DEF16;
    const float* W = a.in[4] + (size_t)f * FF_ * D_; unsigned char* WT = a.ws + WS_WD + (size_t)f * SZ_WD;
    for (int r = cnt - def + widx; r < cnt; r += nw) {
        const int kb = r / 32, nb = r % 32;
        if (f8) cvt_tile<0, 1>(W, D_, D_, nullptr, WT, FF_, nb * 64, kb * 128, lane, scr);
        else cvt_tile<0, 0>(W, D_, D_, nullptr, WT, FF_, nb * 64, kb * 64, lane, scr);
    }
}
DI void p0_prologue(const Args& a, LAS unsigned char* lds, int gw, int NGW, int lane, int wave) {
    unsigned char* ws = a.ws;
    const float* ng = a.in[1];
    LAS unsigned short* scr = (LAS unsigned short*)(lds + wave * 17408);
    constexpr int NT_DIN = 66 * 32, NT_O = 32 * 32, NT_HIN = 128 * 32;
    int n_ffn = 0;
#pragma unroll
    for (int m = 0; m < 24; ++m) { const bool f8m = ((((m >> 3) < 2 ? (GU8_MASK | GUI8_MASK) : DN8_MASK) >> (m & 7)) & 1) != 0; n_ffn += (f8m ? 1408 : 2816) - ((m >> 3) == 2 ? (f8m ? DEF8 : DEF16) : 0); }
    const int NITEMS = n_ffn + 2 * (NT_DIN + NT_O + NT_HIN + NT_O);
    for (int it = gw; it < NITEMS; it += NGW) {
        int r = it;
        if (r < n_ffn) {
            int m = 0; bool f8 = false;
            for (; m < 24; ++m) { f8 = ((((m >> 3) < 2 ? (GU8_MASK | GUI8_MASK) : DN8_MASK) >> (m & 7)) & 1) != 0; const int cnt = (f8 ? 1408 : 2816) - ((m >> 3) == 2 ? (f8 ? DEF8 : DEF16) : 0); if (r < cnt) break; r -= cnt; }
            const int f = m & 7, kind = m >> 3;
            if (kind < 2) {
                const int kb = r / 88, nb = r % 88;
                const float* W = a.in[2 + kind] + (size_t)f * D_ * FF_;
                const float* gain = ng + (size_t)((f >> 1) * 3 + ((f & 1) ? 2 : 0)) * D_;
                unsigned char* WT = ws + WS_WGU + (size_t)f * SZ_WGU;
                if (f8 && ((GUI8_MASK >> f) & 1)) { if (kind == 0) cvt_tile<1, 2>(W, FF_, FF_, gain, WT, D_, nb * 64, kb * 128, lane, scr); else cvt_tile<2, 2>(W, FF_, FF_, gain, WT, D_, nb * 64, kb * 128, lane, scr); }
                else if (f8) { if (kind == 0) cvt_tile<1, 1>(W, FF_, FF_, gain, WT, D_, nb * 64, kb * 128, lane, scr); else cvt_tile<2, 1>(W, FF_, FF_, gain, WT, D_, nb * 64, kb * 128, lane, scr); }
                else { if (kind == 0) cvt_tile<1, 0>(W, FF_, FF_, gain, WT, D_, nb * 64, kb * 64, lane, scr); else cvt_tile<2, 0>(W, FF_, FF_, gain, WT, D_, nb * 64, kb * 64, lane, scr); }
            } else {
                const int kb = r / 32, nb = r % 32;
                const float* W = a.in[4] + (size_t)f * FF_ * D_; unsigned char* WT = ws + WS_WD + (size_t)f * SZ_WD;
                if (f8) cvt_tile<0, 1>(W, D_, D_, nullptr, WT, FF_, nb * 64, kb * 128, lane, scr);
                else cvt_tile<0, 0>(W, D_, D_, nullptr, WT, FF_, nb * 64, kb * 64, lane, scr);
            }
            continue;
        }
        r -= n_ffn;
        if (r < 2 * NT_DIN) { const int j = r / NT_DIN; r %= NT_DIN; const int kb = r / 66, nb = r % 66;
            if ((MIX8_MASK >> (2 * j)) & 1) { if ((kb & 1) == 0) cvt_tile<0, 2>(a.in[5] + (size_t)j * D_ * A_IN, A_IN, A_IN, ng + (size_t)((2 * j) * 3 + 1) * D_, ws + WS_DWIN + (size_t)j * SZ_DWIN, D_, nb * 64, kb * 64, lane, scr); }
            else cvt_tile<0, 0>(a.in[5] + (size_t)j * D_ * A_IN, A_IN, A_IN, ng + (size_t)((2 * j) * 3 + 1) * D_, ws + WS_DWIN + (size_t)j * SZ_DWIN, D_, nb * 64, kb * 64, lane, scr);
            continue; }
        r -= 2 * NT_DIN;
        if (r < 2 * NT_O) { const int j = r / NT_O; r %= NT_O; const int kb = r / 32, nb = r % 32;
            cvt_tile<0, 0>(a.in[6] + (size_t)j * D_ * D_, D_, D_, nullptr, ws + WS_DWO + (size_t)j * SZ_WO, D_, nb * 64, kb * 64, lane, scr); continue; }
        r -= 2 * NT_O;
        if (r < 2 * NT_HIN) { const int j = r / NT_HIN; r %= NT_HIN; const int kb = r / 128, nb = r % 128;
            if ((MIX8_MASK >> (2 * j + 1)) & 1) { if ((kb & 1) == 0) cvt_tile<3, 2>(a.in[11] + (size_t)j * D_ * 4 * D_, 4 * D_, 4 * D_, ng + (size_t)((2 * j + 1) * 3 + 1) * D_, ws + WS_HWIN + (size_t)j * SZ_HWIN, D_, nb * 64, kb * 64, lane, scr); }
            else cvt_tile<3, 0>(a.in[11] + (size_t)j * D_ * 4 * D_, 4 * D_, 4 * D_, ng + (size_t)((2 * j + 1) * 3 + 1) * D_, ws + WS_HWIN + (size_t)j * SZ_HWIN, D_, nb * 64, kb * 64, lane, scr);
            continue; }
        r -= 2 * NT_HIN;
        { const int j = r / NT_O; r %= NT_O; const int kb = r / 32, nb = r % 32;
            cvt_tile<0, 0>(a.in[12] + (size_t)j * D_ * D_, D_, D_, nullptr, ws + WS_HWO + (size_t)j * SZ_WO, D_, nb * 64, kb * 64, lane, scr); }
    }
    const float* x = a.in[0]; bf16* XB = (bf16*)(ws + WS_XB); float* ssq = (float*)(ws + WS_SSQ); float* XS = (float*)(ws + WS_XS);
    for (int m = gw; m < S_; m += NGW) {
        const f32x4* xr = (const f32x4*)(x + (size_t)m * D_) + lane; float s = 0.f;
        u32x2* o8 = (u32x2*)(XB + (size_t)m * D_) + lane; unsigned* o4 = (unsigned*)(ws + WS_X8 + (size_t)m * D_) + lane;
        f32x4 v[8];
#pragma unroll
        for (int j = 0; j < 8; ++j) { v[j] = xr[64 * j]; s += (v[j][0] * v[j][0] + v[j][1] * v[j][1]) + (v[j][2] * v[j][2] + v[j][3] * v[j][3]); }
        s = wave_sum(s);
        const float xs = __builtin_amdgcn_rsqf(s * (1.0f / D_) + EPS_) * (127.0f / XI8_CLIP);
#pragma unroll
        for (int j = 0; j < 8; ++j) {
            if (((GUI8_MASK | GU8_MASK) & 1) == 0) { u32x2 w; w.x = pk2(v[j][0], v[j][1]); w.y = pk2(v[j][2], v[j][3]); o8[64 * j] = w; }
            else o4[64 * j] = (GUI8_MASK & 1) ? pk4_i8(v[j][0] * xs, v[j][1] * xs, v[j][2] * xs, v[j][3] * xs) : pk4_fp8s(v[j][0], v[j][1], v[j][2], v[j][3]); }
        if (lane < 32) ssq[(size_t)m * 32 + lane] = (lane == 0) ? s : 0.f;
        if (lane == 0) XS[m] = xs;
    }
    const float* lg = a.in[13]; float* LB = (float*)(ws + WS_LB);
    for (int c = gw * 64 + lane; c < D_; c += NGW * 64) {
        const float l0 = lg[c], l1 = lg[D_ + c], l2 = lg[2 * D_ + c], l3 = lg[3 * D_ + c];
        const float mx = fmaxf(fmaxf(l0, l1), fmaxf(l2, l3));
        const float e0 = expf(l0 - mx), e1 = expf(l1 - mx), e2 = expf(l2 - mx), e3 = expf(l3 - mx), inv = 1.0f / (e0 + e1 + e2 + e3);
        LB[c] = e1 * inv; LB[D_ + c] = (e1 + e2 + e3) * inv;
    }
}

DI unsigned pk4_fp8(float a, float b, float c, float d) { int w = 0; w = __builtin_amdgcn_cvt_pk_fp8_f32(a, b, w, false); w = __builtin_amdgcn_cvt_pk_fp8_f32(c, d, w, true); return (unsigned)w; }
DI void dsa_prep(unsigned char* ws, const float* qg, const float* kg, const float* ikg, int gw, int NGW, int lane) {
    const bf16* PROJ = (const bf16*)(ws + WS_R + R_PROJ); const float* EX = (const float*)(ws + WS_R + R_EX);
    bf16* IKN = (bf16*)(ws + WS_R + R_IKN); float* IWS = (float*)(ws + WS_R + R_IWS);
    unsigned char* Q8 = ws + WS_R + R_Q8; unsigned char* K8 = ws + WS_R + R_K8; unsigned char* V8 = ws + WS_R + R_V8;
    for (int t = gw; t < S_; t += NGW) {
        const bf16* row = PROJ + (size_t)t * PROJ_LD;
        u32x4 wq_[4];
#pragma unroll
        for (int i = 0; i < 4; ++i) wq_[i] = *(const u32x4*)(row + lane * 32 + 8 * i);
        const u32x4 wk_ = *(const u32x4*)(row + 2048 + lane * 8), wv_ = *(const u32x4*)(row + 2560 + lane * 8);
        float exv_[8], exw_[8];
#pragma unroll
        for (int sl = 0; sl < 8; ++sl) { const float* ex = EX + ((size_t)sl * S_ + t) * EX_LD; exv_[sl] = ex[lane]; exw_[sl] = ex[64 + (lane & 15)]; }
        EPI_FENCE();
        {
            u32x4 w[4]; float v[32]; float s = 0.f;
#pragma unroll
            for (int i = 0; i < 4; ++i) { w[i] = wq_[i]; unpack8(w[i], v + 8 * i); }
#pragma unroll
            for (int i = 0; i < 32; ++i) s += v[i] * v[i];
            s += __shfl_xor(s, 1); s += __shfl_xor(s, 2);
            const float r = __builtin_amdgcn_rsqf(s * (1.0f / 128.0f) + EPS_);
            const int d0 = (lane & 3) * 32;
#pragma unroll
            for (int i = 0; i < 32; ++i) v[i] = v[i] * r * qg[d0 + i];
#pragma unroll
            for (int i = 0; i < 2; ++i) { u32x4 o; o.x = pk4_fp8(v[16 * i], v[16 * i + 1], v[16 * i + 2], v[16 * i + 3]); o.y = pk4_fp8(v[16 * i + 4], v[16 * i + 5], v[16 * i + 6], v[16 * i + 7]);
                o.z = pk4_fp8(v[16 * i + 8], v[16 * i + 9], v[16 * i + 10], v[16 * i + 11]); o.w = pk4_fp8(v[16 * i + 12], v[16 * i + 13], v[16 * i + 14], v[16 * i + 15]);
                *(u32x4*)(Q8 + (size_t)t * 2048 + lane * 32 + 16 * i) = o; }
        }
        {
            float v[8]; float s = 0.f; unpack8(wk_, v);
#pragma unroll
            for (int i = 0; i < 8; ++i) s += v[i] * v[i];
            s += __shfl_xor(s, 1); s += __shfl_xor(s, 2); s += __shfl_xor(s, 4); s += __shfl_xor(s, 8);
            const float r = __builtin_amdgcn_rsqf(s * (1.0f / 128.0f) + EPS_);
            const int d0 = (lane & 15) * 8;
#pragma unroll
            for (int i = 0; i < 8; ++i) v[i] = v[i] * r * kg[d0 + i];
            u32x2 o; o.x = pk4_fp8(v[0], v[1], v[2], v[3]); o.y = pk4_fp8(v[4], v[5], v[6], v[7]);
            *(u32x2*)(K8 + (size_t)t * 512 + lane * 8) = o;
        }
        {
            float v[8]; unpack8(wv_, v);
            u32x2 o; o.x = pk4_fp8(v[0], v[1], v[2], v[3]); o.y = pk4_fp8(v[4], v[5], v[6], v[7]);
            *(u32x2*)(V8 + (size_t)t * 512 + lane * 8) = o;
        }
        {
            float v = 0.f, wv = 0.f;
#pragma unroll
            for (int sl = 0; sl < 8; ++sl) { v += exv_[sl]; wv += exw_[sl]; }
            const float s = wave_sum(v * v);
            const float r = __builtin_amdgcn_rsqf(s * (1.0f / 64.0f) + EPS_);
            const float o = v * r * ikg[lane]; const float o2 = __shfl_xor(o, 1);
            if ((lane & 1) == 0) *(unsigned*)(IKN + (size_t)(t >> 5) * 2048 + (lane >> 4) * 512 + ((lane >> 3) & 1) * 256 + (t & 31) * 8 + (lane & 7)) = pk2(o, o2);
            if (lane < 16) IWS[(size_t)t * 16 + lane] = wv * 0.03125f;
        }
    }
}

DI unsigned okey(float f) { const unsigned u = __float_as_uint(f); return (u & 0x80000000u) ? ~u : (u | 0x80000000u); }

DI unsigned short okey16(float f) { const _Float16 h = (_Float16)f; const unsigned short u = __builtin_bit_cast(unsigned short, h); return (unsigned short)((u & 0x8000u) ? ~u : (u | 0x8000u)); }
DI void digit_search(LAS unsigned* hist, unsigned need, int lane, unsigned& dig, unsigned& nn) {
    unsigned c[4]; unsigned s4 = 0u;
#pragma unroll
    for (int i = 0; i < 4; ++i) { c[i] = hist[255 - (4 * lane + i)]; s4 += c[i]; }
    unsigned incl = s4;
#pragma unroll
    for (int d = 1; d < 64; d <<= 1) { const unsigned x = __shfl_up(incl, d); if (lane >= d) incl += x; }
    const unsigned excl = incl - s4;
    const bool hit = excl < need && need <= incl;
    unsigned run = excl, dd = 0u, n2 = 0u; bool found = false;
#pragma unroll
    for (int i = 0; i < 4; ++i) { if (!found && run + c[i] >= need) { dd = 255u - (unsigned)(4 * lane + i); n2 = need - run; found = true; } run += c[i]; }
    const unsigned long long hb = __ballot(hit);
    const int src = hb ? (__ffsll((long long)hb) - 1) : 0;
    dig = (unsigned)__builtin_amdgcn_readlane((int)dd, src); nn = (unsigned)__builtin_amdgcn_readlane((int)n2, src);
}
DI float relu_i(float x) { const int xi = __builtin_bit_cast(int, x); return __builtin_bit_cast(float, xi > 0 ? xi : 0); }
DI void dsa_select(unsigned char* ws, LAS unsigned char* lds, int tid, int lane, int wave, int bid, int G, int score_only) {
    const bf16* PROJ = (const bf16*)(ws + WS_R + R_PROJ); const bf16* IKN = (const bf16*)(ws + WS_R + R_IKN); const float* IWS = (const float*)(ws + WS_R + R_IWS);
    int* SELG = (int*)(ws + WS_R + R_SEL);
    LAS unsigned short* SC = (LAS unsigned short*)lds;
    LAS unsigned* HIST = (LAS unsigned*)(lds + LDS_AUX);
    for (int wi = bid; wi < S_ / 8; wi += G) {
        const int rr = wi >> 8, ww = wi & 255, u = (rr << 8) + ((rr & 1) ? 255 - ww : ww);
        const int t0 = 8 * u;
        {
            const int rho = lane & 31, hf = lane >> 5, qq = (rho >> 2) & 1, hh = (rho & 3) + 4 * (rho >> 3);
            bf16x8 afr[4][4];
#pragma unroll
            for (int rt = 0; rt < 4; ++rt)
#pragma unroll
                for (int ks = 0; ks < 4; ++ks) afr[rt][ks] = *(const bf16x8*)(PROJ + (size_t)(t0 + 2 * rt + qq) * PROJ_LD + 3072 + hh * 64 + 16 * ks + 8 * hf);
            f32x4 wv[4][4];
#pragma unroll
            for (int rt = 0; rt < 4; ++rt)
#pragma unroll
                for (int i4 = 0; i4 < 4; ++i4) wv[rt][i4] = *(const f32x4*)(IWS + (size_t)(t0 + 2 * rt + hf) * 16 + 4 * i4);
            const int ntiles = (t0 + 8 + 31) >> 5;
            const bf16* ikb = IKN + lane * 8;
            bf16x8 b0[4], b1[4], b2[4];
#define SEL_LOADB(B, KT) do { int k_ = (KT); k_ = k_ < ntiles ? k_ : ntiles - 1; _Pragma("unroll") for (int ks = 0; ks < 4; ++ks) B[ks] = *(const bf16x8*)(ikb + (size_t)k_ * 2048 + ks * 512); } while (0)
#define SEL_FMA(S, W, R) asm("v_fma_f32 %0, %1, %2, %0" : "+v"(S) : "v"(W), "v"(R))
#define SEL_TILE(B, KT) do { const int key = 32 * (KT) + (lane & 31); float sc4[4]; \
                _Pragma("unroll") for (int rt = 0; rt < 4; ++rt) { f32x16 acc; \
                    _Pragma("unroll") for (int i = 0; i < 16; ++i) acc[i] = 0.f; \
                    _Pragma("unroll") for (int ks = 0; ks < 4; ++ks) acc = MFMA32(afr[rt][ks], B[ks], acc); \
                    float s0 = 0.f, s1 = 0.f; \
                    _Pragma("unroll") for (int i4 = 0; i4 < 4; ++i4) { \
                        SEL_FMA(s0, wv[rt][i4][0], relu_i(acc[4 * i4])); SEL_FMA(s1, wv[rt][i4][1], relu_i(acc[4 * i4 + 1])); \
                        SEL_FMA(s0, wv[rt][i4][2], relu_i(acc[4 * i4 + 2])); SEL_FMA(s1, wv[rt][i4][3], relu_i(acc[4 * i4 + 3])); } \
                    sc4[rt] = s0 + s1; } \
                _Pragma("unroll") for (int rt = 0; rt < 4; ++rt) SC[(2 * rt + hf) * 8192 + key] = okey16(sc4[rt]); } while (0)
            EPI_FENCE();
            SEL_LOADB(b0, wave); EPI_FENCE(); SEL_LOADB(b1, wave + 8); EPI_FENCE(); SEL_LOADB(b2, wave + 16); EPI_FENCE();
            int kt = wave;
            for (; kt + 16 < ntiles; kt += 24) {
                SEL_TILE(b0, kt); EPI_FENCE(); SEL_LOADB(b0, kt + 24); EPI_FENCE();
                SEL_TILE(b1, kt + 8); EPI_FENCE(); SEL_LOADB(b1, kt + 32); EPI_FENCE();
                SEL_TILE(b2, kt + 16); EPI_FENCE(); SEL_LOADB(b2, kt + 40); EPI_FENCE();
            }
            if (kt < ntiles) { SEL_TILE(b0, kt); EPI_FENCE(); if (kt + 8 < ntiles) { SEL_TILE(b1, kt + 8); } }
        }
        __syncthreads();
        if (!score_only) {
            const int t = t0 + wave, n = t + 1;
            LAS unsigned short* sc = SC + wave * 8192; LAS unsigned* hist = HIST + wave * 256;
            const LAS unsigned* sc2 = (const LAS unsigned*)sc;
            int* selg = SELG + (size_t)t * TOPK;
            if (n <= TOPK) {
#pragma unroll
                for (int i = 0; i < 4; ++i) { const int p = lane + 64 * i; selg[p] = p < n ? p : 0; }
            } else {
                const int nw2 = (n + 1) >> 1;
#pragma unroll
                for (int i = 0; i < 4; ++i) hist[lane + 64 * i] = 0u;
                for (int i0 = 0; i0 < nw2; i0 += 64) { const int i = i0 + lane; if (i < nw2) { const unsigned wd = sc2[i];
                        __hip_atomic_fetch_add(&hist[(wd >> 8) & 255u], 1u, __ATOMIC_RELAXED, __HIP_MEMORY_SCOPE_WORKGROUP);
                        if (2 * i + 1 < n) __hip_atomic_fetch_add(&hist[wd >> 24], 1u, __ATOMIC_RELAXED, __HIP_MEMORY_SCOPE_WORKGROUP); } }
                LDS_WAIT();
                unsigned dA, need; digit_search(hist, TOPK, lane, dA, need);
#pragma unroll
                for (int i = 0; i < 4; ++i) hist[lane + 64 * i] = 0u;
                for (int i0 = 0; i0 < nw2; i0 += 64) { const int i = i0 + lane; if (i < nw2) { const unsigned wd = sc2[i];
                        if (((wd >> 8) & 255u) == dA) __hip_atomic_fetch_add(&hist[wd & 255u], 1u, __ATOMIC_RELAXED, __HIP_MEMORY_SCOPE_WORKGROUP);
                        if (2 * i + 1 < n && (wd >> 24) == dA) __hip_atomic_fetch_add(&hist[(wd >> 16) & 255u], 1u, __ATOMIC_RELAXED, __HIP_MEMORY_SCOPE_WORKGROUP); } }
                LDS_WAIT();
                unsigned dB, need_eq; digit_search(hist, need, lane, dB, need_eq);
                const unsigned T = (dA << 8) | dB;
                unsigned goff = 0u, eoff = 0u; const unsigned gtot = TOPK - need_eq;
                LAS int* rowb = (LAS int*)(lds + LDS_AUX + 8192) + wave * 256;
                const unsigned long long ltm = (1ull << lane) - 1ull;
                for (int i0 = 0; i0 < nw2; i0 += 64) { const int i = i0 + lane; const bool v0 = i < nw2, v1 = v0 && (2 * i + 1 < n); const unsigned wd = v0 ? sc2[i] : 0u;
                    const unsigned k0 = wd & 0xffffu, k1 = wd >> 16;
                    const bool g0 = v0 && k0 > T, g1 = v1 && k1 > T, e0 = v0 && k0 == T, e1 = v1 && k1 == T;
                    const unsigned long long bg0 = __ballot(g0), bg1 = __ballot(g1), be0 = __ballot(e0), be1 = __ballot(e1);
                    const unsigned pg = goff + (unsigned)__popcll(bg0 & ltm) + (unsigned)__popcll(bg1 & ltm);
                    if (g0) rowb[pg] = 2 * i;
                    if (g1) rowb[pg + (g0 ? 1u : 0u)] = 2 * i + 1;
                    const unsigned pe = eoff + (unsigned)__popcll(be0 & ltm) + (unsigned)__popcll(be1 & ltm);
                    if (e0 && pe < need_eq) rowb[gtot + pe] = 2 * i;
                    if (e1 && pe + (e0 ? 1u : 0u) < need_eq) rowb[gtot + pe + (e0 ? 1u : 0u)] = 2 * i + 1;
                    goff += (unsigned)__popcll(bg0) + (unsigned)__popcll(bg1); eoff += (unsigned)__popcll(be0) + (unsigned)__popcll(be1); }
                LDS_WAIT();
                *(i32x4*)(selg + 4 * lane) = *(const LAS i32x4*)(rowb + 4 * lane);
            }
        }
        __syncthreads();
    }
}

DI bf16x8 tr_read2(unsigned a0, unsigned a1) {
    s16x4 lo, hi;
    asm volatile("ds_read_b64_tr_b16 %0, %2\n\tds_read_b64_tr_b16 %1, %3\n\ts_waitcnt lgkmcnt(0)" : "=&v"(lo), "=&v"(hi) : "v"(a0), "v"(a1) : "memory");
    return (bf16x8){lo[0], lo[1], lo[2], lo[3], hi[0], hi[1], hi[2], hi[3]};
}
DI void dsa_attend(unsigned char* ws, const float* relb, LAS unsigned char* lds, int tid, int lane, int wave, int jl) {
    const unsigned char* Q8 = ws + WS_R + R_Q8; const unsigned char* K8 = ws + WS_R + R_K8; const unsigned char* V8 = ws + WS_R + R_V8;
    const int* SELG = (const int*)(ws + WS_R + R_SEL);
    bf16* AO = (bf16*)(ws + WS_AO);
    unsigned* wq = (unsigned*)(ws + WS_CTL) + CW_WQ + 256 * jl;
    LAS int* SELL = (LAS int*)lds;
    LAS unsigned char* VBUF = lds + 8192;
    LAS float* BIAS = (LAS float*)(lds + 8192 + 131072);
    for (int i = tid; i < 129 * 16; i += NTHREADS) { const int d = i >> 4; int b = d; if (d >= 16) { b = 16 + (int)(logf((float)d * (1.0f / 16.0f)) / 2.0794415416798357f * 16.0f); b = b < 31 ? b : 31; }
        BIAS[i] = relb[b * 16 + (i & 15)]; }
    __syncthreads();
    LAS int* sel = SELL + wave * 256; LAS unsigned char* vbuf = VBUF + wave * 16384;
    const int g = lane & 15, kg = lane >> 4;
    LAS int* selg = sel + g; LAS int* selk = sel + 4 * kg;
    const int vrow = lane >> 3;
    LAS int* selv = sel + vrow;
    const int tq = (lane & 15) >> 2, tp = lane & 3;
    const int j0 = (int)(xb_xcc_id() >> 1) & 3;
    for (int dj = 0; dj < 4; ++dj) {
        const int j = (j0 + dj) & 3;
        const int hcol = 4 * j + (g & 3);
        const unsigned char* Vb = V8 + j * 128;
        for (;;) {
            unsigned it = 0u;
            if (lane == 0) it = __hip_atomic_fetch_add(wq + 64 * j, 1u, __ATOMIC_RELAXED, __HIP_MEMORY_SCOPE_AGENT);
            it = (unsigned)__builtin_amdgcn_readfirstlane((int)it);
            if (it >= (unsigned)S_) break;
            const int t = (int)it, cnt = (t + 1) < TOPK ? (t + 1) : TOPK;
            *(LAS i32x4*)(sel + 4 * lane) = *(const i32x4*)(SELG + (size_t)t * TOPK + 4 * lane);
            u32x4 qf[2];
#pragma unroll
            for (int p = 0; p < 2; ++p) qf[p] = *(const u32x4*)(Q8 + (size_t)t * 2048 + hcol * 128 + 64 * p + 16 * kg);
            LDS_WAIT();
#define ATT_VIDX(S, c) do { _Pragma("unroll") for (int m_ = 0; m_ < 8; ++m_) S[m_] = selv[64 * (c) + 8 * m_] & 8191; } while (0)
#define ATT_VDMA(S, bufi) do { _Pragma("unroll") for (int m_ = 0; m_ < 8; ++m_) { const int row_ = 8 * m_ + vrow; \
                const int ch_ = (lane & 7) ^ (((row_ >> 1) & 3) << 1); \
                __builtin_amdgcn_global_load_lds((const unsigned*)(Vb + (size_t)S[m_] * 512 + 16 * ch_), (LAS unsigned*)(vbuf + (bufi) * 8192 + m_ * 1024), 16, 0, 0); } } while (0)
            int vs0[8], vs1[8], ksel[16];
            ATT_VIDX(vs0, 0); ATT_VIDX(vs1, 1);
#pragma unroll
            for (int i = 0; i < 16; ++i) ksel[i] = selg[16 * i] & 8191;
            ATT_VDMA(vs0, 0); ATT_VDMA(vs1, 1);
            __builtin_amdgcn_s_waitcnt(0xC07F);
            __builtin_amdgcn_sched_barrier(0);
            f32x4 lg[16];
            const unsigned char* Kb = K8 + j * 128 + 16 * kg;
            u32x4 kb[8][2];
#pragma unroll
            for (int i = 0; i < 8; ++i) { const unsigned char* kp = Kb + (size_t)ksel[i] * 512;
#pragma unroll
                for (int p = 0; p < 2; ++p) kb[i][p] = *(const u32x4*)(kp + 64 * p); }
            __builtin_amdgcn_sched_barrier(0);
#pragma unroll
            for (int kt = 0; kt < 16; ++kt) {
                f32x4 a4 = {0.f, 0.f, 0.f, 0.f};
#pragma unroll
                for (int p = 0; p < 2; ++p) {
                    const u32x4 kk = kb[kt & 7][p];
                    const long a0 = (long)(((unsigned long long)kk.y << 32) | kk.x), a1 = (long)(((unsigned long long)kk.w << 32) | kk.z);
                    const long b0 = (long)(((unsigned long long)qf[p].y << 32) | qf[p].x), b1 = (long)(((unsigned long long)qf[p].w << 32) | qf[p].z);
                    a4 = __builtin_amdgcn_mfma_f32_16x16x32_fp8_fp8(a0, b0, a4, 0, 0, 0);
                    a4 = __builtin_amdgcn_mfma_f32_16x16x32_fp8_fp8(a1, b1, a4, 0, 0, 0);
                }
                lg[kt] = a4;
                if (kt + 8 < 16) { const unsigned char* kp = Kb + (size_t)ksel[kt + 8] * 512;
#pragma unroll
                    for (int p = 0; p < 2; ++p) kb[kt & 7][p] = *(const u32x4*)(kp + 64 * p); }
                __builtin_amdgcn_sched_barrier(0);
            }
            const int cq = g >> 2;
            float mx = -INFINITY;
            const int cntk = cnt - 4 * kg;
            float pw[4][4];
#pragma unroll
            for (int i = 0; i < 4; ++i) {
                f32x4 lgi = (cq == 0) ? lg[i] : (cq == 1) ? lg[4 + i] : (cq == 2) ? lg[8 + i] : lg[12 + i];
                const int kt = 4 * cq + i;
                const i32x4 s4 = *(const LAS i32x4*)(selk + 16 * kt);
#pragma unroll
                for (int r = 0; r < 4; ++r) {
                    int dist = t - s4[r]; dist = dist < 0 ? 0 : (dist > 128 ? 128 : dist);
                    float v = lgi[r] * 0.08838834764831845f + BIAS[dist * 16 + hcol];
                    v = (16 * kt + r < cntk) ? v : -INFINITY;
                    pw[i][r] = v; mx = fmaxf(mx, v);
                }
            }
            mx = fmaxf(mx, __shfl_xor(mx, 4)); mx = fmaxf(mx, __shfl_xor(mx, 8)); mx = fmaxf(mx, __shfl_xor(mx, 16)); mx = fmaxf(mx, __shfl_xor(mx, 32));
            float sum = 0.f;
#pragma unroll
            for (int i = 0; i < 4; ++i)
#pragma unroll
                for (int r = 0; r < 4; ++r) { const float e = __expf(pw[i][r] - mx); pw[i][r] = e; sum += e; }
            sum += __shfl_xor(sum, 4); sum += __shfl_xor(sum, 8); sum += __shfl_xor(sum, 16); sum += __shfl_xor(sum, 32);
            const float inv = __builtin_amdgcn_rcpf(sum) * 128.0f;
            const unsigned pA0 = pk4_fp8(pw[0][0] * inv, pw[0][1] * inv, pw[0][2] * inv, pw[0][3] * inv), pB0 = pk4_fp8(pw[1][0] * inv, pw[1][1] * inv, pw[1][2] * inv, pw[1][3] * inv);
            const unsigned pA1 = pk4_fp8(pw[2][0] * inv, pw[2][1] * inv, pw[2][2] * inv, pw[2][3] * inv), pB1 = pk4_fp8(pw[3][0] * inv, pw[3][1] * inv, pw[3][2] * inv, pw[3][3] * inv);
            f32x4 o[8];
#pragma unroll
            for (int dt = 0; dt < 8; ++dt) o[dt] = (f32x4){0.f, 0.f, 0.f, 0.f};
#pragma unroll
            for (int c = 0; c < 4; ++c) {
                if (c < 3) asm volatile("s_waitcnt vmcnt(8)" ::: "memory"); else asm volatile("s_waitcnt vmcnt(0)" ::: "memory");
                const unsigned base = (unsigned)(size_t)(vbuf + (c & 1) * 8192);
#pragma unroll
                for (int s2 = 0; s2 < 2; ++s2) {
                    const int ks = 2 * c + s2;
                    const int rA = 32 * s2 + 4 * kg + tq, rB = rA + 16;
                    const bool mine = (ks >> 1) == cq;
                    const unsigned pa = mine ? ((ks & 1) ? pA1 : pA0) : 0u, pb = mine ? ((ks & 1) ? pB1 : pB0) : 0u;
                    const long pf = (long)(((unsigned long long)pb << 32) | pa);
                    u32x2 vl[4], vh[4];
#pragma unroll
                    for (int mp = 0; mp < 4; ++mp) {
                        const unsigned a0 = base + 128u * rA + 16u * ((2 * mp + (tp >> 1)) ^ (((rA >> 1) & 3) << 1)) + 8u * (tp & 1);
                        const unsigned a1 = base + 128u * rB + 16u * ((2 * mp + (tp >> 1)) ^ (((rB >> 1) & 3) << 1)) + 8u * (tp & 1);
                        asm volatile("ds_read_b64_tr_b16 %0, %2\n\tds_read_b64_tr_b16 %1, %3" : "=&v"(vl[mp]), "=&v"(vh[mp]) : "v"(a0), "v"(a1) : "memory");
                    }
                    asm volatile("s_waitcnt lgkmcnt(0)" : "+v"(vl[0]), "+v"(vl[1]), "+v"(vl[2]), "+v"(vl[3]), "+v"(vh[0]), "+v"(vh[1]), "+v"(vh[2]), "+v"(vh[3]) :: "memory");
#pragma unroll
                    for (int mp = 0; mp < 4; ++mp) {
                        const unsigned e0 = __builtin_amdgcn_perm(vl[mp].y, vl[mp].x, 0x06040200u), e1 = __builtin_amdgcn_perm(vh[mp].y, vh[mp].x, 0x06040200u);
                        const unsigned o0 = __builtin_amdgcn_perm(vl[mp].y, vl[mp].x, 0x07050301u), o1 = __builtin_amdgcn_perm(vh[mp].y, vh[mp].x, 0x07050301u);
                        const long fe = (long)(((unsigned long long)e1 << 32) | e0), fo = (long)(((unsigned long long)o1 << 32) | o0);
                        o[2 * mp] = __builtin_amdgcn_mfma_f32_16x16x32_fp8_fp8(fe, pf, o[2 * mp], 0, 0, 0);
                        o[2 * mp + 1] = __builtin_amdgcn_mfma_f32_16x16x32_fp8_fp8(fo, pf, o[2 * mp + 1], 0, 0, 0);
                    }
                }
                if (c + 2 < 4) { int vsn[8]; ATT_VIDX(vsn, c + 2); ATT_VDMA(vsn, c & 1); }
            }
#undef ATT_VDMA
#undef ATT_VIDX
#pragma unroll
            for (int dt = 0; dt < 8; ++dt)
#pragma unroll
                for (int r = 0; r < 4; ++r) { float x = o[dt][r];
                    x += __builtin_bit_cast(float, __builtin_amdgcn_update_dpp(0, __builtin_bit_cast(int, x), 0x128, 0xf, 0xf, false));
                    x += __builtin_bit_cast(float, __builtin_amdgcn_update_dpp(0, __builtin_bit_cast(int, x), 0x124, 0xf, 0xf, false)); o[dt][r] = x; }
            if (g < 4) {
#pragma unroll
                for (int mp = 0; mp < 4; ++mp) { const f32x4 ev = o[2 * mp] * (1.0f / 128.0f), ov = o[2 * mp + 1] * (1.0f / 128.0f);
                    const float h8[8] = {ev[0], ov[0], ev[1], ov[1], ev[2], ov[2], ev[3], ov[3]};
                    *(bf16x8*)(AO + (size_t)t * D_ + (4 * j + g) * 128 + 32 * mp + 8 * kg) = pack8(h8); }
            }
            LDS_WAIT();
        }
    }
}

DI void hgrn_a(unsigned char* ws, int lane, int wave, int bid, int G) {
    const float* F = (const float*)(ws + WS_R + R_F); const bf16* VT = (const bf16*)(ws + WS_R + R_VT);
    float* BC = (float*)(ws + WS_R + R_BC); unsigned char* STB = ws + WS_R + R_ST; float* EBL = (float*)(ws + WS_R + R_EBL);
    const int u2 = wave >> 2, dt = wave & 3, dl = lane & 31, hf = lane >> 5;
    for (int U = bid * 2 + u2; U < 2048; U += 2 * G) {
        const int c = U >> 4, h = U & 15, d = h * 128 + dt * 32 + dl;
        float b[4][8], kd[4][8], tot[4];
#pragma unroll
        for (int i = 0; i < 4; ++i) {
            float run = 0.f;
#pragma unroll
            for (int jj = 0; jj < 8; ++jj) { const float f = F[(size_t)(c * 64 + 8 * (2 * i + hf) + jj) * D_ + d]; kd[i][jj] = 1.0f - f; run += logf(f); b[i][jj] = run; }
            tot[i] = run;
        }
        float pre = 0.f;
#pragma unroll
        for (int i = 0; i < 4; ++i) {
            const float pt = __shfl_xor(tot[i], 32);
            const float mypre = pre + (hf ? pt : 0.f);
#pragma unroll
            for (int jj = 0; jj < 8; ++jj) b[i][jj] += mypre;
            pre += tot[i] + pt;
        }
        const float blast = pre;
#pragma unroll
        for (int i = 0; i < 4; ++i)
#pragma unroll
            for (int jj = 0; jj < 8; ++jj) { BC[(size_t)(c * 64 + 8 * (2 * i + hf) + jj) * D_ + d] = b[i][jj]; kd[i][jj] *= __expf(blast - b[i][jj]); }
        if (hf == 0) EBL[(size_t)U * 128 + dt * 32 + dl] = __expf(blast);
        f32x16 acc[4];
#pragma unroll
        for (int et = 0; et < 4; ++et)
#pragma unroll
            for (int i = 0; i < 16; ++i) acc[et][i] = 0.f;
#pragma unroll
        for (int ks = 0; ks < 4; ++ks) {
            const bf16x8 bfr = pack8(kd[ks]);
#pragma unroll
            for (int et = 0; et < 4; ++et) {
                const bf16x8 afr = *(const bf16x8*)(VT + (size_t)(h * 128 + et * 32 + dl) * S_ + c * 64 + 16 * ks + 8 * hf);
                acc[et] = MFMA32(bfr, afr, acc[et]);
            }
        }
#pragma unroll
        for (int et = 0; et < 4; ++et)
#pragma unroll
            for (int s2 = 0; s2 < 2; ++s2) {
                float v[8];
#pragma unroll
                for (int i = 0; i < 8; ++i) v[i] = acc[et][8 * s2 + i];
                *(bf16x8*)(STB + (((size_t)U * 4 + et) * 8 + 2 * dt + s2) * 1024 + lane * 16) = pack8(v);
            }
    }
}
DI void hgrn_b(unsigned char* ws, int gtid, int nthreads, int dummy) {
    unsigned char* STB = ws + WS_R + R_ST; const float* EBL = (const float*)(ws + WS_R + R_EBL);
    for (int p = gtid; p < 131072; p += nthreads) {
        const int h = p >> 13, rem = p & 8191, ks = (rem >> 8) & 7, ln = (rem >> 2) & 63, wsel = rem & 3;
        const int d0 = 16 * ks + 8 * (wsel >> 1) + 4 * (ln >> 5) + 2 * (wsel & 1);
        float r0 = 0.f, r1 = 0.f;
#pragma unroll 8
        for (int c = 0; c < 128; ++c) {
            unsigned* ptr = (unsigned*)(STB + (size_t)(c * 16 + h) * 32768 + (size_t)rem * 4);
            const unsigned loc = *ptr; const f32x2 eb = *(const f32x2*)(EBL + (size_t)(c * 16 + h) * 128 + d0);
            *ptr = dummy ? loc : pk2(r0, r1);
            r0 = r0 * eb[0] + bf_lo(loc); r1 = r1 * eb[1] + bf_hi(loc);
        }
    }
}
DI void hgrn_c(unsigned char* ws, const float* ogain, int lane, int wave, int bid, int NG) {
    const bf16* Q = (const bf16*)(ws + WS_R + R_Q); const float* F = (const float*)(ws + WS_R + R_F); const bf16* G = (const bf16*)(ws + WS_R + R_G);
    const bf16* VT = (const bf16*)(ws + WS_R + R_VT); const float* BC = (const float*)(ws + WS_R + R_BC); const unsigned char* STB = ws + WS_R + R_ST;
    bf16* AO = (bf16*)(ws + WS_AO);
    const int u4 = wave >> 1, tt = wave & 1, tl = lane & 31, hf = lane >> 5;
    for (int U = bid * 4 + u4; U < 2048; U += 4 * NG) {
        const int c = U >> 4, h = U & 15, t = c * 64 + tt * 32 + tl;
        const size_t cb = (size_t)h * 128 + 4 * hf;
        bf16x8 qt[8];
        const bf16* qrow = Q + (size_t)t * D_ + cb; const float* brow = BC + (size_t)t * D_ + cb; const float* b31 = BC + (size_t)(c * 64 + 31) * D_ + cb;
#pragma unroll
        for (int ks = 0; ks < 8; ++ks) {
            const u32x2 qa = *(const u32x2*)(qrow + 16 * ks), qb2 = *(const u32x2*)(qrow + 16 * ks + 8);
            const float q[8] = {bf_lo(qa.x), bf_hi(qa.x), bf_lo(qa.y), bf_hi(qa.y), bf_lo(qb2.x), bf_hi(qb2.x), bf_lo(qb2.y), bf_hi(qb2.y)};
            const f32x4 b0 = *(const f32x4*)(brow + 16 * ks), b1 = *(const f32x4*)(brow + 16 * ks + 8);
            float v[8];
#pragma unroll
            for (int e = 0; e < 4; ++e) { v[e] = q[e] * __expf(b0[e]); v[4 + e] = q[4 + e] * __expf(b1[e]); }
            qt[ks] = pack8(v);
        }
        f32x16 acc[4];
#pragma unroll
        for (int et = 0; et < 4; ++et)
#pragma unroll
            for (int i = 0; i < 16; ++i) acc[et][i] = 0.f;
#pragma unroll
        for (int ks = 0; ks < 8; ++ks) {
#pragma unroll
            for (int et = 0; et < 4; ++et) {
                const bf16x8 sf = *(const bf16x8*)(STB + (((size_t)U * 4 + et) * 8 + ks) * 1024 + lane * 16);
                acc[et] = MFMA32(sf, qt[ks], acc[et]);
            }
            if ((ks & 3) == 3) asm volatile("" ::: "memory");
        }
        for (int st = 0; st <= tt; ++st) {
            const int sa = c * 64 + st * 32 + tl;
            const float* frow = F + (size_t)sa * D_ + cb; const float* srow = BC + (size_t)sa * D_ + cb;
            f32x16 X;
#pragma unroll
            for (int i = 0; i < 16; ++i) X[i] = 0.f;
#pragma unroll
            for (int ks = 0; ks < 8; ++ks) {
                const f32x4 f0 = *(const f32x4*)(frow + 16 * ks), f1 = *(const f32x4*)(frow + 16 * ks + 8);
                const f32x4 b0 = *(const f32x4*)(srow + 16 * ks), b1 = *(const f32x4*)(srow + 16 * ks + 8);
                f32x4 c0 = {0.f, 0.f, 0.f, 0.f}, c1 = {0.f, 0.f, 0.f, 0.f};
                bf16x8 qb = qt[ks];
                if (st == 1) {
                    c0 = *(const f32x4*)(b31 + 16 * ks); c1 = *(const f32x4*)(b31 + 16 * ks + 8);
                    const u32x2 qa = *(const u32x2*)(qrow + 16 * ks), qb2 = *(const u32x2*)(qrow + 16 * ks + 8);
                    const float q[8] = {bf_lo(qa.x), bf_hi(qa.x), bf_lo(qa.y), bf_hi(qa.y), bf_lo(qb2.x), bf_hi(qb2.x), bf_lo(qb2.y), bf_hi(qb2.y)};
                    const f32x4 t0 = *(const f32x4*)(brow + 16 * ks), t1 = *(const f32x4*)(brow + 16 * ks + 8);
                    float w[8];
#pragma unroll
                    for (int e = 0; e < 4; ++e) { w[e] = q[e] * __expf(t0[e] - c0[e]); w[4 + e] = q[4 + e] * __expf(t1[e] - c1[e]); }
                    qb = pack8(w);
                }
                float v[8];
#pragma unroll
                for (int e = 0; e < 4; ++e) { v[e] = (1.0f - f0[e]) * __expf(c0[e] - b0[e]); v[4 + e] = (1.0f - f1[e]) * __expf(c1[e] - b1[e]); }
                X = MFMA32(pack8(v), qb, X);
                if (ks & 1) asm volatile("" ::: "memory");
            }
            if (st == tt) {
#pragma unroll
                for (int r = 0; r < 16; ++r) { const int sl = (r & 3) + 8 * (r >> 2) + 4 * hf; X[r] = (sl <= tl) ? X[r] : 0.f; }
            }
#pragma unroll
            for (int kp = 0; kp < 2; ++kp) {
                float xv[8];
#pragma unroll
                for (int i = 0; i < 8; ++i) xv[i] = X[8 * kp + i];
                const bf16x8 xb = pack8(xv);
#pragma unroll
                for (int et = 0; et < 4; ++et) {
                    const bf16* vp = VT + (size_t)(h * 128 + et * 32 + tl) * S_ + c * 64 + st * 32 + 16 * kp + 4 * hf;
                    const s16x4 lo = *(const s16x4*)vp, hi = *(const s16x4*)(vp + 8);
                    const bf16x8 vf = {lo[0], lo[1], lo[2], lo[3], hi[0], hi[1], hi[2], hi[3]};
                    acc[et] = MFMA32(vf, xb, acc[et]);
                }
            }
        }
        float ss = 0.f;
#pragma unroll
        for (int et = 0; et < 4; ++et)
#pragma unroll
            for (int i = 0; i < 16; ++i) ss += acc[et][i] * acc[et][i];
        ss += __shfl_xor(ss, 32);
        const float rstd = __builtin_amdgcn_rsqf(ss * (1.0f / 128.0f) + EPS_);
#pragma unroll
        for (int et = 0; et < 4; ++et)
#pragma unroll
            for (int rq = 0; rq < 4; ++rq) {
                const int e0 = h * 128 + et * 32 + 8 * rq + 4 * hf;
                const f32x4 og = *(const f32x4*)(ogain + e0);
                const u32x2 gw = *(const u32x2*)(G + (size_t)t * D_ + e0);
                const float g0 = bf_lo(gw.x), g1 = bf_hi(gw.x), g2 = bf_lo(gw.y), g3 = bf_hi(gw.y);
                u32x2 w;
                w.x = pk2(acc[et][4 * rq] * rstd * og[0] * g0, acc[et][4 * rq + 1] * rstd * og[1] * g1);
                w.y = pk2(acc[et][4 * rq + 2] * rstd * og[2] * g2, acc[et][4 * rq + 3] * rstd * og[3] * g3);
                *(u32x2*)(AO + (size_t)t * D_ + e0) = w;
            }
    }
}

DI void hgrn_a2(unsigned char* ws, LAS unsigned char* lds, int tid, int lane, int wave, int bid, int NG) {
    const unsigned short* K1 = (const unsigned short*)(ws + WS_R + R_F); const bf16* VT = (const bf16*)(ws + WS_R + R_VT);
    unsigned short* BC = (unsigned short*)(ws + WS_R + R_BC); unsigned char* STB = ws + WS_R + R_ST; float* EBL = (float*)(ws + WS_R + R_EBL);
    constexpr int BLK = 1040;
    LAS unsigned char* Ft = lds;
    LAS float* QT = (LAS float*)(lds + 32 * BLK);
    LAS unsigned char* KDT = lds + 32 * BLK + 2048;
    LAS unsigned char* BCT = lds + 65536;
    const int d = tid & 127, tq = tid >> 7;
    const int dt = wave & 3, ep = wave >> 2, dl = lane & 31, hf = lane >> 5;
#define A2_STAGE(U_) do { const int c_ = (U_) >> 4, h_ = (U_) & 15; \
        _Pragma("unroll") for (int i_ = 0; i_ < 2; ++i_) { const int m_ = wave * 2 + i_; \
            __builtin_amdgcn_global_load_lds((const unsigned*)(K1 + (size_t)(c_ * 64 + 4 * m_ + (lane >> 4)) * D_ + h_ * 128 + (lane & 15) * 8), (LAS unsigned*)(Ft + m_ * BLK), 16, 0, 0); } } while (0)
    int U = bid;
    if (U < 2048) A2_STAGE(U);
    for (; U < 2048; U += NG) {
        const int c = U >> 4, h = U & 15;
        bf16x8 vf[2][4];
#pragma unroll
        for (int e2 = 0; e2 < 2; ++e2)
#pragma unroll
            for (int ks = 0; ks < 4; ++ks) vf[e2][ks] = *(const bf16x8*)(VT + (size_t)(h * 128 + (2 * ep + e2) * 32 + dl) * S_ + c * 64 + 16 * ks + 8 * hf);
        asm volatile("s_waitcnt vmcnt(0)" ::: "memory");
        __syncthreads();
        float f[16], b[16];
        float run = 0.f;
#pragma unroll
        for (int i = 0; i < 16; ++i) { const int r = 16 * tq + i; f[i] = (float)*(const LAS _Float16*)(Ft + (r >> 2) * BLK + (r & 3) * 256 + d * 2); run += __logf(1.0f - f[i]); b[i] = run; }
        QT[tq * 128 + d] = run;
        LDS_WAIT();
        __syncthreads();
        if (U + NG < 2048) A2_STAGE(U + NG);
        const float q0 = QT[d], q1 = QT[128 + d], q2 = QT[256 + d], q3 = QT[384 + d];
        const float pre = (tq > 0 ? q0 : 0.f) + (tq > 1 ? q1 : 0.f) + (tq > 2 ? q2 : 0.f);
        const float blast = (q0 + q1) + (q2 + q3);
        float kd[16];
#pragma unroll
        for (int i = 0; i < 16; ++i) { b[i] += pre; *(LAS unsigned short*)(BCT + (16 * tq + i) * 272 + d * 2) = __builtin_bit_cast(unsigned short, (_Float16)b[i]); kd[i] = f[i] * __expf(blast - b[i]); }
        if (tq == 0) EBL[(size_t)U * 128 + d] = __expf(blast);
        *(LAS bf16x8*)(KDT + d * 144 + 32 * tq) = pack8(kd); *(LAS bf16x8*)(KDT + d * 144 + 32 * tq + 16) = pack8(kd + 8);
        LDS_WAIT();
        __syncthreads();
#pragma unroll
        for (int i = 0; i < 2; ++i) { const int q = tid + NTHREADS * i, r = q >> 4, cc = q & 15;
            *(u32x4*)(BC + (size_t)(c * 64 + r) * D_ + h * 128 + cc * 8) = *(const LAS u32x4*)(BCT + r * 272 + cc * 16); }
        f32x16 acc[2];
#pragma unroll
        for (int e2 = 0; e2 < 2; ++e2)
#pragma unroll
            for (int i = 0; i < 16; ++i) acc[e2][i] = 0.f;
#pragma unroll
        for (int ks = 0; ks < 4; ++ks) {
            const bf16x8 af = *(const LAS bf16x8*)(KDT + (dt * 32 + dl) * 144 + 32 * ks + 16 * hf);
#pragma unroll
            for (int e2 = 0; e2 < 2; ++e2) acc[e2] = MFMA32(af, vf[e2][ks], acc[e2]);
        }
#pragma unroll
        for (int e2 = 0; e2 < 2; ++e2)
#pragma unroll
            for (int s2 = 0; s2 < 2; ++s2) {
                float v[8];
#pragma unroll
                for (int i = 0; i < 8; ++i) v[i] = acc[e2][8 * s2 + i];
                *(bf16x8*)(STB + (((size_t)U * 4 + 2 * ep + e2) * 8 + 2 * dt + s2) * 1024 + lane * 16) = pack8(v);
            }
    }
#undef A2_STAGE
}

DI void hgrn_c2(unsigned char* ws, const float* ogain, LAS unsigned char* lds, int tid, int lane, int wave, int bid, int NG) {
    const bf16* Q = (const bf16*)(ws + WS_R + R_Q); const unsigned short* K1 = (const unsigned short*)(ws + WS_R + R_F); const bf16* G = (const bf16*)(ws + WS_R + R_G);
    const bf16* VT = (const bf16*)(ws + WS_R + R_VT); const unsigned short* BC = (const unsigned short*)(ws + WS_R + R_BC); const unsigned char* STB = ws + WS_R + R_ST;
    bf16* AO = (bf16*)(ws + WS_AO);
    constexpr int BLK = 1040;
    constexpr int SETB = 48 * BLK;
    LAS float* SSt = (LAS float*)(lds + 2 * SETB);
    LAS unsigned char* XFt = lds + 2 * SETB + 1024;
    const int et = wave & 3, tt = wave >> 2, tl = lane & 31, hf = lane >> 5;
    const int rt = tt * 32 + tl;
#define C2_DMA(G_, L_) do { const unsigned la_ = (unsigned)(size_t)(L_); asm volatile("s_mov_b32 m0, %1\n\ts_nop 0\n\tglobal_load_lds_dwordx4 %0, off" :: "v"(G_), "s"(la_) : "memory", "m0"); } while (0)
#define C2_STAGE(U_, S_) do { const int c_ = (U_) >> 4, h_ = (U_) & 15; LAS unsigned char* sb_ = lds + (S_) * SETB; \
        _Pragma("unroll") for (int i_ = 0; i_ < 2; ++i_) { const int m_ = wave * 2 + i_; const size_t ro_ = (size_t)(c_ * 64 + 4 * m_ + (lane >> 4)) * D_ + h_ * 128 + (lane & 15) * 8; \
            C2_DMA(BC + ro_, sb_ + m_ * BLK); C2_DMA(K1 + ro_, sb_ + (16 + m_) * BLK); C2_DMA(Q + ro_, sb_ + (32 + m_) * BLK); } } while (0)
#define C2_ROW4(T, r) ((T) + ((r) >> 2) * BLK + ((r) & 3) * 256)
#define C2_ROWQ(r) C2_ROW4(Qt, r)
#define C2_H4(p_) ({ const u32x2 w_ = *(const LAS u32x2*)(p_); (f32x4){h_lo(w_.x), h_hi(w_.x), h_lo(w_.y), h_hi(w_.y)}; })
    int U = bid;
    if (U < 2048) C2_STAGE(U, 0);
    asm volatile("s_waitcnt vmcnt(0)" ::: "memory");
    for (int iter = 0; U < 2048; U += NG, ++iter) {
        const int par = iter & 1;
        const int c = U >> 4, h = U & 15, t = c * 64 + rt;
        LAS unsigned char* BCt = lds + par * SETB; LAS unsigned char* Ft = BCt + 16 * BLK; LAS unsigned char* Qt = BCt + 32 * BLK;
        asm volatile("s_waitcnt vmcnt(4)" ::: "memory");
        __syncthreads();
        bf16x8 sfr[8]; s16x4 vlo[2][2], vhi[2][2]; u32x2 gwr[4]; f32x4 ogr[4];
#pragma unroll
        for (int ks = 0; ks < 8; ++ks) sfr[ks] = *(const bf16x8*)(STB + (((size_t)U * 4 + et) * 8 + ks) * 1024 + lane * 16);
#pragma unroll
        for (int st = 0; st < 2; ++st)
#pragma unroll
            for (int kp = 0; kp < 2; ++kp) { const bf16* vp = VT + (size_t)(h * 128 + et * 32 + tl) * S_ + c * 64 + st * 32 + 16 * kp + 4 * hf; vlo[st][kp] = *(const s16x4*)vp; vhi[st][kp] = *(const s16x4*)(vp + 8); }
#pragma unroll
        for (int rq = 0; rq < 4; ++rq) { const int e0 = h * 128 + et * 32 + 8 * rq + 4 * hf; ogr[rq] = *(const f32x4*)(ogain + e0); gwr[rq] = *(const u32x2*)(G + (size_t)t * D_ + e0); }
        EPI_FENCE();
        if (U + NG < 2048) C2_STAGE(U + NG, par ^ 1);
        EPI_FENCE();
        const LAS unsigned char* qrow = C2_ROWQ(rt) + 8 * hf; const LAS unsigned char* brow = C2_ROW4(BCt, rt) + 8 * hf; const LAS unsigned char* b31 = C2_ROW4(BCt, 31) + 8 * hf;
        bf16x8 qt[8];
#pragma unroll
        for (int ks = 0; ks < 8; ++ks) {
            const u32x2 qa = *(const LAS u32x2*)(qrow + 32 * ks), qb2 = *(const LAS u32x2*)(qrow + 32 * ks + 16);
            const float q[8] = {bf_lo(qa.x), bf_hi(qa.x), bf_lo(qa.y), bf_hi(qa.y), bf_lo(qb2.x), bf_hi(qb2.x), bf_lo(qb2.y), bf_hi(qb2.y)};
            const f32x4 b0 = C2_H4(brow + 32 * ks), b1 = C2_H4(brow + 32 * ks + 16);
            float v[8];
#pragma unroll
            for (int e = 0; e < 4; ++e) { v[e] = q[e] * __expf(b0[e]); v[4 + e] = q[4 + e] * __expf(b1[e]); }
            qt[ks] = pack8(v);
            if (ks & 1) asm volatile("" ::: "memory");
        }
        f32x16 acc;
#pragma unroll
        for (int i = 0; i < 16; ++i) acc[i] = 0.f;
#pragma unroll
        for (int ks = 0; ks < 8; ++ks) {
            acc = MFMA32(sfr[ks], qt[ks], acc);
        }
        if (et <= tt) {
            const int st = et;
            const LAS unsigned char* frow = C2_ROW4(Ft, st * 32 + tl) + 8 * hf; const LAS unsigned char* srow = C2_ROW4(BCt, st * 32 + tl) + 8 * hf;
            f32x16 X;
#pragma unroll
            for (int i = 0; i < 16; ++i) X[i] = 0.f;
#pragma unroll
            for (int ks = 0; ks < 8; ++ks) {
                const f32x4 f0 = C2_H4(frow + 32 * ks), f1 = C2_H4(frow + 32 * ks + 16);
                const f32x4 b0 = C2_H4(srow + 32 * ks), b1 = C2_H4(srow + 32 * ks + 16);
                f32x4 c0 = {0.f, 0.f, 0.f, 0.f}, c1 = {0.f, 0.f, 0.f, 0.f};
                bf16x8 qb = qt[ks];
                if (st == 1) {
                    c0 = C2_H4(b31 + 32 * ks); c1 = C2_H4(b31 + 32 * ks + 16);
                    const u32x2 qa = *(const LAS u32x2*)(qrow + 32 * ks), qb2 = *(const LAS u32x2*)(qrow + 32 * ks + 16);
                    const float q[8] = {bf_lo(qa.x), bf_hi(qa.x), bf_lo(qa.y), bf_hi(qa.y), bf_lo(qb2.x), bf_hi(qb2.x), bf_lo(qb2.y), bf_hi(qb2.y)};
                    const f32x4 t0 = C2_H4(brow + 32 * ks), t1 = C2_H4(brow + 32 * ks + 16);
                    float w[8];
#pragma unroll
                    for (int e = 0; e < 4; ++e) { w[e] = q[e] * __expf(t0[e] - c0[e]); w[4 + e] = q[4 + e] * __expf(t1[e] - c1[e]); }
                    qb = pack8(w);
                }
                float v[8];
#pragma unroll
                for (int e = 0; e < 4; ++e) { v[e] = f0[e] * __expf(c0[e] - b0[e]); v[4 + e] = f1[e] * __expf(c1[e] - b1[e]); }
                X = MFMA32(pack8(v), qb, X);
                if (ks & 1) asm volatile("" ::: "memory");
            }
            if (st == tt) {
#pragma unroll
                for (int r = 0; r < 16; ++r) { const int sl = (r & 3) + 8 * (r >> 2) + 4 * hf; X[r] = (sl <= tl) ? X[r] : 0.f; }
            }
#pragma unroll
            for (int kp = 0; kp < 2; ++kp) {
                float xv[8];
#pragma unroll
                for (int i = 0; i < 8; ++i) xv[i] = X[8 * kp + i];
                *(LAS bf16x8*)(XFt + ((st + tt) * 2 + kp) * 1024 + lane * 16) = pack8(xv);
            }
        }
        LDS_WAIT();
        __syncthreads();
#pragma unroll
        for (int st = 0; st < 2; ++st) {
            if (st <= tt) {
#pragma unroll
                for (int kp = 0; kp < 2; ++kp) {
                    const bf16x8 xb = *(const LAS bf16x8*)(XFt + ((st + tt) * 2 + kp) * 1024 + lane * 16);
                    const s16x4 lo = vlo[st][kp], hi = vhi[st][kp];
                    const bf16x8 vf = {lo[0], lo[1], lo[2], lo[3], hi[0], hi[1], hi[2], hi[3]};
                    acc = MFMA32(vf, xb, acc);
                }
            }
        }
        float ss = 0.f;
#pragma unroll
        for (int i = 0; i < 16; ++i) ss += acc[i] * acc[i];
        ss += __shfl_xor(ss, 32);
        if (hf == 0) SSt[rt * 4 + et] = ss;
        LDS_WAIT();
        __syncthreads();
        const f32x4 s4 = *(const LAS f32x4*)(SSt + rt * 4);
        const float rstd = __builtin_amdgcn_rsqf(((s4[0] + s4[1]) + (s4[2] + s4[3])) * (1.0f / 128.0f) + EPS_);
        LDS_WAIT();
        __syncthreads();
        u32x2 wo[4];
#pragma unroll
        for (int rq = 0; rq < 4; ++rq) {
            const f32x4 og = ogr[rq];
            const u32x2 gw = gwr[rq];
            const float g0 = bf_lo(gw.x), g1 = bf_hi(gw.x), g2 = bf_lo(gw.y), g3 = bf_hi(gw.y);
            wo[rq].x = pk2(acc[4 * rq] * rstd * og[0] * g0, acc[4 * rq + 1] * rstd * og[1] * g1);
            wo[rq].y = pk2(acc[4 * rq + 2] * rstd * og[2] * g2, acc[4 * rq + 3] * rstd * og[3] * g3);
        }
        { bf16* op_ = AO + (size_t)t * D_ + h * 128 + et * 32 + 4 * hf;
          asm volatile("global_store_dwordx2 %0, %1, off\n\tglobal_store_dwordx2 %0, %2, off offset:16\n\tglobal_store_dwordx2 %0, %3, off offset:32\n\tglobal_store_dwordx2 %0, %4, off offset:48"
                       :: "v"(op_), "v"(wo[0]), "v"(wo[1]), "v"(wo[2]), "v"(wo[3]) : "memory"); }
    }
#undef C2_STAGE
#undef C2_DMA
#undef C2_ROW4
#undef C2_ROWQ
#undef C2_H4
}

constexpr int N_PHASE_IDS = 41;
__global__ void __launch_bounds__(NTHREADS, 2) fwd(Args args) {
    extern __shared__ __attribute__((aligned(16))) unsigned char lds_raw[];
    LAS unsigned char* lds = (LAS unsigned char*)lds_raw;
    const int tid = threadIdx.x, lane = tid & 63, wave = __builtin_amdgcn_readfirstlane(tid >> 6);
    const int G = gridDim.x;
    const int NGW = G * NWAVES;
    unsigned char* ws_k = args.ws;
#if MK_ONE_LAUNCH
    constexpr int lo = 0, hi = N_PHASE_IDS; constexpr bool multi = true;
#else
    const int lo = args.ph_lo, hi = args.ph_hi;
    const bool multi = (hi - lo) > 1;
#endif
    volatile LAS unsigned* MISC = (volatile LAS unsigned*)(lds + LDS_MISC);
    if (tid < 4) MISC[tid] = 0u;
    __syncthreads();
    XcdBarrier bar; bar.bar = (unsigned*)(ws_k + WS_CTL) + CW_BAR; bar.x = 0; bar.st = MISC;
    if (multi) bar = xcd_barrier_post((unsigned*)(ws_k + WS_CTL) + CW_BAR, MISC);
#ifndef PH_MASK
#define PH_MASK 0xFFFF
#endif
#define IN(k) (lo <= (k) && (k) < hi)
#define EN(b) ((PH_MASK >> (b)) & 1)
#ifndef PROBE_DUP
#define PROBE_DUP 0
#endif
#ifndef PROBE_MODE
#define PROBE_MODE 0
#endif
#ifndef PROBE_BAR
#define PROBE_BAR 0
#endif
#define REP(b) for (int rep_ = ((PROBE_DUP >> (b)) & 1); rep_ >= 0; --rep_)
#define OPQ() __builtin_amdgcn_s_waitcnt(0); int tid_ = tid, bid_ = (int)blockIdx.x; GAS unsigned char* wsg_ = (GAS unsigned char*)ws_k; asm volatile("" : "+v"(tid_), "+s"(bid_), "+s"(wsg_)); unsigned char* ws = (unsigned char*)wsg_; float* X = (float*)args.out; bf16* XB = (bf16*)(ws + WS_XB); bf16* AO = (bf16*)(ws + WS_AO); float* SSQ = (float*)(ws + (sqp ? WS_SSQ1 : WS_SSQ)); float* SSQO = (float*)(ws + (sqp ? WS_SSQ : WS_SSQ1)); float* XS = (float*)(ws + WS_XS); (void)X; (void)XB; (void)AO; (void)SSQ; (void)SSQO; (void)XS; const int lane_ = tid_ & 63, wave_ = __builtin_amdgcn_readfirstlane(tid_ >> 6), gw_ = bid_ * NWAVES + wave_; (void)lane_; (void)gw_
#define SEAM(k) do { if (multi && (k) + 1 < hi) { XcdBarrier b_ = bar; GAS unsigned* bp_ = (GAS unsigned*)b_.bar; asm volatile("" : "+s"(bp_)); b_.bar = (unsigned*)bp_; xcd_barrier(b_); if (PROBE_BAR) xcd_barrier(b_); } } while (0)


    int sqp = 0;
    if (EN(0) && IN(0)) REP(0) { OPQ(); p0_prologue(args, lds, gw_, NGW, lane_, wave_); SEAM(0); }

    for (int l = 0; l < DEPTH_; ++l) {
        const int pb = 1 + 10 * l, j = l >> 1;
        for (int f = 0; f < 2; ++f) {
            const int ff = 2 * l + f, p_gu = pb + (f ? 7 : 0), p_dn = p_gu + 1;
            sqp = (3 * l + (f ? 2 : 0)) & 1;
            if (EN(1) && IN(p_gu)) REP(1) {
                OPQ();
                pg8::StaticOrder S; S.init(S_, 2 * FF_, G, bid_);
                unsigned char* Hp = ws + WS_R + R_H;
                const bool ini8 = (GUI8_MASK >> ff) & 1, in8 = !ini8 && ((GU8_MASK >> ff) & 1), out8 = (DN8_MASK >> ff) & 1;
                constexpr int G8 = GU8_MASK & ~GUI8_MASK & 0xff, G16 = ~GU8_MASK & ~GUI8_MASK & 0xff;
                constexpr int MI1 = GUI8_MASK & DN8_MASK, MI0 = GUI8_MASK & ~DN8_MASK & 0xff;
                constexpr int M11 = G8 & DN8_MASK, M10 = G8 & ~DN8_MASK & 0xff, M01 = G16 & DN8_MASK, M00 = G16 & ~DN8_MASK & 0xff;
                pg8::Gemm g8{ws + WS_X8, ws + WS_WGU + (size_t)ff * SZ_WGU, S_, 2 * FF_, D_}, g16{XB, ws + WS_WGU + (size_t)ff * SZ_WGU, S_, 2 * FF_, 2 * D_};
                if (ini8 && out8) { if constexpr (MI1 != 0) { EpiSwiglu<2, true> E{Hp, SSQ, XS}; pg8::gemm_phase<EpiSwiglu<2, true>, pg8::StaticOrder, true, true, 2>(lds, g8, S, E, tid_); } }
                else if (ini8) { if constexpr (MI0 != 0) { EpiSwiglu<2, false> E{Hp, SSQ, XS}; pg8::gemm_phase<EpiSwiglu<2, false>, pg8::StaticOrder, true, true, 2>(lds, g8, S, E, tid_); } }
                else if (in8 && out8) { if constexpr (M11 != 0) { EpiSwiglu<1, true> E{Hp, SSQ, XS}; pg8::gemm_phase<EpiSwiglu<1, true>, pg8::StaticOrder, true, true, 1>(lds, g8, S, E, tid_); } }
                else if (in8) { if constexpr (M10 != 0) { EpiSwiglu<1, false> E{Hp, SSQ, XS}; pg8::gemm_phase<EpiSwiglu<1, false>, pg8::StaticOrder, true, true, 1>(lds, g8, S, E, tid_); } }
                else if (out8) { if constexpr (M01 != 0) { EpiSwiglu<0, true> E{Hp, SSQ, XS}; pg8::gemm_phase<EpiSwiglu<0, true>, pg8::StaticOrder, true, true, 0>(lds, g16, S, E, tid_); } }
                else { if constexpr (M00 != 0) { EpiSwiglu<0, false> E{Hp, SSQ, XS}; pg8::gemm_phase<EpiSwiglu<0, false>, pg8::StaticOrder, true, true, 0>(lds, g16, S, E, tid_); } }
                if (bid_ >= G / 2 && G == 256) p0_deferred_down(args, lds, ff, (bid_ - G / 2) * NWAVES + wave_, (G / 2) * NWAVES, lane_, wave_);
                else if (G != 256) p0_deferred_down(args, lds, ff, bid_ * NWAVES + wave_, G * NWAVES, lane_, wave_);
                SEAM(p_gu);
            }
            if (EN(2) && IN(p_dn)) REP(2) {
                OPQ();
                pg8::StaticOrder S; S.init(S_, D_, G, bid_);
                EpiResid<true> E{args.in[0], X, XB, ws + WS_X8, SSQ, SSQO, XS, rep_ ? 0.0f : 0.5f, (f == 0) ? (((MIX8_MASK >> l) & 1) ? 1 : 0) : (((GUI8_MASK >> (ff + 1)) & 1) ? 1 : (((GU8_MASK >> (ff + 1)) & 1) ? 2 : 0)), ff == 0, ff == 2 * DEPTH_ - 1};
                if ((DN8_MASK >> ff) & 1) { if constexpr (DN8_MASK != 0) { pg8::Gemm g{ws + WS_R + R_H, ws + WS_WD + (size_t)ff * SZ_WD, S_, D_, FF_};
                        pg8::gemm_phase<EpiResid<true>, pg8::StaticOrder, true, true, 1, true, true>(lds, g, S, E, tid_); } }
                else { if constexpr (DN8_MASK != 0xff) { pg8::Gemm g{ws + WS_R + R_H, ws + WS_WD + (size_t)ff * SZ_WD, S_, D_, 2 * FF_};
                        pg8::gemm_phase<EpiResid<true>, pg8::StaticOrder, true, true, 0, true, true>(lds, g, S, E, tid_); } }
                SEAM(p_dn);
            }
            if (f == 0) {
                sqp = (3 * l + 1) & 1;
                if ((l & 1) == 0) {
                    if (EN(3) && IN(pb + 2)) REP(3) {
                        OPQ();
                        const bool m8 = (MIX8_MASK >> l) & 1;
                        const unsigned char* Wd = ws + WS_DWIN + (size_t)j * SZ_DWIN; const int kbp = m8 ? D_ : 2 * D_;
                        const unsigned char* xa = m8 ? (const unsigned char*)(ws + WS_X8) : (const unsigned char*)XB;
                        {
                            pg8::StaticOrder S; S.init(S_, 4096, G, bid_);
                            EpiDsaIn E{(bf16*)(ws + WS_R + R_PROJ), SSQ, XS, m8};
                            pg8::Gemm g{xa, Wd, S_, 4096, kbp};
                            if (m8) { if constexpr ((MIX8_MASK & 5) != 0) pg8::gemm_phase<EpiDsaIn, pg8::StaticOrder, true, true, 2>(lds, g, S, E, tid_); }
                            else { if constexpr ((MIX8_MASK & 5) != 5) pg8::gemm_phase<EpiDsaIn, pg8::StaticOrder, true, true, 0>(lds, g, S, E, tid_); }
                        }
                        {
                            const int ntk = kbp / 128 / 8;
                            EpiDsaEx E{(float*)(ws + WS_R + R_EX), SSQ, XS, m8};
                            for (int L = bid_; L < 256; L += G) {
                                const int pm = L >> 3, sl = L & 7;
                                pg8::Gemm g{xa + (size_t)sl * ntk * 128, Wd + (size_t)16 * 256 * kbp, S_, 256, kbp, ntk};
                                pg8::SingleOrder S1{pg8::Unit{pm, sl}};
                                if (m8) { if constexpr ((MIX8_MASK & 5) != 0) pg8::gemm_phase<EpiDsaEx, pg8::SingleOrder, true, true, 2>(lds, g, S1, E, tid_); }
                                else { if constexpr ((MIX8_MASK & 5) != 5) pg8::gemm_phase<EpiDsaEx, pg8::SingleOrder, true, true, 0>(lds, g, S1, E, tid_); }
                            }
                        }
                        SEAM(pb + 2);
                    }
                    if (EN(4) && IN(pb + 3)) REP(4) { OPQ(); dsa_prep(ws, args.in[7] + j * 128, args.in[8] + j * 128, args.in[9] + j * 64, gw_, NGW, lane_); SEAM(pb + 3); }
                    if (EN(5) && IN(pb + 4)) REP(5) { OPQ(); dsa_select(ws, lds, tid_, lane_, wave_, bid_, G, (PROBE_MODE == 3) && rep_); SEAM(pb + 4); }
                    if (EN(11) && IN(pb + 5)) REP(11) { OPQ(); dsa_attend(ws, args.in[10], lds, tid_, lane_, wave_, j + 2 * rep_); SEAM(pb + 5); }
                } else {
                    if (EN(6) && IN(pb + 2)) REP(6) {
#define HW_PTRS() const bool m8 = (MIX8_MASK >> l) & 1; const unsigned char* Wb = ws + WS_HWIN + (size_t)j * SZ_HWIN; const size_t wstep = (size_t)D_ * D_ * (m8 ? 1 : 2); const float* lbp = (const float*)(ws + WS_LB) + j * D_; const void* xa = m8 ? (const void*)(ws + WS_X8) : (const void*)XB; const int kbp = m8 ? D_ : 2 * D_; (void)lbp
#define HG_CALL(EPI, SCH, S_, G_, E_) do { if (m8) { if constexpr ((MIX8_MASK & 10) != 0) pg8::gemm_phase<EPI, SCH, true, true, 2>(lds, G_, S_, E_, tid_); } else { if constexpr ((MIX8_MASK & 10) != 10) pg8::gemm_phase<EPI, SCH, true, true, false>(lds, G_, S_, E_, tid_); } } while (0)
                        { OPQ(); HW_PTRS(); pg8::StaticOrder S; S.init(S_, D_, G, bid_);
                          pg8::Gemm g{xa, Wb, S_, D_, kbp}; EpiHgrnIn<0> E{(bf16*)(ws + WS_R + R_Q), nullptr, SSQ, lbp, XS, m8};
                          HG_CALL(EpiHgrnIn<0>, pg8::StaticOrder, S, g, E); }
                        { OPQ(); HW_PTRS(); pg8::StaticOrder S; S.init(S_, D_, G, bid_);
                          pg8::Gemm g{xa, Wb + wstep, S_, D_, kbp}; EpiHgrnIn<1> E{nullptr, (float*)(ws + WS_R + R_F), SSQ, lbp, XS, m8};
                          HG_CALL(EpiHgrnIn<1>, pg8::StaticOrder, S, g, E); }
                        { OPQ(); HW_PTRS(); pg8::StaticOrder S; S.init(S_, D_, G, bid_);
                          pg8::Gemm g{xa, Wb + 2 * wstep, S_, D_, kbp}; EpiHgrnIn<2> E{(bf16*)(ws + WS_R + R_G), nullptr, SSQ, lbp, XS, m8};
                          HG_CALL(EpiHgrnIn<2>, pg8::StaticOrder, S, g, E); }
                        {
                            OPQ(); HW_PTRS();
                            pg8::StaticOrder S; S.init(D_, S_, G, bid_);
                            pg8::Unit uu;
                            LAS float* tab = (LAS float*)(lds + LDS_TAB);
                            for (int i = 0; S.next(i, uu); ++i) {
                                __syncthreads();
                                { const int row = uu.pn * 256 + (tid_ >> 1); const f32x4* p = (const f32x4*)(SSQ + (size_t)row * 32 + 16 * (tid_ & 1));
                                  const f32x4 a = p[0], b = p[1], c = p[2], d = p[3];
                                  float s = (((a[0] + a[1]) + (a[2] + a[3])) + ((b[0] + b[1]) + (b[2] + b[3]))) + (((c[0] + c[1]) + (c[2] + c[3])) + ((d[0] + d[1]) + (d[2] + d[3])));
                                  s += __shfl_xor(s, 1);
                                  if ((tid_ & 1) == 0) tab[tid_ >> 1] = __builtin_amdgcn_rsqf(s * (1.0f / D_) + EPS_) * (m8 ? __builtin_amdgcn_rcpf(XS[row] * WI8_SCALE) : 1.0f); }
                                __syncthreads();
                                pg8::Gemm g{Wb + 3 * wstep, xa, D_, S_, kbp};
                                pg8::SingleOrder S1{uu};
                                EpiHgrnVT E{(bf16*)(ws + WS_R + R_VT), tab, m8};
                                if (m8) { if constexpr ((MIX8_MASK & 10) != 0) pg8::gemm_phase<EpiHgrnVT, pg8::SingleOrder, true, true, 2, true, false>(lds, g, S1, E, tid_); }
                                else { if constexpr ((MIX8_MASK & 10) != 10) pg8::gemm_phase<EpiHgrnVT, pg8::SingleOrder, true, true, false, true, false>(lds, g, S1, E, tid_); }
                            }
                        }
                        SEAM(pb + 2);
                    }
                    if (EN(7) && IN(pb + 3)) REP(7) { OPQ(); hgrn_a2(ws, lds, tid_, lane_, wave_, bid_, G); SEAM(pb + 3); }
                    if (EN(8) && IN(pb + 4)) REP(8) { OPQ(); hgrn_b(ws, bid_ * NTHREADS + tid_, G * NTHREADS, rep_); SEAM(pb + 4); }
                    if (EN(9) && IN(pb + 5)) REP(9) { OPQ(); hgrn_c2(ws, args.in[14] + j * D_, lds, tid_, lane_, wave_, bid_, G); SEAM(pb + 5); }
                }
                if (EN(10) && IN(pb + 6)) REP(10) {
                    OPQ();
                    const bf16* Wo = (l & 1) ? (const bf16*)(ws + WS_HWO + (size_t)j * SZ_WO) : (const bf16*)(ws + WS_DWO + (size_t)j * SZ_WO);
                    pg8::Gemm g{AO, Wo, S_, D_, 2 * D_}; pg8::StaticOrder S; S.init(S_, D_, G, bid_);
                    EpiResid<false> E{args.in[0], X, XB, ws + WS_X8, SSQ, SSQO, XS, rep_ ? 0.0f : 1.0f, ((GUI8_MASK >> (2 * l + 1)) & 1) ? 1 : (((GU8_MASK >> (2 * l + 1)) & 1) ? 2 : 0), false, false};
                    pg8::gemm_phase<EpiResid<false>, pg8::StaticOrder, true, true>(lds, g, S, E, tid_);
                    SEAM(pb + 6);
                }
            }
        }
    }
#undef IN
#undef SEAM
}

extern "C" void kernel_launch(void* const* d_in, const int* in_sizes, int n_in, void* d_out, int out_size, void* d_ws, size_t ws_size, hipStream_t stream) {
    static int grid = 0;
    if (grid == 0) {
        if (n_in != 15 || in_sizes[0] != S_ * D_ || out_size != S_ * D_ || ws_size < WS_END) {
            fprintf(stderr, "kernel_launch: unexpected shapes/workspace (n_in %d, in0 %d, out %d, ws %zu, need %zu); nothing launched\n", n_in, n_in > 0 ? in_sizes[0] : -1, out_size, ws_size, (size_t)WS_END);
            grid = -1; return; }
        int dev = 0, cus = 0, per_cu = 0;
        if (hipGetDevice(&dev) != hipSuccess || hipDeviceGetAttribute(&cus, hipDeviceAttributeMultiprocessorCount, dev) != hipSuccess) { grid = -1; return; }
        if (hipFuncSetAttribute((const void*)fwd, hipFuncAttributeMaxDynamicSharedMemorySize, LDS_BYTES) != hipSuccess) { fprintf(stderr, "kernel_launch: hipFuncSetAttribute failed\n"); grid = -1; return; }
        if (hipOccupancyMaxActiveBlocksPerMultiprocessor(&per_cu, (const void*)fwd, NTHREADS, LDS_BYTES) != hipSuccess || per_cu < 1)
            fprintf(stderr, "kernel_launch: note: occupancy query reports %d workgroups per CU\n", per_cu);
        (void)hipGetLastError();
        grid = cus;
    }
    if (grid < 0) return;
    if (hipMemsetAsync((char*)d_ws + WS_CTL, 0, CTL_ZERO_BYTES, stream) != hipSuccess) return;
    Args a{};
    for (int i = 0; i < 15; ++i) a.in[i] = (const float*)d_in[i];
    a.out = (float*)d_out; a.ws = (unsigned char*)d_ws;
#if MK_ONE_LAUNCH
    a.ph_lo = 0; a.ph_hi = N_PHASE_IDS;
    hipLaunchKernelGGL(fwd, dim3(grid), dim3(NTHREADS), LDS_BYTES, stream, a);
#else
    for (int p = 0; p < N_PHASE_IDS; ++p) {
        const int r = (p - 1) % 10, l = (p - 1) / 10;
        if (p > 0) { if (r == 9) continue; }
        a.ph_lo = p; a.ph_hi = p + 1;
        hipLaunchKernelGGL(fwd, dim3(grid), dim3(NTHREADS), LDS_BYTES, stream, a);
    }
#endif
}
```

```cpp
#include <hip/hip_runtime.h>
#include <cstdio>
#include <cstdint>

#ifndef GU8_MASK
#define GU8_MASK 0xFC
#endif
#ifndef DN8_MASK
#define DN8_MASK 0xFE
#endif
#ifndef GUI8_MASK
#define GUI8_MASK 0xFF
#endif
#ifndef MIX8_MASK
#define MIX8_MASK 0xE
#endif
#ifndef MK_ONE_LAUNCH
#define MK_ONE_LAUNCH 1
#endif

namespace pg8 {
#define PG8_LAS __attribute__((address_space(3)))
typedef unsigned short bf16_t;
typedef short bf16x8 __attribute__((ext_vector_type(8)));
typedef float f32x4 __attribute__((ext_vector_type(4)));
typedef unsigned u32x4 __attribute__((ext_vector_type(4)));
constexpr int BM = 256, BK = 64, HALF = 128, HTB = HALF * BK * 2, STAGE_BYTES = 8 * HTB, NXCD = 8, WGM = 8;

__host__ __device__ __forceinline__ int lds_byte(int r, int c) { const int st = (r >> 4) * 2 + (c >> 5), rr = r & 15, cc = c & 31, ob = rr * 64 + cc * 2; return st * 1024 + (ob ^ (((ob >> 9) & 1) << 5)); }
__host__ __device__ __forceinline__ void stage_rc(int b, int& R, int& C) { const int st = b / 1024, sb = b % 1024, swz = sb ^ (((sb >> 9) & 1) << 5); R = (st >> 1) * 16 + swz / 64; C = (st & 1) * 32 + (swz % 64) / 2; }
__host__ __device__ __forceinline__ int perm32(int rho) { const int n = rho >> 4, i = rho & 15; return 8 * (i >> 2) + 4 * n + (i & 3); }

struct Unit { int pm, pn; };
struct Gemm { const void* A; const void* Bt; int M, N, KB; int ntk = 0; };

struct StaticOrder {
    int nM, nN, nwg, G, c;
    __host__ __device__ __forceinline__ void init(int M, int N, int G_, int c_) { nM = M / BM; nN = N / BM; nwg = nM * nN; G = G_; c = c_; }
    __host__ __device__ __forceinline__ bool next(int i, Unit& u) const {
        const long L = (long)i * G + c; if (L >= nwg) return false;
        int wgid = (int)L; { const int q = nwg / NXCD, r = nwg % NXCD, xcd = wgid % NXCD, off = wgid / NXCD; wgid = (xcd < r ? xcd * (q + 1) : r * (q + 1) + (xcd - r) * q) + off; }
        const int nig = WGM * nN, gid = wgid / nig, fm = gid * WGM, gsz = (nM - fm) < WGM ? (nM - fm) : WGM;
        u.pm = fm + ((wgid % nig) % gsz); u.pn = (wgid % nig) / gsz; return true;
    }
    __device__ __forceinline__ void a_ready(const Unit&) const {}
    __device__ __forceinline__ void done(const Unit&) const {}
};
struct SingleOrder {
    Unit u0;
    __device__ __forceinline__ bool next(int i, Unit& u) const { if (i != 0) return false; u = u0; return true; }
    __device__ __forceinline__ void a_ready(const Unit&) const {}
    __device__ __forceinline__ void done(const Unit&) const {}
};

typedef int i32x8 __attribute__((ext_vector_type(8)));
typedef int i32x4v __attribute__((ext_vector_type(4)));
__device__ __forceinline__ i32x8 cat8(bf16x8 lo, bf16x8 hi) { const i32x4v a = __builtin_bit_cast(i32x4v, lo), b = __builtin_bit_cast(i32x4v, hi); return (i32x8){a[0], a[1], a[2], a[3], b[0], b[1], b[2], b[3]}; }
template <class Epi, int FP8> struct FP8SC { static constexpr int A = 0, B = 0; };
template <class Epi> struct FP8SC<Epi, 1> { static constexpr int A = Epi::SCALE_A, B = Epi::SCALE_B; };
template <class Epi, class Sched, bool ALIGN_EPI = false, bool SP2 = false, int FP8 = 0, bool TA = false, bool TB = true>
__device__ __forceinline__ void gemm_phase(PG8_LAS unsigned char* lds, const Gemm g, const Sched& S, const Epi& E, const int tid) {
    const int wid = __builtin_amdgcn_readfirstlane(tid >> 6), lane = tid & 63, wr = wid >> 2, wc = wid & 3, fr = lane & 15, fq = lane >> 4;
    const int K = g.KB, nt = g.ntk ? g.ntk : K / 128;
    unsigned voffA[2], voffB[2];
#pragma unroll
    for (int i = 0; i < 2; ++i) { int R, C; stage_rc(tid * 16 + i * 8192, R, C); const int Rb = Epi::PERM ? ((R & ~31) + perm32(R & 31)) : R;
        voffA[i] = TA ? (unsigned)(R * 128 + C * 2) : (unsigned)(R * K + C * 2); voffB[i] = TB ? (unsigned)(Rb * 128 + C * 2) : (unsigned)(Rb * K + C * 2); }
    const size_t kstepA = TA ? 32768 : 128, kstepB = TB ? 32768 : 128;
    const size_t hstepA = TA ? 16384 : (size_t)HALF * K, hstepB = TB ? 16384 : (size_t)HALF * K;
    const size_t tstepA = TA ? (size_t)32768 * nt : (size_t)256 * K, tstepB = TB ? (size_t)32768 * nt : (size_t)256 * K;
    const unsigned ldsw = (unsigned)wid * 1024u;
    const int aoff = lds_byte(wr * 64 + fr, fq * 8), boff = lds_byte(wc * 32 + fr, fq * 8);
#define PG8_SA(b, h) (((b) * 2 + (h)) * HTB)
#define PG8_SB(b, h) ((4 + (b) * 2 + (h)) * HTB)
#define PG8_STAGE(bufoff, gbase, voff) do { _Pragma("unroll") for (int _i = 0; _i < 2; ++_i) \
        __builtin_amdgcn_global_load_lds((const unsigned*)((const char*)(gbase) + (voff)[_i]), (PG8_LAS unsigned*)(lds + (bufoff) + ldsw + _i * 8192), 16, 0, 0); } while (0)
#define PG8_LD8(p) __builtin_shufflevector(*(const PG8_LAS i32x4v*)(p), *(const PG8_LAS i32x4v*)((p) + 1024), 0, 1, 2, 3, 4, 5, 6, 7)
#define PG8_LDA(dst, b, h) do { _Pragma("unroll") for (int m = 0; m < 4; ++m) { if constexpr (FP8 == 1) dst##8[m] = PG8_LD8(lds + PG8_SA(b, h) + aoff + m * 2048); else { _Pragma("unroll") for (int k = 0; k < 2; ++k) dst[m][k] = *(const PG8_LAS bf16x8*)(lds + PG8_SA(b, h) + aoff + m * 2048 + k * 1024); } } } while (0)
#define PG8_LDB(dst, b, h) do { _Pragma("unroll") for (int n = 0; n < 2; ++n) { if constexpr (FP8 == 1) dst##8[n] = PG8_LD8(lds + PG8_SB(b, h) + boff + n * 2048); else { _Pragma("unroll") for (int k = 0; k < 2; ++k) dst[n][k] = *(const PG8_LAS bf16x8*)(lds + PG8_SB(b, h) + boff + n * 2048 + k * 1024); } } } while (0)
#define PG8_MMA(ai, bj, At, Bt) do { __builtin_amdgcn_s_setprio(1); _Pragma("unroll") for (int m = 0; m < 4; ++m) _Pragma("unroll") for (int n = 0; n < 2; ++n) { \
        if constexpr (FP8 == 1) asm volatile("v_mfma_scale_f32_16x16x128_f8f6f4 %0, %1, %2, %0, %3, %4 op_sel_hi:[0,0,0]" : "+v"(acc[ai][bj][m][n]) : "v"(Bt##8[n]), "v"(At##8[m]), "v"(sc_b), "v"(sc_a)); \
        else if constexpr (FP8 == 2) { _Pragma("unroll") for (int k = 0; k < 2; ++k) asm volatile("v_mfma_i32_16x16x64_i8 %0, %1, %2, %0" : "+v"(acc[ai][bj][m][n]) : "v"(Bt[n][k]), "v"(At[m][k])); } \
        else { _Pragma("unroll") for (int k = 0; k < 2; ++k) acc[ai][bj][m][n] = __builtin_amdgcn_mfma_f32_16x16x32_bf16(Bt[n][k], At[m][k], acc[ai][bj][m][n], 0, 0, 0); } } __builtin_amdgcn_s_setprio(0); } while (0)
#define PG8_WAIT_V(n) asm volatile("s_waitcnt vmcnt(" #n ")" ::: "memory")
#define PG8_WAIT_L(n) asm volatile("s_waitcnt lgkmcnt(" #n ")" ::: "memory")
#define PG8_BAR __builtin_amdgcn_s_barrier()
#define PG8_SCHED __builtin_amdgcn_sched_barrier(0)
    Unit cur, nxt; int ui = 0;
    if (!S.next(0, cur)) return;
    f32x4 acc[2][2][4][2];
#pragma unroll
    for (int a = 0; a < 2; ++a)
#pragma unroll
        for (int b = 0; b < 2; ++b)
#pragma unroll
            for (int m = 0; m < 4; ++m)
#pragma unroll
                for (int n = 0; n < 2; ++n) acc[a][b][m][n] = (f32x4){0.f, 0.f, 0.f, 0.f};
    const int sc_a = Epi::PERM ? FP8SC<Epi, FP8>::A : FP8SC<Epi, FP8>::A, sc_b = FP8SC<Epi, FP8>::B;
    bf16x8 At[4][2], B0[2][2], B1[2][2]; i32x8 At8[4], B08[2], B18[2];
    const char* cA = (const char*)g.A + (size_t)cur.pm * tstepA; const char* cB = (const char*)g.Bt + (size_t)cur.pn * tstepB;
    S.a_ready(cur);
    if constexpr (SP2) {
        PG8_STAGE(PG8_SB(0, 0), cB, voffB); PG8_STAGE(PG8_SB(0, 1), cB + hstepB, voffB); PG8_STAGE(PG8_SA(0, 0), cA, voffA); PG8_STAGE(PG8_SA(0, 1), cA + hstepA, voffA);
        if (wr == 1) PG8_BAR;
        PG8_WAIT_V(2); PG8_BAR;
        PG8_STAGE(PG8_SB(1, 0), cB + kstepB, voffB); PG8_STAGE(PG8_SA(1, 0), cA + kstepA, voffA); PG8_STAGE(PG8_SB(1, 1), cB + hstepB + kstepB, voffB);
        PG8_WAIT_V(6); PG8_BAR;
    } else {
        PG8_STAGE(PG8_SB(0, 0), cB, voffB); PG8_STAGE(PG8_SA(0, 0), cA, voffA); PG8_STAGE(PG8_SB(0, 1), cB + hstepB, voffB); PG8_STAGE(PG8_SA(0, 1), cA + hstepA, voffA);
        if (wr == 1) PG8_BAR;
        PG8_WAIT_V(4); PG8_BAR;
        PG8_STAGE(PG8_SB(1, 0), cB + kstepB, voffB); PG8_STAGE(PG8_SA(1, 0), cA + kstepA, voffA); PG8_STAGE(PG8_SB(1, 1), cB + hstepB + kstepB, voffB);
        PG8_WAIT_V(6); PG8_BAR;
    }
    for (;;) {
        const bool has_next = S.next(ui + 1, nxt);
        const char* nA = has_next ? (const char*)g.A + (size_t)nxt.pm * tstepA : cA; const char* nB = has_next ? (const char*)g.Bt + (size_t)nxt.pn * tstepB : cB;
        for (int t = 0; t < nt; t += 2) {
            const bool last = (t == nt - 2);
            const char* a1 = cA + (size_t)(t + 1) * kstepA;
            const char* a2 = last ? nA : cA + (size_t)(t + 2) * kstepA; const char* b2 = last ? nB : cB + (size_t)(t + 2) * kstepB;
            const char* a3 = a2 + kstepA; const char* b3 = b2 + kstepB;
            if (last && has_next) S.a_ready(nxt);
            if constexpr (SP2) {
            PG8_LDB(B0, 0, 0); PG8_LDB(B1, 0, 1); PG8_SCHED; PG8_LDA(At, 0, 0); PG8_STAGE(PG8_SA(1, 1), a1 + hstepA, voffA);
            PG8_WAIT_V(8); PG8_WAIT_L(0); PG8_BAR; PG8_MMA(0, 0, At, B0); PG8_MMA(0, 1, At, B1); PG8_BAR; PG8_SCHED;
            PG8_LDA(At, 0, 1); PG8_STAGE(PG8_SB(0, 0), b2, voffB); PG8_STAGE(PG8_SB(0, 1), b2 + hstepB, voffB); PG8_STAGE(PG8_SA(0, 0), a2, voffA);
            PG8_WAIT_V(8); PG8_WAIT_L(0); PG8_BAR; PG8_MMA(1, 0, At, B0); PG8_MMA(1, 1, At, B1); PG8_BAR; PG8_SCHED;
            PG8_LDB(B0, 1, 0); PG8_LDB(B1, 1, 1); PG8_SCHED; PG8_LDA(At, 1, 0); PG8_STAGE(PG8_SA(0, 1), a2 + hstepA, voffA);
            PG8_WAIT_V(8); PG8_WAIT_L(0); PG8_BAR; PG8_MMA(0, 0, At, B0); PG8_MMA(0, 1, At, B1); PG8_BAR; PG8_SCHED;
            PG8_LDA(At, 1, 1); PG8_STAGE(PG8_SB(1, 0), b3, voffB); PG8_STAGE(PG8_SB(1, 1), b3 + hstepB, voffB); PG8_STAGE(PG8_SA(1, 0), a3, voffA);
            PG8_WAIT_V(8); PG8_WAIT_L(0); PG8_BAR; PG8_MMA(1, 0, At, B0); PG8_MMA(1, 1, At, B1); PG8_BAR; PG8_SCHED;
            } else {
            PG8_LDB(B0, 0, 0); PG8_SCHED; PG8_LDA(At, 0, 0); PG8_STAGE(PG8_SA(1, 1), a1 + hstepA, voffA);
            PG8_WAIT_L(8); PG8_BAR; PG8_WAIT_L(0); PG8_MMA(0, 0, At, B0); PG8_BAR; PG8_SCHED;
            PG8_LDB(B1, 0, 1); PG8_STAGE(PG8_SB(0, 0), b2, voffB);
            PG8_BAR; PG8_WAIT_L(0); PG8_MMA(0, 1, At, B1); PG8_BAR;
            PG8_LDA(At, 0, 1); PG8_STAGE(PG8_SA(0, 0), a2, voffA);
            PG8_BAR; PG8_WAIT_L(0); PG8_MMA(1, 0, At, B0); PG8_BAR; PG8_SCHED;
            PG8_STAGE(PG8_SB(0, 1), b2 + hstepB, voffB);
            PG8_WAIT_V(6); PG8_BAR; PG8_MMA(1, 1, At, B1); PG8_BAR;
            PG8_LDB(B0, 1, 0); PG8_SCHED; PG8_LDA(At, 1, 0); PG8_STAGE(PG8_SA(0, 1), a2 + hstepA, voffA);
            PG8_WAIT_L(8); PG8_BAR; PG8_WAIT_L(0); PG8_MMA(0, 0, At, B0); PG8_BAR; PG8_SCHED;
            PG8_LDB(B1, 1, 1); PG8_STAGE(PG8_SB(1, 0), b3, voffB);
            PG8_BAR; PG8_WAIT_L(0); PG8_MMA(0, 1, At, B1); PG8_BAR;
            PG8_LDA(At, 1, 1); PG8_STAGE(PG8_SA(1, 0), a3, voffA);
            PG8_BAR; PG8_WAIT_L(0); PG8_MMA(1, 0, At, B0); PG8_BAR; PG8_SCHED;
            PG8_STAGE(PG8_SB(1, 1), b3 + hstepB, voffB);
            PG8_WAIT_V(6); PG8_BAR; PG8_MMA(1, 1, At, B1); PG8_BAR;
            }
        }
        if constexpr (ALIGN_EPI) { if (wr == 0) PG8_BAR; }
        E(acc, cur, wr, wc, fr, fq);
        if (!has_next) break;
#pragma unroll
        for (int a = 0; a < 2; ++a)
#pragma unroll
            for (int b = 0; b < 2; ++b)
#pragma unroll
                for (int m = 0; m < 4; ++m)
#pragma unroll
                    for (int n = 0; n < 2; ++n) acc[a][b][m][n] = (f32x4){0.f, 0.f, 0.f, 0.f};
        cur = nxt; cA = nA; cB = nB; ++ui;
        if constexpr (ALIGN_EPI) { if (wr == 1) PG8_BAR; }
    }
    PG8_WAIT_V(0);
    if constexpr (!ALIGN_EPI) { if (wr == 0) PG8_BAR; }
    PG8_BAR;
#undef PG8_SA
#undef PG8_SB
#undef PG8_STAGE
#undef PG8_LDA
#undef PG8_LD8
#undef PG8_LDB
#undef PG8_MMA
#undef PG8_WAIT_V
#undef PG8_WAIT_L
#undef PG8_BAR
#undef PG8_SCHED
}
}

constexpr int S_ = 8192, D_ = 2048, FF_ = 5632, DEPTH_ = 4;
constexpr int A_IN = 4176, A_IN_PAD = 4352;
constexpr int PROJ_LD = 4096;
constexpr int EX_LD = 128;
constexpr int TOPK = 256;
constexpr float EPS_ = 1e-6f;
constexpr int NWAVES = 8, NTHREADS = 512;

typedef unsigned short bf16;
typedef short bf16x8 __attribute__((ext_vector_type(8)));
typedef short s16x4 __attribute__((ext_vector_type(4)));
typedef float f32x4 __attribute__((ext_vector_type(4)));
typedef float f32x2 __attribute__((ext_vector_type(2)));
typedef float f32x16 __attribute__((ext_vector_type(16)));
typedef unsigned u32x4 __attribute__((ext_vector_type(4)));
typedef unsigned u32x2 __attribute__((ext_vector_type(2)));
typedef int i32x4 __attribute__((ext_vector_type(4)));
typedef __bf16 bf2_t __attribute__((ext_vector_type(2)));
#define LAS __attribute__((address_space(3)))
#define GAS __attribute__((address_space(1)))
#define DI __device__ __forceinline__

DI unsigned pk2(float lo, float hi) { f32x2 v = {lo, hi}; bf2_t r = __builtin_convertvector(v, bf2_t); return __builtin_bit_cast(unsigned, r); }
DI float bf_lo(unsigned w) { return __uint_as_float(w << 16); }
DI float bf_hi(unsigned w) { return __uint_as_float(w & 0xffff0000u); }
typedef _Float16 h2_t __attribute__((ext_vector_type(2)));
DI unsigned pkh2(float a, float b) { const h2_t h = {(_Float16)a, (_Float16)b}; return __builtin_bit_cast(unsigned, h); }
DI float h_lo(unsigned w) { return (float)__builtin_bit_cast(h2_t, w)[0]; }
DI float h_hi(unsigned w) { return (float)__builtin_bit_cast(h2_t, w)[1]; }
DI bf16x8 pack8(const float* v) { u32x4 w; w.x = pk2(v[0], v[1]); w.y = pk2(v[2], v[3]); w.z = pk2(v[4], v[5]); w.w = pk2(v[6], v[7]); return __builtin_bit_cast(bf16x8, w); }
DI void unpack8(u32x4 w, float* v) { v[0] = bf_lo(w.x); v[1] = bf_hi(w.x); v[2] = bf_lo(w.y); v[3] = bf_hi(w.y); v[4] = bf_lo(w.z); v[5] = bf_hi(w.z); v[6] = bf_lo(w.w); v[7] = bf_hi(w.w); }
DI float silu_f(float g) { return g * __builtin_amdgcn_rcpf(1.0f + __expf(-g)); }
DI float sigmoid_f(float g) { return __builtin_amdgcn_rcpf(1.0f + __expf(-g)); }
#define LDS_WAIT() asm volatile("s_waitcnt lgkmcnt(0)" ::: "memory")
#define MFMA32(a, b, c) __builtin_amdgcn_mfma_f32_32x32x16_bf16((a), (b), (c), 0, 0, 0)
#define MFMA16(a, b, c) __builtin_amdgcn_mfma_f32_16x16x32_bf16((a), (b), (c), 0, 0, 0)

constexpr size_t MiB = 1u << 20;
constexpr size_t WS_CTL = 0, CTL_ZERO_BYTES = 1 * MiB;
constexpr size_t WS_LB = 1 * MiB;
constexpr size_t WS_SSQ = 2 * MiB;
constexpr size_t WS_XB = 3 * MiB;
constexpr size_t WS_AO = 35 * MiB;
constexpr size_t WS_W = 67 * MiB;
constexpr size_t SZ_WGU = 44 * MiB, SZ_WD = 22 * MiB, SZ_DWIN = 17 * MiB, SZ_WO = 8 * MiB, SZ_HWIN = 32 * MiB;
constexpr size_t WS_WGU = WS_W;
constexpr size_t WS_WD = WS_WGU + 8 * SZ_WGU;
constexpr size_t WS_DWIN = WS_WD + 8 * SZ_WD;
constexpr size_t WS_DWO = WS_DWIN + 2 * SZ_DWIN;
constexpr size_t WS_HWIN = WS_DWO + 2 * SZ_WO;
constexpr size_t WS_HWO = WS_HWIN + 2 * SZ_HWIN;
constexpr size_t WS_R = WS_HWO + 2 * SZ_WO;
constexpr size_t R_H = 0;
constexpr size_t R_PROJ = 0;
constexpr size_t R_EX = 112 * MiB;
constexpr size_t R_IKN = 72 * MiB;
constexpr size_t R_IWS = 73 * MiB;
constexpr size_t R_SEL = 74 * MiB;
constexpr size_t R_Q8 = 82 * MiB;
constexpr size_t R_K8 = 98 * MiB;
constexpr size_t R_V8 = 102 * MiB;
constexpr size_t R_Q = 0;
constexpr size_t R_F = 32 * MiB;
constexpr size_t R_G = 96 * MiB;
constexpr size_t R_VT = 128 * MiB;
constexpr size_t R_BC = 160 * MiB;
constexpr size_t R_ST = 224 * MiB;
constexpr size_t R_EBL = 352 * MiB;
constexpr size_t WS_X8 = WS_R + 353 * MiB;
constexpr size_t WS_SSQ1 = WS_X8 + 16 * MiB;
constexpr size_t WS_XS = WS_SSQ1 + 1 * MiB;
constexpr size_t WS_END = WS_XS + 1 * MiB;

constexpr int CW_BAR = 4096;
constexpr int CW_WQ = 8192;

constexpr int RING_BYTES = 131072;
constexpr int LDS_AUX = RING_BYTES;
constexpr int LDS_TAB = 161792;
constexpr int LDS_MISC = 162816;
constexpr int LDS_BYTES = 163840;

#define XB_TMO      128
#define XB_XCNT(j)  (256  + 64 * (j))
#define XB_XSUB(j)  (1280 + 64 * (j))
#define XB_XGEN(j)  (2304 + 64 * (j))
#define XB_TOP      3328
#define XB_TOPGEN   3392
#define XCD_BAR_WORDS 3456
#define XB_SPIN_CAP (1u << 18)

__device__ __forceinline__ unsigned xb_ld(unsigned* p)              { return __hip_atomic_load(p, __ATOMIC_RELAXED, __HIP_MEMORY_SCOPE_AGENT); }
__device__ __forceinline__ unsigned xb_add(unsigned* p, unsigned v) { return __hip_atomic_fetch_add(p, v, __ATOMIC_RELAXED, __HIP_MEMORY_SCOPE_AGENT); }
__device__ __forceinline__ unsigned xb_xcc_id() { return (unsigned)__builtin_amdgcn_s_getreg((3 << 11) | 20) & 0xFu; }
#define XB_SPIN(cond, bar) do { unsigned _sp = 0; while (cond) { __builtin_amdgcn_s_sleep(1); \
    if ((++_sp & 255u) == 0u) { if (xb_ld(&(bar)[XB_TMO])) break; if (_sp > XB_SPIN_CAP) { atomicAdd(&(bar)[XB_TMO], 1u); break; } } } } while (0)

struct XcdBarrier {
    unsigned* bar; unsigned x;
    volatile LAS unsigned* st;
};
__device__ __forceinline__ XcdBarrier xcd_barrier_post(unsigned* bar, volatile LAS unsigned* st) {
    XcdBarrier b; b.bar = bar; b.x = xb_xcc_id(); b.st = st;
    if (threadIdx.x == 0) (void)xb_add(&bar[XB_XCNT(b.x)], 1u);
    return b;
}
__device__ __forceinline__ void xcd_barrier_complete(unsigned* bar, unsigned x, unsigned& nloc, unsigned& nx) {
    const unsigned G = gridDim.x * gridDim.y * gridDim.z;
    unsigned sum, cnt, mine, sp = 0u;
    for (;;) {
        sum = 0u; cnt = 0u; mine = 0u;
#pragma unroll
        for (unsigned j = 0; j < 16; ++j) { const unsigned c = xb_ld(&bar[XB_XCNT(j)]); sum += c; cnt += (c > 0u) ? 1u : 0u; mine = (j == x) ? c : mine; }
        if (sum == G) break;
        __builtin_amdgcn_s_sleep(1);
        if ((++sp & 255u) == 0u) { if (xb_ld(&bar[XB_TMO])) break; if (sp > XB_SPIN_CAP) { atomicAdd(&bar[XB_TMO], 1u); break; } }
    }
    nloc = mine > 0u ? mine : 1u; nx = cnt > 0u ? cnt : 1u;
}
__device__ __forceinline__ void xcd_barrier(const XcdBarrier& b) {
    asm volatile("s_waitcnt vmcnt(0)" ::: "memory");
    __syncthreads();
    if (threadIdx.x == 0) {
        unsigned* bar = b.bar;
        __builtin_amdgcn_s_waitcnt(0);
        unsigned nloc = b.st[0], nx = b.st[1];
        if (nloc == 0u) { xcd_barrier_complete(bar, b.x, nloc, nx); b.st[0] = nloc; b.st[1] = nx; }
        const unsigned old = xb_add(&bar[XB_XSUB(b.x)], 1u);
        const unsigned gen = old / nloc;
        if (old + 1u == (gen + 1u) * nloc) {
            __builtin_amdgcn_fence(__ATOMIC_RELEASE, "agent");
            asm volatile("s_waitcnt vmcnt(0)" ::: "memory");
            const unsigned og = xb_add(&bar[XB_TOP], 1u);
            const unsigned tg = og / nx;
            if (og + 1u == (tg + 1u) * nx) xb_add(&bar[XB_TOPGEN], 1u);
            else XB_SPIN(xb_ld(&bar[XB_TOPGEN]) == tg, bar);
            __builtin_amdgcn_fence(__ATOMIC_ACQUIRE, "agent");
            xb_add(&bar[XB_XGEN(b.x)], 1u);
            asm volatile("s_waitcnt vmcnt(0)" ::: "memory");
        } else {
            XB_SPIN(xb_ld(&bar[XB_XGEN(b.x)]) == gen, bar);
            __builtin_amdgcn_fence(__ATOMIC_ACQUIRE, "agent");
            asm volatile("s_waitcnt vmcnt(0)" ::: "memory");
        }
    }
    __syncthreads();
}

DI size_t tiled_off(int r, int kb, int KB) { return (size_t)(r >> 8) * ((size_t)KB * 256) + (size_t)(kb >> 7) * 32768 + (size_t)(r & 255) * 128 + (kb & 127); }
DI float load_rstd1(const float* ssq, int row, int fq) {
    const f32x4* p = (const f32x4*)(ssq + (size_t)row * 32 + 8 * fq);
    const f32x4 a = p[0], b = p[1];
    float s = ((a[0] + a[1]) + (a[2] + a[3])) + ((b[0] + b[1]) + (b[2] + b[3]));
    s += __shfl_xor(s, 16); s += __shfl_xor(s, 32);
    return __builtin_amdgcn_rsqf(s * (1.0f / D_) + EPS_);
}
#define EPI_FENCE() asm volatile("" ::: "memory")
constexpr float WI8_SCALE = 1250.0f;
template <int NB = 1> DI void row_factors8(const float* ssq, const float* XS, const bool i8, const int row0, const int fq, float (&rq)[8]) {
    __builtin_amdgcn_s_waitcnt(0);
    constexpr int GB = 8 / NB;
#pragma unroll
    for (int b0 = 0; b0 < 8; b0 += GB) {
        f32x4 pa[GB], pb[GB]; float xv[GB], sp[GB], t[GB];
#pragma unroll
        for (int gi = 0; gi < GB; ++gi) { const int row = row0 + ((b0 + gi) >> 2) * 128 + ((b0 + gi) & 3) * 16; const f32x4* p = (const f32x4*)(ssq + (size_t)row * 32 + 8 * fq); pa[gi] = p[0]; pb[gi] = p[1]; xv[gi] = XS[row]; }
        EPI_FENCE();
#pragma unroll
        for (int gi = 0; gi < GB; ++gi) sp[gi] = ((pa[gi][0] + pa[gi][1]) + (pa[gi][2] + pa[gi][3])) + ((pb[gi][0] + pb[gi][1]) + (pb[gi][2] + pb[gi][3]));
#pragma unroll
        for (int gi = 0; gi < GB; ++gi) t[gi] = __shfl_xor(sp[gi], 16);
#pragma unroll
        for (int gi = 0; gi < GB; ++gi) sp[gi] += t[gi];
#pragma unroll
        for (int gi = 0; gi < GB; ++gi) t[gi] = __shfl_xor(sp[gi], 32);
#pragma unroll
        for (int gi = 0; gi < GB; ++gi) { const float r = __builtin_amdgcn_rsqf((sp[gi] + t[gi]) * (1.0f / D_) + EPS_); rq[b0 + gi] = i8 ? r * __builtin_amdgcn_rcpf(xv[gi] * WI8_SCALE) : r; }
        EPI_FENCE();
    }
}

DI float sat8(float v) { return __builtin_amdgcn_fmed3f(v, -448.0f, 448.0f); }
DI unsigned pk4_fp8s(float a, float b, float c, float d) { int w = 0; w = __builtin_amdgcn_cvt_pk_fp8_f32(sat8(a), sat8(b), w, false); w = __builtin_amdgcn_cvt_pk_fp8_f32(sat8(c), sat8(d), w, true); return (unsigned)w; }
DI unsigned pk4_i8(float a, float b, float c, float d) {
    const unsigned ua = __float_as_uint(__builtin_amdgcn_fmed3f(a, -127.f, 127.f) + 12582912.0f), ub = __float_as_uint(__builtin_amdgcn_fmed3f(b, -127.f, 127.f) + 12582912.0f);
    const unsigned uc = __float_as_uint(__builtin_amdgcn_fmed3f(c, -127.f, 127.f) + 12582912.0f), ud = __float_as_uint(__builtin_amdgcn_fmed3f(d, -127.f, 127.f) + 12582912.0f);
    return __builtin_amdgcn_perm(ub, ua, 0x0c0c0400u) | __builtin_amdgcn_perm(ud, uc, 0x04000c0cu); }
constexpr int SC_ONE = 0x7f7f7f7f;
constexpr int SC_W64 = 0x79797979;
constexpr int SC_H8 = 0x7c7c7c7c;

template <int IN8, bool OUT8> struct EpiSwiglu {
    static constexpr bool PERM = true; static constexpr int SCALE_A = SC_ONE, SCALE_B = SC_W64;
    unsigned char* H; const float* ssq; const float* XS;
    DI void operator()(const f32x4 (&acc)[2][2][4][2], const pg8::Unit& u, int wr, int wc, int fr_in, int fq_in) const {
        int fr = fr_in, fq = fq_in; asm volatile("" : "+v"(fr), "+v"(fq));
        const int row0 = u.pm * 256 + wr * 64 + fr;
        const int col0 = u.pn * 128 + wc * 32 + 8 * fq;
        float rqa[8];
        row_factors8(ssq, XS, IN8 == 2, row0, fq, rqa);
#pragma unroll
        for (int ai = 0; ai < 2; ++ai)
#pragma unroll
            for (int m = 0; m < 4; ++m) {
                const int row = row0 + ai * 128 + m * 16;
                const float rq = rqa[ai * 4 + m];
                const float rq_e = rq * -1.4426950408889634f, rq_h = rq * rq * (OUT8 ? 8.0f : 1.0f);
                float h[8];
#pragma unroll
                for (int n = 0; n < 2; ++n)
#pragma unroll
                    for (int e = 0; e < 4; ++e) {
                        const float ag = (IN8 == 2) ? (float)__float_as_int(acc[ai][0][m][n][e]) : acc[ai][0][m][n][e];
                        const float au = (IN8 == 2) ? (float)__float_as_int(acc[ai][1][m][n][e]) : acc[ai][1][m][n][e];
                        const float sg = __builtin_amdgcn_rcpf(1.0f + __builtin_amdgcn_exp2f(ag * rq_e));
                        h[4 * n + e] = (ag * au) * rq_h * sg; }
                if constexpr (OUT8) { u32x2 w; w.x = pk4_fp8s(h[0], h[1], h[2], h[3]); w.y = pk4_fp8s(h[4], h[5], h[6], h[7]); *(u32x2*)(H + tiled_off(row, col0, FF_)) = w; }
                else *(bf16x8*)(H + tiled_off(row, 2 * col0, 2 * FF_)) = pack8(h);
                EPI_FENCE();
            }
    }
};

constexpr float XI8_CLIP = 5.0f;
template <bool F8> struct EpiResid {
    static constexpr bool PERM = true; static constexpr int SCALE_A = SC_H8, SCALE_B = SC_W64;
    const float* base32; float* out32; bf16* XB; unsigned char* X8; const float* ssq_old; float* ssq; float* XS; float coef; int x8i; bool first, last;
    DI void operator()(const f32x4 (&acc)[2][2][4][2], const pg8::Unit& u, int wr, int wc, int fr_in, int fq_in) const {
        int fr = fr_in, fq = fq_in; asm volatile("" : "+v"(fr), "+v"(fq));
        const int row0 = u.pm * 256 + wr * 64 + fr, col0 = u.pn * 256 + wc * 32 + 8 * fq;
        float xsa[8];
        if (x8i == 1) {
            row_factors8<2>(ssq_old, ssq_old, false, row0, fq, xsa);
#pragma unroll
            for (int gi = 0; gi < 8; ++gi) { xsa[gi] *= (127.0f / XI8_CLIP); if (u.pn == 0 && wc == 0 && fq == 0) XS[row0 + (gi >> 2) * 128 + (gi & 3) * 16] = xsa[gi]; }
        } else {
            __builtin_amdgcn_s_waitcnt(0);
#pragma unroll
            for (int gi = 0; gi < 8; ++gi) xsa[gi] = 0.f;
        }
        f32x4 bq[2][2]; u32x4 bw[2];
#define RES_LOADB(gi_) do { const int row_ = row0 + ((gi_) >> 2) * 128 + ((gi_) & 3) * 16; \
            if (first) { _Pragma("unroll") for (int bj = 0; bj < 2; ++bj) _Pragma("unroll") for (int n = 0; n < 2; ++n) bq[bj][n] = *(const f32x4*)(base32 + (size_t)row_ * D_ + col0 + bj * 128 + n * 4); } \
            else { _Pragma("unroll") for (int bj = 0; bj < 2; ++bj) bw[bj] = *(const u32x4*)(XB + (size_t)row_ * D_ + col0 + bj * 128); } } while (0)
        RES_LOADB(0);
#pragma unroll
        for (int ai = 0; ai < 2; ++ai)
#pragma unroll
            for (int m = 0; m < 4; ++m) {
                const int gi = ai * 4 + m;
                const int row = row0 + ai * 128 + m * 16; float s = 0.f;
                const float xs = xsa[gi];
                f32x4 b[2][2];
#pragma unroll
                for (int bj = 0; bj < 2; ++bj) {
                    const f32x4 lo_ = {bf_lo(bw[bj].x), bf_hi(bw[bj].x), bf_lo(bw[bj].y), bf_hi(bw[bj].y)}; const f32x4 hi_ = {bf_lo(bw[bj].z), bf_hi(bw[bj].z), bf_lo(bw[bj].w), bf_hi(bw[bj].w)};
                    b[bj][0] = first ? bq[bj][0] : lo_; b[bj][1] = first ? bq[bj][1] : hi_; }
                EPI_FENCE();
                if (gi < 7) RES_LOADB(gi + 1);
                EPI_FENCE();
#pragma unroll
                for (int bj = 0; bj < 2; ++bj) {
                    const size_t off = (size_t)row * D_ + col0 + bj * 128;
                    const f32x4 v0 = b[bj][0] + coef * acc[ai][bj][m][0], v1 = b[bj][1] + coef * acc[ai][bj][m][1];
                    if (last) { *(f32x4*)(out32 + off) = v0; *(f32x4*)(out32 + off + 4) = v1; }
                    else { u32x4 w; w.x = pk2(v0[0], v0[1]); w.y = pk2(v0[2], v0[3]); w.z = pk2(v1[0], v1[1]); w.w = pk2(v1[2], v1[3]); *(u32x4*)(XB + off) = w; }
                    if (x8i != 0) { u32x2 q;
                        q.x = (x8i == 1) ? pk4_i8(v0[0] * xs, v0[1] * xs, v0[2] * xs, v0[3] * xs) : pk4_fp8s(v0[0], v0[1], v0[2], v0[3]);
                        q.y = (x8i == 1) ? pk4_i8(v1[0] * xs, v1[1] * xs, v1[2] * xs, v1[3] * xs) : pk4_fp8s(v1[0], v1[1], v1[2], v1[3]);
                        *(u32x2*)(X8 + off) = q; }
                    s += ((v0[0] * v0[0] + v0[1] * v0[1]) + (v0[2] * v0[2] + v0[3] * v0[3])) + ((v1[0] * v1[0] + v1[1] * v1[1]) + (v1[2] * v1[2] + v1[3] * v1[3]));
                }
                s += __shfl_xor(s, 16); s += __shfl_xor(s, 32);
                if (fq == 0) ssq[(size_t)row * 32 + u.pn * 4 + wc] = s;
                EPI_FENCE();
            }
#undef RES_LOADB
    }
};

DI f32x4 acc_f(const f32x4 a, const bool i8) { f32x4 o;
#pragma unroll
    for (int e = 0; e < 4; ++e) o[e] = i8 ? (float)__float_as_int(a[e]) : a[e];
    return o; }
struct EpiDsaEx {
    static constexpr bool PERM = true; static constexpr int SCALE_A = SC_ONE, SCALE_B = SC_W64;
    float* EXP; const float* ssq; const float* XS; bool i8;
    DI void operator()(const f32x4 (&acc)[2][2][4][2], const pg8::Unit& u, int wr, int wc, int fr_in, int fq_in) const {
        int fr = fr_in, fq = fq_in; asm volatile("" : "+v"(fr), "+v"(fq));
        const int row0 = u.pm * 256 + wr * 64 + fr, col0 = wc * 32 + 8 * fq;
        float rqa[8]; row_factors8<2>(ssq, XS, i8, row0, fq, rqa);
#pragma unroll
        for (int ai = 0; ai < 2; ++ai)
#pragma unroll
            for (int m = 0; m < 4; ++m) {
                const int row = row0 + ai * 128 + m * 16;
                const float r = rqa[ai * 4 + m];
                float* p = EXP + ((size_t)u.pn * S_ + row) * EX_LD + col0;
                *(f32x4*)p = acc_f(acc[ai][0][m][0], i8) * r; *(f32x4*)(p + 4) = acc_f(acc[ai][0][m][1], i8) * r;
                EPI_FENCE();
            }
    }
};
struct EpiDsaIn {
    static constexpr bool PERM = true; static constexpr int SCALE_A = SC_ONE, SCALE_B = SC_W64;
    bf16* PROJ; const float* ssq; const float* XS; bool i8;
    DI void operator()(const f32x4 (&acc)[2][2][4][2], const pg8::Unit& u, int wr, int wc, int fr_in, int fq_in) const {
        int fr = fr_in, fq = fq_in; asm volatile("" : "+v"(fr), "+v"(fq));
        const int row0 = u.pm * 256 + wr * 64 + fr;
        const int col0 = u.pn * 256 + wc * 32 + 8 * fq;
        float rqa[8]; row_factors8<2>(ssq, XS, i8, row0, fq, rqa);
#pragma unroll
        for (int ai = 0; ai < 2; ++ai)
#pragma unroll
            for (int m = 0; m < 4; ++m) {
                const int row = row0 + ai * 128 + m * 16;
                const float r = rqa[ai * 4 + m];
#pragma unroll
                for (int bj = 0; bj < 2; ++bj) {
                    const f32x4 v0 = acc_f(acc[ai][bj][m][0], i8) * r, v1 = acc_f(acc[ai][bj][m][1], i8) * r;
                    float h[8] = {v0[0], v0[1], v0[2], v0[3], v1[0], v1[1], v1[2], v1[3]};
                    *(bf16x8*)(PROJ + (size_t)row * PROJ_LD + col0 + bj * 128) = pack8(h);
                }
                EPI_FENCE();
            }
    }
};

template <int T> struct EpiHgrnIn {
    static constexpr bool PERM = true; static constexpr int SCALE_A = SC_ONE, SCALE_B = SC_W64;
    bf16* O; float* F; const float* ssq; const float* lb; const float* XS; bool i8;
    DI void operator()(const f32x4 (&acc)[2][2][4][2], const pg8::Unit& u, int wr, int wc, int fr_in, int fq_in) const {
        int fr = fr_in, fq = fq_in; asm volatile("" : "+v"(fr), "+v"(fq));
        const int row0 = u.pm * 256 + wr * 64 + fr;
        const int col0 = u.pn * 256 + wc * 32 + 8 * fq;
        float rqa[8]; row_factors8<2>(ssq, XS, i8, row0, fq, rqa);
#pragma unroll
        for (int ai = 0; ai < 2; ++ai)
#pragma unroll
            for (int m = 0; m < 4; ++m) {
                const int row = row0 + ai * 128 + m * 16;
                const float r = rqa[ai * 4 + m];
#pragma unroll
                for (int bj = 0; bj < 2; ++bj) {
                    float v[8]; const f32x4 a0 = acc_f(acc[ai][bj][m][0], i8), a1 = acc_f(acc[ai][bj][m][1], i8);
#pragma unroll
                    for (int e = 0; e < 4; ++e) { v[e] = a0[e] * r; v[4 + e] = a1[e] * r; }
                    const int col = col0 + bj * 128;
                    if constexpr (T == 1) {
                        const f32x4 l0 = *(const f32x4*)(lb + col), l1 = *(const f32x4*)(lb + col + 4);
                        float kq[8];
#pragma unroll
                        for (int e = 0; e < 4; ++e) { kq[e] = (1.0f - l0[e]) * sigmoid_f(-v[e]); kq[4 + e] = (1.0f - l1[e]) * sigmoid_f(-v[4 + e]); }
                        u32x4 w; w.x = pkh2(kq[0], kq[1]); w.y = pkh2(kq[2], kq[3]); w.z = pkh2(kq[4], kq[5]); w.w = pkh2(kq[6], kq[7]);
                        *(u32x4*)((unsigned short*)F + (size_t)row * D_ + col) = w;
                    } else {
#pragma unroll
                        for (int e = 0; e < 8; ++e) v[e] = (T == 0) ? v[e] * 0.08838834764831845f : silu_f(v[e]);
                        *(bf16x8*)(O + (size_t)row * D_ + col) = pack8(v);
                    }
                }
                EPI_FENCE();
            }
    }
};

struct EpiHgrnVT {
    static constexpr bool PERM = true; static constexpr int SCALE_A = SC_W64, SCALE_B = SC_ONE;
    bf16* VT; const LAS float* tab; bool i8;
    DI void operator()(const f32x4 (&acc)[2][2][4][2], const pg8::Unit& u, int wr, int wc, int fr_in, int fq_in) const {
        int fr = fr_in, fq = fq_in; asm volatile("" : "+v"(fr), "+v"(fq));
        const int row0 = u.pm * 256 + wr * 64 + fr, cl = wc * 32 + 8 * fq;
#pragma unroll
        for (int bj = 0; bj < 2; ++bj) {
            const f32x4 r0 = *(const LAS f32x4*)(tab + cl + bj * 128), r1 = *(const LAS f32x4*)(tab + cl + bj * 128 + 4);
#pragma unroll
            for (int ai = 0; ai < 2; ++ai)
#pragma unroll
                for (int m = 0; m < 4; ++m) {
                    float h[8];
                    const f32x4 a0 = acc_f(acc[ai][bj][m][0], i8), a1 = acc_f(acc[ai][bj][m][1], i8);
#pragma unroll
                    for (int e = 0; e < 4; ++e) { h[e] = a0[e] * r0[e]; h[4 + e] = a1[e] * r1[e]; }
                    *(bf16x8*)(VT + (size_t)(row0 + ai * 128 + m * 16) * S_ + u.pn * 256 + cl + bj * 128) = pack8(h);
                }
        }
    }
};

DI float wave_sum(float v) {
#pragma unroll
    for (int o = 1; o < 64; o <<= 1) v += __shfl_xor(v, o);
    return v;
}
template <int MAP> DI int map_row(int n) {
    if (MAP == 1) return 256 * (n >> 7) + (n & 127);
    if (MAP == 2) return 256 * (n >> 7) + (n & 127) + 128;
    if (MAP == 3) return n < 4096 ? n : (n < 6144 ? n + 2048 : n - 2048);
    return n;
}
constexpr int P0_PITCH = 66;
template <int MAP, int F8> DI void cvt_tile(const float* __restrict__ W, int ldw, int ncols, const float* __restrict__ gain, unsigned char* __restrict__ WT, int K, int n0, int k0, int lane, LAS unsigned short* scr) {
    constexpr int KT = F8 ? 128 : 64;
    const int q = lane & 15, kr = lane >> 4;
    int nc = n0 + 4 * q; nc = nc < ncols - 4 ? nc : ncols - 4;
    const float* src = W + (size_t)(k0 + kr) * ldw + nc;
    const float gs = F8 == 1 ? 64.0f : (F8 == 2 ? WI8_SCALE : 1.0f);
#pragma unroll
    for (int h = 0; h < KT / 64; ++h) {
        f32x4 v[16];
#pragma unroll
        for (int i = 0; i < 16; ++i) v[i] = __builtin_nontemporal_load((const f32x4*)(src + (size_t)(64 * h + 4 * i) * ldw));
#pragma unroll
        for (int i = 0; i < 16; ++i) {
            const int k = 64 * h + 4 * i + kr;
            const float gk = gain ? gain[k0 + k] * gs : gs;
            LAS unsigned* d = (LAS unsigned*)(scr + k * P0_PITCH + 4 * q);
            d[0] = pk2(v[i][0] * gk, v[i][1] * gk); d[1] = pk2(v[i][2] * gk, v[i][3] * gk);
        }
    }
    LDS_WAIT();
    const int nl = lane >> 3, c = lane & 7;
#pragma unroll
    for (int jj = 0; jj < 8; ++jj) {
        const int n = 8 * jj + nl;
        const int row = map_row<MAP>(n0 + n);
        if constexpr (F8) {
            const LAS unsigned short* sp = scr + (16 * c) * P0_PITCH + n;
            float f[16];
#pragma unroll
            for (int i = 0; i < 16; ++i) f[i] = __uint_as_float((unsigned)sp[i * P0_PITCH] << 16);
            u32x4 o;
            if constexpr (F8 == 2) { o.x = pk4_i8(f[0], f[1], f[2], f[3]); o.y = pk4_i8(f[4], f[5], f[6], f[7]); o.z = pk4_i8(f[8], f[9], f[10], f[11]); o.w = pk4_i8(f[12], f[13], f[14], f[15]); }
            else { o.x = pk4_fp8s(f[0], f[1], f[2], f[3]); o.y = pk4_fp8s(f[4], f[5], f[6], f[7]); o.z = pk4_fp8s(f[8], f[9], f[10], f[11]); o.w = pk4_fp8s(f[12], f[13], f[14], f[15]); }
            *(u32x4*)(WT + tiled_off(row, k0 + 16 * c, K)) = o;
        } else {
            const LAS unsigned short* sp = scr + (8 * c) * P0_PITCH + n;
            unsigned e[8];
#pragma unroll
            for (int i = 0; i < 8; ++i) e[i] = sp[i * P0_PITCH];
            u32x4 o; o.x = e[0] | (e[1] << 16); o.y = e[2] | (e[3] << 16); o.z = e[4] | (e[5] << 16); o.w = e[6] | (e[7] << 16);
            *(u32x4*)(WT + tiled_off(row, (k0 + 8 * c) * 2, K * 2)) = o;
        }
    }
    LDS_WAIT();
}

struct Args {
    const float* in[15]; float* out; unsigned char* ws; int ph_lo, ph_hi;
};

constexpr int DEF8 = 1024, DEF16 = 2048;
DI void p0_deferred_down(const Args& a, LAS unsigned char* lds, int f, int widx, int nw, int lane, int wave) {
    LAS unsigned short* scr = (LAS unsigned short*)(lds + wave * 17408);
    const bool f8 = ((DN8_MASK >> f) & 1) != 0;
    const int cnt = f8 ? 1408 : 2816, def = f8 ? DEF8 : DEF16;
    const float* W = a.in[4] + (size_t)f * FF_ * D_; unsigned char* WT = a.ws + WS_WD + (size_t)f * SZ_WD;
    for (int r = cnt - def + widx; r < cnt; r += nw) {
        const int kb = r / 32, nb = r % 32;
        if (f8) cvt_tile<0, 1>(W, D_, D_, nullptr, WT, FF_, nb * 64, kb * 128, lane, scr);
        else cvt_tile<0, 0>(W, D_, D_, nullptr, WT, FF_, nb * 64, kb * 64, lane, scr);
    }
}
DI void p0_prologue(const Args& a, LAS unsigned char* lds, int gw, int NGW, int lane, int wave) {
    unsigned char* ws = a.ws;
    const float* ng = a.in[1];
    LAS unsigned short* scr = (LAS unsigned short*)(lds + wave * 17408);
    constexpr int NT_DIN = 66 * 32, NT_O = 32 * 32, NT_HIN = 128 * 32;
    int n_ffn = 0;
#pragma unroll
    for (int m = 0; m < 24; ++m) { const bool f8m = ((((m >> 3) < 2 ? (GU8_MASK | GUI8_MASK) : DN8_MASK) >> (m & 7)) & 1) != 0; n_ffn += (f8m ? 1408 : 2816) - ((m >> 3) == 2 ? (f8m ? DEF8 : DEF16) : 0); }
    const int NITEMS = n_ffn + 2 * (NT_DIN + NT_O + NT_HIN + NT_O);
    for (int it = gw; it < NITEMS; it += NGW) {
        int r = it;
        if (r < n_ffn) {
            int m = 0; bool f8 = false;
            for (; m < 24; ++m) { f8 = ((((m >> 3) < 2 ? (GU8_MASK | GUI8_MASK) : DN8_MASK) >> (m & 7)) & 1) != 0; const int cnt = (f8 ? 1408 : 2816) - ((m >> 3) == 2 ? (f8 ? DEF8 : DEF16) : 0); if (r < cnt) break; r -= cnt; }
            const int f = m & 7, kind = m >> 3;
            if (kind < 2) {
                const int kb = r / 88, nb = r % 88;
                const float* W = a.in[2 + kind] + (size_t)f * D_ * FF_;
                const float* gain = ng + (size_t)((f >> 1) * 3 + ((f & 1) ? 2 : 0)) * D_;
                unsigned char* WT = ws + WS_WGU + (size_t)f * SZ_WGU;
                if (f8 && ((GUI8_MASK >> f) & 1)) { if (kind == 0) cvt_tile<1, 2>(W, FF_, FF_, gain, WT, D_, nb * 64, kb * 128, lane, scr); else cvt_tile<2, 2>(W, FF_, FF_, gain, WT, D_, nb * 64, kb * 128, lane, scr); }
                else if (f8) { if (kind == 0) cvt_tile<1, 1>(W, FF_, FF_, gain, WT, D_, nb * 64, kb * 128, lane, scr); else cvt_tile<2, 1>(W, FF_, FF_, gain, WT, D_, nb * 64, kb * 128, lane, scr); }
                else { if (kind == 0) cvt_tile<1, 0>(W, FF_, FF_, gain, WT, D_, nb * 64, kb * 64, lane, scr); else cvt_tile<2, 0>(W, FF_, FF_, gain, WT, D_, nb * 64, kb * 64, lane, scr); }
            } else {
                const int kb = r / 32, nb = r % 32;
                const float* W = a.in[4] + (size_t)f * FF_ * D_; unsigned char* WT = ws + WS_WD + (size_t)f * SZ_WD;
                if (f8) cvt_tile<0, 1>(W, D_, D_, nullptr, WT, FF_, nb * 64, kb * 128, lane, scr);
                else cvt_tile<0, 0>(W, D_, D_, nullptr, WT, FF_, nb * 64, kb * 64, lane, scr);
            }
            continue;
        }
        r -= n_ffn;
        if (r < 2 * NT_DIN) { const int j = r / NT_DIN; r %= NT_DIN; const int kb = r / 66, nb = r % 66;
            if ((MIX8_MASK >> (2 * j)) & 1) { if ((kb & 1) == 0) cvt_tile<0, 2>(a.in[5] + (size_t)j * D_ * A_IN, A_IN, A_IN, ng + (size_t)((2 * j) * 3 + 1) * D_, ws + WS_DWIN + (size_t)j * SZ_DWIN, D_, nb * 64, kb * 64, lane, scr); }
            else cvt_tile<0, 0>(a.in[5] + (size_t)j * D_ * A_IN, A_IN, A_IN, ng + (size_t)((2 * j) * 3 + 1) * D_, ws + WS_DWIN + (size_t)j * SZ_DWIN, D_, nb * 64, kb * 64, lane, scr);
            continue; }
        r -= 2 * NT_DIN;
        if (r < 2 * NT_O) { const int j = r / NT_O; r %= NT_O; const int kb = r / 32, nb = r % 32;
            cvt_tile<0, 0>(a.in[6] + (size_t)j * D_ * D_, D_, D_, nullptr, ws + WS_DWO + (size_t)j * SZ_WO, D_, nb * 64, kb * 64, lane, scr); continue; }
        r -= 2 * NT_O;
        if (r < 2 * NT_HIN) { const int j = r / NT_HIN; r %= NT_HIN; const int kb = r / 128, nb = r % 128;
            if ((MIX8_MASK >> (2 * j + 1)) & 1) { if ((kb & 1) == 0) cvt_tile<3, 2>(a.in[11] + (size_t)j * D_ * 4 * D_, 4 * D_, 4 * D_, ng + (size_t)((2 * j + 1) * 3 + 1) * D_, ws + WS_HWIN + (size_t)j * SZ_HWIN, D_, nb * 64, kb * 64, lane, scr); }
            else cvt_tile<3, 0>(a.in[11] + (size_t)j * D_ * 4 * D_, 4 * D_, 4 * D_, ng + (size_t)((2 * j + 1) * 3 + 1) * D_, ws + WS_HWIN + (size_t)j * SZ_HWIN, D_, nb * 64, kb * 64, lane, scr);
            continue; }
        r -= 2 * NT_HIN;
        { const int j = r / NT_O; r %= NT_O; const int kb = r / 32, nb = r % 32;
            cvt_tile<0, 0>(a.in[12] + (size_t)j * D_ * D_, D_, D_, nullptr, ws + WS_HWO + (size_t)j * SZ_WO, D_, nb * 64, kb * 64, lane, scr); }
    }
    const float* x = a.in[0]; bf16* XB = (bf16*)(ws + WS_XB); float* ssq = (float*)(ws + WS_SSQ); float* XS = (float*)(ws + WS_XS);
    for (int m = gw; m < S_; m += NGW) {
        const f32x4* xr = (const f32x4*)(x + (size_t)m * D_) + lane; float s = 0.f;
        u32x2* o8 = (u32x2*)(XB + (size_t)m * D_) + lane; unsigned* o4 = (unsigned*)(ws + WS_X8 + (size_t)m * D_) + lane;
        f32x4 v[8];
#pragma unroll
        for (int j = 0; j < 8; ++j) { v[j] = xr[64 * j]; s += (v[j][0] * v[j][0] + v[j][1] * v[j][1]) + (v[j][2] * v[j][2] + v[j][3] * v[j][3]); }
        s = wave_sum(s);
        const float xs = __builtin_amdgcn_rsqf(s * (1.0f / D_) + EPS_) * (127.0f / XI8_CLIP);
#pragma unroll
        for (int j = 0; j < 8; ++j) {
            if (((GUI8_MASK | GU8_MASK) & 1) == 0) { u32x2 w; w.x = pk2(v[j][0], v[j][1]); w.y = pk2(v[j][2], v[j][3]); o8[64 * j] = w; }
            else o4[64 * j] = (GUI8_MASK & 1) ? pk4_i8(v[j][0] * xs, v[j][1] * xs, v[j][2] * xs, v[j][3] * xs) : pk4_fp8s(v[j][0], v[j][1], v[j][2], v[j][3]); }
        if (lane < 32) ssq[(size_t)m * 32 + lane] = (lane == 0) ? s : 0.f;
        if (lane == 0) XS[m] = xs;
    }
    const float* lg = a.in[13]; float* LB = (float*)(ws + WS_LB);
    for (int c = gw * 64 + lane; c < D_; c += NGW * 64) {
        const float l0 = lg[c], l1 = lg[D_ + c], l2 = lg[2 * D_ + c], l3 = lg[3 * D_ + c];
        const float mx = fmaxf(fmaxf(l0, l1), fmaxf(l2, l3));
        const float e0 = expf(l0 - mx), e1 = expf(l1 - mx), e2 = expf(l2 - mx), e3 = expf(l3 - mx), inv = 1.0f / (e0 + e1 + e2 + e3);
        LB[c] = e1 * inv; LB[D_ + c] = (e1 + e2 + e3) * inv;
    }
}

DI unsigned pk4_fp8(float a, float b, float c, float d) { int w = 0; w = __builtin_amdgcn_cvt_pk_fp8_f32(a, b, w, false); w = __builtin_amdgcn_cvt_pk_fp8_f32(c, d, w, true); return (unsigned)w; }
DI void dsa_prep(unsigned char* ws, const float* qg, const float* kg, const float* ikg, int gw, int NGW, int lane) {
    const bf16* PROJ = (const bf16*)(ws + WS_R + R_PROJ); const float* EX = (const float*)(ws + WS_R + R_EX);
    bf16* IKN = (bf16*)(ws + WS_R + R_IKN); float* IWS = (float*)(ws + WS_R + R_IWS);
    unsigned char* Q8 = ws + WS_R + R_Q8; unsigned char* K8 = ws + WS_R + R_K8; unsigned char* V8 = ws + WS_R + R_V8;
    for (int t = gw; t < S_; t += NGW) {
        const bf16* row = PROJ + (size_t)t * PROJ_LD;
        u32x4 wq_[4];
#pragma unroll
        for (int i = 0; i < 4; ++i) wq_[i] = *(const u32x4*)(row + lane * 32 + 8 * i);
        const u32x4 wk_ = *(const u32x4*)(row + 2048 + lane * 8), wv_ = *(const u32x4*)(row + 2560 + lane * 8);
        float exv_[8], exw_[8];
#pragma unroll
        for (int sl = 0; sl < 8; ++sl) { const float* ex = EX + ((size_t)sl * S_ + t) * EX_LD; exv_[sl] = ex[lane]; exw_[sl] = ex[64 + (lane & 15)]; }
        EPI_FENCE();
        {
            u32x4 w[4]; float v[32]; float s = 0.f;
#pragma unroll
            for (int i = 0; i < 4; ++i) { w[i] = wq_[i]; unpack8(w[i], v + 8 * i); }
#pragma unroll
            for (int i = 0; i < 32; ++i) s += v[i] * v[i];
            s += __shfl_xor(s, 1); s += __shfl_xor(s, 2);
            const float r = __builtin_amdgcn_rsqf(s * (1.0f / 128.0f) + EPS_);
            const int d0 = (lane & 3) * 32;
#pragma unroll
            for (int i = 0; i < 32; ++i) v[i] = v[i] * r * qg[d0 + i];
#pragma unroll
            for (int i = 0; i < 2; ++i) { u32x4 o; o.x = pk4_fp8(v[16 * i], v[16 * i + 1], v[16 * i + 2], v[16 * i + 3]); o.y = pk4_fp8(v[16 * i + 4], v[16 * i + 5], v[16 * i + 6], v[16 * i + 7]);
                o.z = pk4_fp8(v[16 * i + 8], v[16 * i + 9], v[16 * i + 10], v[16 * i + 11]); o.w = pk4_fp8(v[16 * i + 12], v[16 * i + 13], v[16 * i + 14], v[16 * i + 15]);
                *(u32x4*)(Q8 + (size_t)t * 2048 + lane * 32 + 16 * i) = o; }
        }
        {
            float v[8]; float s = 0.f; unpack8(wk_, v);
#pragma unroll
            for (int i = 0; i < 8; ++i) s += v[i] * v[i];
            s += __shfl_xor(s, 1); s += __shfl_xor(s, 2); s += __shfl_xor(s, 4); s += __shfl_xor(s, 8);
            const float r = __builtin_amdgcn_rsqf(s * (1.0f / 128.0f) + EPS_);
            const int d0 = (lane & 15) * 8;
#pragma unroll
            for (int i = 0; i < 8; ++i) v[i] = v[i] * r * kg[d0 + i];
            u32x2 o; o.x = pk4_fp8(v[0], v[1], v[2], v[3]); o.y = pk4_fp8(v[4], v[5], v[6], v[7]);
            *(u32x2*)(K8 + (size_t)t * 512 + lane * 8) = o;
        }
        {
            float v[8]; unpack8(wv_, v);
            u32x2 o; o.x = pk4_fp8(v[0], v[1], v[2], v[3]); o.y = pk4_fp8(v[4], v[5], v[6], v[7]);
            *(u32x2*)(V8 + (size_t)t * 512 + lane * 8) = o;
        }
        {
            float v = 0.f, wv = 0.f;
#pragma unroll
            for (int sl = 0; sl < 8; ++sl) { v += exv_[sl]; wv += exw_[sl]; }
            const float s = wave_sum(v * v);
            const float r = __builtin_amdgcn_rsqf(s * (1.0f / 64.0f) + EPS_);
            const float o = v * r * ikg[lane]; const float o2 = __shfl_xor(o, 1);
            if ((lane & 1) == 0) *(unsigned*)(IKN + (size_t)(t >> 5) * 2048 + (lane >> 4) * 512 + ((lane >> 3) & 1) * 256 + (t & 31) * 8 + (lane & 7)) = pk2(o, o2);
            if (lane < 16) IWS[(size_t)t * 16 + lane] = wv * 0.03125f;
        }
    }
}

DI unsigned okey(float f) { const unsigned u = __float_as_uint(f); return (u & 0x80000000u) ? ~u : (u | 0x80000000u); }

DI unsigned short okey16(float f) { const _Float16 h = (_Float16)f; const unsigned short u = __builtin_bit_cast(unsigned short, h); return (unsigned short)((u & 0x8000u) ? ~u : (u | 0x8000u)); }
constexpr int HCOPY = 2;
DI void digit_search(LAS unsigned* hist, unsigned need, int lane, unsigned& dig, unsigned& nn) {
    unsigned c[4]; unsigned s4 = 0u;
#pragma unroll
    for (int i = 0; i < 4; ++i) { c[i] = 0u;
#pragma unroll
        for (int k = 0; k < HCOPY; ++k) c[i] += hist[(255 - (4 * lane + i)) * HCOPY + k];
        s4 += c[i]; }
    unsigned incl = s4;
#pragma unroll
    for (int d = 1; d < 64; d <<= 1) { const unsigned x = __shfl_up(incl, d); if (lane >= d) incl += x; }
    const unsigned excl = incl - s4;
    const bool hit = excl < need && need <= incl;
    unsigned run = excl, dd = 0u, n2 = 0u; bool found = false;
#pragma unroll
    for (int i = 0; i < 4; ++i) { if (!found && run + c[i] >= need) { dd = 255u - (unsigned)(4 * lane + i); n2 = need - run; found = true; } run += c[i]; }
    const unsigned long long hb = __ballot(hit);
    const int src = hb ? (__ffsll((long long)hb) - 1) : 0;
    dig = (unsigned)__builtin_amdgcn_readlane((int)dd, src); nn = (unsigned)__builtin_amdgcn_readlane((int)n2, src);
}
DI float relu_i(float x) { const int xi = __builtin_bit_cast(int, x); return __builtin_bit_cast(float, xi > 0 ? xi : 0); }
DI void dsa_select(unsigned char* ws, LAS unsigned char* lds, int tid, int lane, int wave, int bid, int G, int score_only) {
    const bf16* PROJ = (const bf16*)(ws + WS_R + R_PROJ); const bf16* IKN = (const bf16*)(ws + WS_R + R_IKN); const float* IWS = (const float*)(ws + WS_R + R_IWS);
    int* SELG = (int*)(ws + WS_R + R_SEL);
    LAS unsigned short* SC = (LAS unsigned short*)lds;
    LAS unsigned* HIST = (LAS unsigned*)(lds + LDS_AUX);
    for (int wi = bid; wi < S_ / 8; wi += G) {
        const int rr = wi >> 8, ww = wi & 255, u = (rr << 8) + ((rr & 1) ? 255 - ww : ww);
        const int t0 = 8 * u;
        {
            const int rho = lane & 31, hf = lane >> 5, qq = (rho >> 2) & 1, hh = (rho & 3) + 4 * (rho >> 3);
            bf16x8 afr[4][4];
#pragma unroll
            for (int rt = 0; rt < 4; ++rt)
#pragma unroll
                for (int ks = 0; ks < 4; ++ks) afr[rt][ks] = *(const bf16x8*)(PROJ + (size_t)(t0 + 2 * rt + qq) * PROJ_LD + 3072 + hh * 64 + 16 * ks + 8 * hf);
            f32x4 wv[4][4];
#pragma unroll
            for (int rt = 0; rt < 4; ++rt)
#pragma unroll
                for (int i4 = 0; i4 < 4; ++i4) wv[rt][i4] = *(const f32x4*)(IWS + (size_t)(t0 + 2 * rt + hf) * 16 + 4 * i4);
            const int ntiles = (t0 + 8 + 31) >> 5;
            const bf16* ikb = IKN + lane * 8;
            bf16x8 b0[4], b1[4], b2[4];
#define SEL_LOADB(B, KT) do { int k_ = (KT); k_ = k_ < ntiles ? k_ : ntiles - 1; _Pragma("unroll") for (int ks = 0; ks < 4; ++ks) B[ks] = *(const bf16x8*)(ikb + (size_t)k_ * 2048 + ks * 512); } while (0)
#define SEL_FMA(S, W, R) asm("v_fma_f32 %0, %1, %2, %0" : "+v"(S) : "v"(W), "v"(R))
#define SEL_TILE(B, KT) do { const int key = 32 * (KT) + (lane & 31); float sc4[4]; \
                _Pragma("unroll") for (int rt = 0; rt < 4; ++rt) { f32x16 acc; \
                    _Pragma("unroll") for (int i = 0; i < 16; ++i) acc[i] = 0.f; \
                    _Pragma("unroll") for (int ks = 0; ks < 4; ++ks) acc = MFMA32(afr[rt][ks], B[ks], acc); \
                    float s0 = 0.f, s1 = 0.f; \
                    _Pragma("unroll") for (int i4 = 0; i4 < 4; ++i4) { \
                        SEL_FMA(s0, wv[rt][i4][0], relu_i(acc[4 * i4])); SEL_FMA(s1, wv[rt][i4][1], relu_i(acc[4 * i4 + 1])); \
                        SEL_FMA(s0, wv[rt][i4][2], relu_i(acc[4 * i4 + 2])); SEL_FMA(s1, wv[rt][i4][3], relu_i(acc[4 * i4 + 3])); } \
                    sc4[rt] = s0 + s1; } \
                _Pragma("unroll") for (int rt = 0; rt < 4; ++rt) SC[(2 * rt + hf) * 8192 + key] = okey16(sc4[rt]); } while (0)
            EPI_FENCE();
            SEL_LOADB(b0, wave); EPI_FENCE(); SEL_LOADB(b1, wave + 8); EPI_FENCE(); SEL_LOADB(b2, wave + 16); EPI_FENCE();
            int kt = wave;
            for (; kt + 16 < ntiles; kt += 24) {
                SEL_TILE(b0, kt); EPI_FENCE(); SEL_LOADB(b0, kt + 24); EPI_FENCE();
                SEL_TILE(b1, kt + 8); EPI_FENCE(); SEL_LOADB(b1, kt + 32); EPI_FENCE();
                SEL_TILE(b2, kt + 16); EPI_FENCE(); SEL_LOADB(b2, kt + 40); EPI_FENCE();
            }
            if (kt < ntiles) { SEL_TILE(b0, kt); EPI_FENCE(); if (kt + 8 < ntiles) { SEL_TILE(b1, kt + 8); } }
        }
        __syncthreads();
        if (!score_only) {
            const int t = t0 + wave, n = t + 1;
            LAS unsigned short* sc = SC + wave * 8192; LAS unsigned* hist = HIST + wave * 256 * HCOPY; LAS unsigned* histc = hist + (lane & (HCOPY - 1));
            const LAS unsigned* sc2 = (const LAS unsigned*)sc;
            int* selg = SELG + (size_t)t * TOPK;
            if (n <= TOPK) {
#pragma unroll
                for (int i = 0; i < 4; ++i) { const int p = lane + 64 * i; selg[p] = p < n ? p : 0; }
            } else {
                const int nw2 = (n + 1) >> 1;
#pragma unroll
                for (int i = 0; i < 4 * HCOPY; ++i) hist[lane + 64 * i] = 0u;
                for (int i0 = 0; i0 < nw2; i0 += 64) { const int i = i0 + lane; if (i < nw2) { const unsigned wd = sc2[i];
                        __hip_atomic_fetch_add(&histc[((wd >> 8) & 255u) * HCOPY], 1u, __ATOMIC_RELAXED, __HIP_MEMORY_SCOPE_WORKGROUP);
                        if (2 * i + 1 < n) __hip_atomic_fetch_add(&histc[(wd >> 24) * HCOPY], 1u, __ATOMIC_RELAXED, __HIP_MEMORY_SCOPE_WORKGROUP); } }
                LDS_WAIT();
                unsigned dA, need; digit_search(hist, TOPK, lane, dA, need);
#pragma unroll
                for (int i = 0; i < 4 * HCOPY; ++i) hist[lane + 64 * i] = 0u;
                for (int i0 = 0; i0 < nw2; i0 += 64) { const int i = i0 + lane; if (i < nw2) { const unsigned wd = sc2[i];
                        if (((wd >> 8) & 255u) == dA) __hip_atomic_fetch_add(&histc[(wd & 255u) * HCOPY], 1u, __ATOMIC_RELAXED, __HIP_MEMORY_SCOPE_WORKGROUP);
                        if (2 * i + 1 < n && (wd >> 24) == dA) __hip_atomic_fetch_add(&histc[((wd >> 16) & 255u) * HCOPY], 1u, __ATOMIC_RELAXED, __HIP_MEMORY_SCOPE_WORKGROUP); } }
                LDS_WAIT();
                unsigned dB, need_eq; digit_search(hist, need, lane, dB, need_eq);
                const unsigned T = (dA << 8) | dB;
                unsigned goff = 0u, eoff = 0u; const unsigned gtot = TOPK - need_eq;
                LAS int* rowb = (LAS int*)(lds + LDS_AUX + 8192 * HCOPY) + wave * 256;
                const unsigned long long ltm = (1ull << lane) - 1ull;
                for (int i0 = 0; i0 < nw2; i0 += 64) { const int i = i0 + lane; const bool v0 = i < nw2, v1 = v0 && (2 * i + 1 < n); const unsigned wd = v0 ? sc2[i] : 0u;
                    const unsigned k0 = wd & 0xffffu, k1 = wd >> 16;
                    const bool g0 = v0 && k0 > T, g1 = v1 && k1 > T, e0 = v0 && k0 == T, e1 = v1 && k1 == T;
                    const unsigned long long bg0 = __ballot(g0), bg1 = __ballot(g1), be0 = __ballot(e0), be1 = __ballot(e1);
                    const unsigned pg = goff + (unsigned)__popcll(bg0 & ltm) + (unsigned)__popcll(bg1 & ltm);
                    if (g0) rowb[pg] = 2 * i;
                    if (g1) rowb[pg + (g0 ? 1u : 0u)] = 2 * i + 1;
                    const unsigned pe = eoff + (unsigned)__popcll(be0 & ltm) + (unsigned)__popcll(be1 & ltm);
                    if (e0 && pe < need_eq) rowb[gtot + pe] = 2 * i;
                    if (e1 && pe + (e0 ? 1u : 0u) < need_eq) rowb[gtot + pe + (e0 ? 1u : 0u)] = 2 * i + 1;
                    goff += (unsigned)__popcll(bg0) + (unsigned)__popcll(bg1); eoff += (unsigned)__popcll(be0) + (unsigned)__popcll(be1); }
                LDS_WAIT();
                *(i32x4*)(selg + 4 * lane) = *(const LAS i32x4*)(rowb + 4 * lane);
            }
        }
        __syncthreads();
    }
}

DI bf16x8 tr_read2(unsigned a0, unsigned a1) {
    s16x4 lo, hi;
    asm volatile("ds_read_b64_tr_b16 %0, %2\n\tds_read_b64_tr_b16 %1, %3\n\ts_waitcnt lgkmcnt(0)" : "=&v"(lo), "=&v"(hi) : "v"(a0), "v"(a1) : "memory");
    return (bf16x8){lo[0], lo[1], lo[2], lo[3], hi[0], hi[1], hi[2], hi[3]};
}
DI void dsa_attend(unsigned char* ws, const float* relb, LAS unsigned char* lds, int tid, int lane, int wave, int jl) {
    const unsigned char* Q8 = ws + WS_R + R_Q8; const unsigned char* K8 = ws + WS_R + R_K8; const unsigned char* V8 = ws + WS_R + R_V8;
    const int* SELG = (const int*)(ws + WS_R + R_SEL);
    bf16* AO = (bf16*)(ws + WS_AO);
    unsigned* wq = (unsigned*)(ws + WS_CTL) + CW_WQ + 256 * jl;
    LAS int* SELL = (LAS int*)lds;
    LAS unsigned char* VBUF = lds + 8192;
    LAS float* BIAS = (LAS float*)(lds + 8192 + 131072);
    for (int i = tid; i < 129 * 16; i += NTHREADS) { const int d = i >> 4; int b = d; if (d >= 16) { b = 16 + (int)(logf((float)d * (1.0f / 16.0f)) / 2.0794415416798357f * 16.0f); b = b < 31 ? b : 31; }
        BIAS[i] = relb[b * 16 + (i & 15)]; }
    __syncthreads();
    LAS int* sel = SELL + wave * 256; LAS unsigned char* vbuf = VBUF + wave * 16384;
    const int g = lane & 15, kg = lane >> 4;
    LAS int* selg = sel + g; LAS int* selk = sel + 4 * kg;
    const int vrow = lane >> 3;
    LAS int* selv = sel + vrow;
    const int tq = (lane & 15) >> 2, tp = lane & 3;
    const int j0 = (int)(xb_xcc_id() >> 1) & 3;
    for (int dj = 0; dj < 4; ++dj) {
        const int j = (j0 + dj) & 3;
        const int hcol = 4 * j + (g & 3);
        const unsigned char* Vb = V8 + j * 128;
        for (;;) {
            unsigned it = 0u;
            if (lane == 0) it = __hip_atomic_fetch_add(wq + 64 * j, 1u, __ATOMIC_RELAXED, __HIP_MEMORY_SCOPE_AGENT);
            it = (unsigned)__builtin_amdgcn_readfirstlane((int)it);
            if (it >= (unsigned)S_) break;
            const int t = (int)it, cnt = (t + 1) < TOPK ? (t + 1) : TOPK;
            *(LAS i32x4*)(sel + 4 * lane) = *(const i32x4*)(SELG + (size_t)t * TOPK + 4 * lane);
            u32x4 qf[2];
#pragma unroll
            for (int p = 0; p < 2; ++p) qf[p] = *(const u32x4*)(Q8 + (size_t)t * 2048 + hcol * 128 + 64 * p + 16 * kg);
            LDS_WAIT();
#define ATT_VIDX(S, c) do { _Pragma("unroll") for (int m_ = 0; m_ < 8; ++m_) S[m_] = selv[64 * (c) + 8 * m_] & 8191; } while (0)
#define ATT_VDMA(S, bufi) do { _Pragma("unroll") for (int m_ = 0; m_ < 8; ++m_) { const int row_ = 8 * m_ + vrow; \
                const int ch_ = (lane & 7) ^ (((row_ >> 1) & 3) << 1); \
                __builtin_amdgcn_global_load_lds((const unsigned*)(Vb + (size_t)S[m_] * 512 + 16 * ch_), (LAS unsigned*)(vbuf + (bufi) * 8192 + m_ * 1024), 16, 0, 0); } } while (0)
            int vs0[8], vs1[8], ksel[16];
            ATT_VIDX(vs0, 0); ATT_VIDX(vs1, 1);
#pragma unroll
            for (int i = 0; i < 16; ++i) ksel[i] = selg[16 * i] & 8191;
            ATT_VDMA(vs0, 0); ATT_VDMA(vs1, 1);
            __builtin_amdgcn_s_waitcnt(0xC07F);
            __builtin_amdgcn_sched_barrier(0);
            f32x4 lg[16];
            const unsigned char* Kb = K8 + j * 128 + 16 * kg;
            u32x4 kb[8][2];
#pragma unroll
            for (int i = 0; i < 8; ++i) { const unsigned char* kp = Kb + (size_t)ksel[i] * 512;
#pragma unroll
                for (int p = 0; p < 2; ++p) kb[i][p] = *(const u32x4*)(kp + 64 * p); }
            __builtin_amdgcn_sched_barrier(0);
#pragma unroll
            for (int kt = 0; kt < 16; ++kt) {
                f32x4 a4 = {0.f, 0.f, 0.f, 0.f};
#pragma unroll
                for (int p = 0; p < 2; ++p) {
                    const u32x4 kk = kb[kt & 7][p];
                    const long a0 = (long)(((unsigned long long)kk.y << 32) | kk.x), a1 = (long)(((unsigned long long)kk.w << 32) | kk.z);
                    const long b0 = (long)(((unsigned long long)qf[p].y << 32) | qf[p].x), b1 = (long)(((unsigned long long)qf[p].w << 32) | qf[p].z);
                    a4 = __builtin_amdgcn_mfma_f32_16x16x32_fp8_fp8(a0, b0, a4, 0, 0, 0);
                    a4 = __builtin_amdgcn_mfma_f32_16x16x32_fp8_fp8(a1, b1, a4, 0, 0, 0);
                }
                lg[kt] = a4;
                if (kt + 8 < 16) { const unsigned char* kp = Kb + (size_t)ksel[kt + 8] * 512;
#pragma unroll
                    for (int p = 0; p < 2; ++p) kb[kt & 7][p] = *(const u32x4*)(kp + 64 * p); }
                __builtin_amdgcn_sched_barrier(0);
            }
            const int cq = g >> 2;
            float mx = -INFINITY;
            const int cntk = cnt - 4 * kg;
            float pw[4][4];
#pragma unroll
            for (int i = 0; i < 4; ++i) {
                f32x4 lgi = (cq == 0) ? lg[i] : (cq == 1) ? lg[4 + i] : (cq == 2) ? lg[8 + i] : lg[12 + i];
                const int kt = 4 * cq + i;
                const i32x4 s4 = *(const LAS i32x4*)(selk + 16 * kt);
#pragma unroll
                for (int r = 0; r < 4; ++r) {
                    int dist = t - s4[r]; dist = dist < 0 ? 0 : (dist > 128 ? 128 : dist);
                    float v = lgi[r] * 0.08838834764831845f + BIAS[dist * 16 + hcol];
                    v = (16 * kt + r < cntk) ? v : -INFINITY;
                    pw[i][r] = v; mx = fmaxf(mx, v);
                }
            }
            mx = fmaxf(mx, __shfl_xor(mx, 4)); mx = fmaxf(mx, __shfl_xor(mx, 8)); mx = fmaxf(mx, __shfl_xor(mx, 16)); mx = fmaxf(mx, __shfl_xor(mx, 32));
            float sum = 0.f;
#pragma unroll
            for (int i = 0; i < 4; ++i)
#pragma unroll
                for (int r = 0; r < 4; ++r) { const float e = __expf(pw[i][r] - mx); pw[i][r] = e; sum += e; }
            sum += __shfl_xor(sum, 4); sum += __shfl_xor(sum, 8); sum += __shfl_xor(sum, 16); sum += __shfl_xor(sum, 32);
            const float inv = __builtin_amdgcn_rcpf(sum) * 128.0f;
            const unsigned pA0 = pk4_fp8(pw[0][0] * inv, pw[0][1] * inv, pw[0][2] * inv, pw[0][3] * inv), pB0 = pk4_fp8(pw[1][0] * inv, pw[1][1] * inv, pw[1][2] * inv, pw[1][3] * inv);
            const unsigned pA1 = pk4_fp8(pw[2][0] * inv, pw[2][1] * inv, pw[2][2] * inv, pw[2][3] * inv), pB1 = pk4_fp8(pw[3][0] * inv, pw[3][1] * inv, pw[3][2] * inv, pw[3][3] * inv);
            f32x4 o[8];
#pragma unroll
            for (int dt = 0; dt < 8; ++dt) o[dt] = (f32x4){0.f, 0.f, 0.f, 0.f};
#pragma unroll
            for (int c = 0; c < 4; ++c) {
                if (c < 3) asm volatile("s_waitcnt vmcnt(8)" ::: "memory"); else asm volatile("s_waitcnt vmcnt(0)" ::: "memory");
                const unsigned base = (unsigned)(size_t)(vbuf + (c & 1) * 8192);
#pragma unroll
                for (int s2 = 0; s2 < 2; ++s2) {
                    const int ks = 2 * c + s2;
                    const int rA = 32 * s2 + 4 * kg + tq, rB = rA + 16;
                    const bool mine = (ks >> 1) == cq;
                    const unsigned pa = mine ? ((ks & 1) ? pA1 : pA0) : 0u, pb = mine ? ((ks & 1) ? pB1 : pB0) : 0u;
                    const long pf = (long)(((unsigned long long)pb << 32) | pa);
                    u32x2 vl[4], vh[4];
#pragma unroll
                    for (int mp = 0; mp < 4; ++mp) {
                        const unsigned a0 = base + 128u * rA + 16u * ((2 * mp + (tp >> 1)) ^ (((rA >> 1) & 3) << 1)) + 8u * (tp & 1);
                        const unsigned a1 = base + 128u * rB + 16u * ((2 * mp + (tp >> 1)) ^ (((rB >> 1) & 3) << 1)) + 8u * (tp & 1);
                        asm volatile("ds_read_b64_tr_b16 %0, %2\n\tds_read_b64_tr_b16 %1, %3" : "=&v"(vl[mp]), "=&v"(vh[mp]) : "v"(a0), "v"(a1) : "memory");
                    }
                    asm volatile("s_waitcnt lgkmcnt(0)" : "+v"(vl[0]), "+v"(vl[1]), "+v"(vl[2]), "+v"(vl[3]), "+v"(vh[0]), "+v"(vh[1]), "+v"(vh[2]), "+v"(vh[3]) :: "memory");
#pragma unroll
                    for (int mp = 0; mp < 4; ++mp) {
                        const unsigned e0 = __builtin_amdgcn_perm(vl[mp].y, vl[mp].x, 0x06040200u), e1 = __builtin_amdgcn_perm(vh[mp].y, vh[mp].x, 0x06040200u);
                        const unsigned o0 = __builtin_amdgcn_perm(vl[mp].y, vl[mp].x, 0x07050301u), o1 = __builtin_amdgcn_perm(vh[mp].y, vh[mp].x, 0x07050301u);
                        const long fe = (long)(((unsigned long long)e1 << 32) | e0), fo = (long)(((unsigned long long)o1 << 32) | o0);
                        o[2 * mp] = __builtin_amdgcn_mfma_f32_16x16x32_fp8_fp8(fe, pf, o[2 * mp], 0, 0, 0);
                        o[2 * mp + 1] = __builtin_amdgcn_mfma_f32_16x16x32_fp8_fp8(fo, pf, o[2 * mp + 1], 0, 0, 0);
                    }
                }
                if (c + 2 < 4) { int vsn[8]; ATT_VIDX(vsn, c + 2); ATT_VDMA(vsn, c & 1); }
            }
#undef ATT_VDMA
#undef ATT_VIDX
#pragma unroll
            for (int dt = 0; dt < 8; ++dt)
#pragma unroll
                for (int r = 0; r < 4; ++r) { float x = o[dt][r];
                    x += __builtin_bit_cast(float, __builtin_amdgcn_update_dpp(0, __builtin_bit_cast(int, x), 0x128, 0xf, 0xf, false));
                    x += __builtin_bit_cast(float, __builtin_amdgcn_update_dpp(0, __builtin_bit_cast(int, x), 0x124, 0xf, 0xf, false)); o[dt][r] = x; }
            if (g < 4) {
#pragma unroll
                for (int mp = 0; mp < 4; ++mp) { const f32x4 ev = o[2 * mp] * (1.0f / 128.0f), ov = o[2 * mp + 1] * (1.0f / 128.0f);
                    const float h8[8] = {ev[0], ov[0], ev[1], ov[1], ev[2], ov[2], ev[3], ov[3]};
                    *(bf16x8*)(AO + (size_t)t * D_ + (4 * j + g) * 128 + 32 * mp + 8 * kg) = pack8(h8); }
            }
            LDS_WAIT();
        }
    }
}

DI void hgrn_a(unsigned char* ws, int lane, int wave, int bid, int G) {
    const float* F = (const float*)(ws + WS_R + R_F); const bf16* VT = (const bf16*)(ws + WS_R + R_VT);
    float* BC = (float*)(ws + WS_R + R_BC); unsigned char* STB = ws + WS_R + R_ST; float* EBL = (float*)(ws + WS_R + R_EBL);
    const int u2 = wave >> 2, dt = wave & 3, dl = lane & 31, hf = lane >> 5;
    for (int U = bid * 2 + u2; U < 2048; U += 2 * G) {
        const int c = U >> 4, h = U & 15, d = h * 128 + dt * 32 + dl;
        float b[4][8], kd[4][8], tot[4];
#pragma unroll
        for (int i = 0; i < 4; ++i) {
            float run = 0.f;
#pragma unroll
            for (int jj = 0; jj < 8; ++jj) { const float f = F[(size_t)(c * 64 + 8 * (2 * i + hf) + jj) * D_ + d]; kd[i][jj] = 1.0f - f; run += logf(f); b[i][jj] = run; }
            tot[i] = run;
        }
        float pre = 0.f;
#pragma unroll
        for (int i = 0; i < 4; ++i) {
            const float pt = __shfl_xor(tot[i], 32);
            const float mypre = pre + (hf ? pt : 0.f);
#pragma unroll
            for (int jj = 0; jj < 8; ++jj) b[i][jj] += mypre;
            pre += tot[i] + pt;
        }
        const float blast = pre;
#pragma unroll
        for (int i = 0; i < 4; ++i)
#pragma unroll
            for (int jj = 0; jj < 8; ++jj) { BC[(size_t)(c * 64 + 8 * (2 * i + hf) + jj) * D_ + d] = b[i][jj]; kd[i][jj] *= __expf(blast - b[i][jj]); }
        if (hf == 0) EBL[(size_t)U * 128 + dt * 32 + dl] = __expf(blast);
        f32x16 acc[4];
#pragma unroll
        for (int et = 0; et < 4; ++et)
#pragma unroll
            for (int i = 0; i < 16; ++i) acc[et][i] = 0.f;
#pragma unroll
        for (int ks = 0; ks < 4; ++ks) {
            const bf16x8 bfr = pack8(kd[ks]);
#pragma unroll
            for (int et = 0; et < 4; ++et) {
                const bf16x8 afr = *(const bf16x8*)(VT + (size_t)(h * 128 + et * 32 + dl) * S_ + c * 64 + 16 * ks + 8 * hf);
                acc[et] = MFMA32(bfr, afr, acc[et]);
            }
        }
#pragma unroll
        for (int et = 0; et < 4; ++et)
#pragma unroll
            for (int s2 = 0; s2 < 2; ++s2) {
                float v[8];
#pragma unroll
                for (int i = 0; i < 8; ++i) v[i] = acc[et][8 * s2 + i];
                *(bf16x8*)(STB + (((size_t)U * 4 + et) * 8 + 2 * dt + s2) * 1024 + lane * 16) = pack8(v);
            }
    }
}
DI void hgrn_b(unsigned char* ws, int gtid, int nthreads, int dummy) {
    unsigned char* STB = ws + WS_R + R_ST; const float* EBL = (const float*)(ws + WS_R + R_EBL);
    for (int p = gtid; p < 131072; p += nthreads) {
        const int h = p >> 13, rem = p & 8191, ks = (rem >> 8) & 7, ln = (rem >> 2) & 63, wsel = rem & 3;
        const int d0 = 16 * ks + 8 * (wsel >> 1) + 4 * (ln >> 5) + 2 * (wsel & 1);
        float r0 = 0.f, r1 = 0.f;
#pragma unroll 8
        for (int c = 0; c < 128; ++c) {
            unsigned* ptr = (unsigned*)(STB + (size_t)(c * 16 + h) * 32768 + (size_t)rem * 4);
            const unsigned loc = *ptr; const f32x2 eb = *(const f32x2*)(EBL + (size_t)(c * 16 + h) * 128 + d0);
            *ptr = dummy ? loc : pk2(r0, r1);
            r0 = r0 * eb[0] + bf_lo(loc); r1 = r1 * eb[1] + bf_hi(loc);
        }
    }
}
DI void hgrn_c(unsigned char* ws, const float* ogain, int lane, int wave, int bid, int NG) {
    const bf16* Q = (const bf16*)(ws + WS_R + R_Q); const float* F = (const float*)(ws + WS_R + R_F); const bf16* G = (const bf16*)(ws + WS_R + R_G);
    const bf16* VT = (const bf16*)(ws + WS_R + R_VT); const float* BC = (const float*)(ws + WS_R + R_BC); const unsigned char* STB = ws + WS_R + R_ST;
    bf16* AO = (bf16*)(ws + WS_AO);
    const int u4 = wave >> 1, tt = wave & 1, tl = lane & 31, hf = lane >> 5;
    for (int U = bid * 4 + u4; U < 2048; U += 4 * NG) {
        const int c = U >> 4, h = U & 15, t = c * 64 + tt * 32 + tl;
        const size_t cb = (size_t)h * 128 + 4 * hf;
        bf16x8 qt[8];
        const bf16* qrow = Q + (size_t)t * D_ + cb; const float* brow = BC + (size_t)t * D_ + cb; const float* b31 = BC + (size_t)(c * 64 + 31) * D_ + cb;
#pragma unroll
        for (int ks = 0; ks < 8; ++ks) {
            const u32x2 qa = *(const u32x2*)(qrow + 16 * ks), qb2 = *(const u32x2*)(qrow + 16 * ks + 8);
            const float q[8] = {bf_lo(qa.x), bf_hi(qa.x), bf_lo(qa.y), bf_hi(qa.y), bf_lo(qb2.x), bf_hi(qb2.x), bf_lo(qb2.y), bf_hi(qb2.y)};
            const f32x4 b0 = *(const f32x4*)(brow + 16 * ks), b1 = *(const f32x4*)(brow + 16 * ks + 8);
            float v[8];
#pragma unroll
            for (int e = 0; e < 4; ++e) { v[e] = q[e] * __expf(b0[e]); v[4 + e] = q[4 + e] * __expf(b1[e]); }
            qt[ks] = pack8(v);
        }
        f32x16 acc[4];
#pragma unroll
        for (int et = 0; et < 4; ++et)
#pragma unroll
            for (int i = 0; i < 16; ++i) acc[et][i] = 0.f;
#pragma unroll
        for (int ks = 0; ks < 8; ++ks) {
#pragma unroll
            for (int et = 0; et < 4; ++et) {
                const bf16x8 sf = *(const bf16x8*)(STB + (((size_t)U * 4 + et) * 8 + ks) * 1024 + lane * 16);
                acc[et] = MFMA32(sf, qt[ks], acc[et]);
            }
            if ((ks & 3) == 3) asm volatile("" ::: "memory");
        }
        for (int st = 0; st <= tt; ++st) {
            const int sa = c * 64 + st * 32 + tl;
            const float* frow = F + (size_t)sa * D_ + cb; const float* srow = BC + (size_t)sa * D_ + cb;
            f32x16 X;
#pragma unroll
            for (int i = 0; i < 16; ++i) X[i] = 0.f;
#pragma unroll
            for (int ks = 0; ks < 8; ++ks) {
                const f32x4 f0 = *(const f32x4*)(frow + 16 * ks), f1 = *(const f32x4*)(frow + 16 * ks + 8);
                const f32x4 b0 = *(const f32x4*)(srow + 16 * ks), b1 = *(const f32x4*)(srow + 16 * ks + 8);
                f32x4 c0 = {0.f, 0.f, 0.f, 0.f}, c1 = {0.f, 0.f, 0.f, 0.f};
                bf16x8 qb = qt[ks];
                if (st == 1) {
                    c0 = *(const f32x4*)(b31 + 16 * ks); c1 = *(const f32x4*)(b31 + 16 * ks + 8);
                    const u32x2 qa = *(const u32x2*)(qrow + 16 * ks), qb2 = *(const u32x2*)(qrow + 16 * ks + 8);
                    const float q[8] = {bf_lo(qa.x), bf_hi(qa.x), bf_lo(qa.y), bf_hi(qa.y), bf_lo(qb2.x), bf_hi(qb2.x), bf_lo(qb2.y), bf_hi(qb2.y)};
                    const f32x4 t0 = *(const f32x4*)(brow + 16 * ks), t1 = *(const f32x4*)(brow + 16 * ks + 8);
                    float w[8];
#pragma unroll
                    for (int e = 0; e < 4; ++e) { w[e] = q[e] * __expf(t0[e] - c0[e]); w[4 + e] = q[4 + e] * __expf(t1[e] - c1[e]); }
                    qb = pack8(w);
                }
                float v[8];
#pragma unroll
                for (int e = 0; e < 4; ++e) { v[e] = (1.0f - f0[e]) * __expf(c0[e] - b0[e]); v[4 + e] = (1.0f - f1[e]) * __expf(c1[e] - b1[e]); }
                X = MFMA32(pack8(v), qb, X);
                if (ks & 1) asm volatile("" ::: "memory");
            }
            if (st == tt) {
#pragma unroll
                for (int r = 0; r < 16; ++r) { const int sl = (r & 3) + 8 * (r >> 2) + 4 * hf; X[r] = (sl <= tl) ? X[r] : 0.f; }
            }
#pragma unroll
            for (int kp = 0; kp < 2; ++kp) {
                float xv[8];
#pragma unroll
                for (int i = 0; i < 8; ++i) xv[i] = X[8 * kp + i];
                const bf16x8 xb = pack8(xv);
#pragma unroll
                for (int et = 0; et < 4; ++et) {
                    const bf16* vp = VT + (size_t)(h * 128 + et * 32 + tl) * S_ + c * 64 + st * 32 + 16 * kp + 4 * hf;
                    const s16x4 lo = *(const s16x4*)vp, hi = *(const s16x4*)(vp + 8);
                    const bf16x8 vf = {lo[0], lo[1], lo[2], lo[3], hi[0], hi[1], hi[2], hi[3]};
                    acc[et] = MFMA32(vf, xb, acc[et]);
                }
            }
        }
        float ss = 0.f;
#pragma unroll
        for (int et = 0; et < 4; ++et)
#pragma unroll
            for (int i = 0; i < 16; ++i) ss += acc[et][i] * acc[et][i];
        ss += __shfl_xor(ss, 32);
        const float rstd = __builtin_amdgcn_rsqf(ss * (1.0f / 128.0f) + EPS_);
#pragma unroll
        for (int et = 0; et < 4; ++et)
#pragma unroll
            for (int rq = 0; rq < 4; ++rq) {
                const int e0 = h * 128 + et * 32 + 8 * rq + 4 * hf;
                const f32x4 og = *(const f32x4*)(ogain + e0);
                const u32x2 gw = *(const u32x2*)(G + (size_t)t * D_ + e0);
                const float g0 = bf_lo(gw.x), g1 = bf_hi(gw.x), g2 = bf_lo(gw.y), g3 = bf_hi(gw.y);
                u32x2 w;
                w.x = pk2(acc[et][4 * rq] * rstd * og[0] * g0, acc[et][4 * rq + 1] * rstd * og[1] * g1);
                w.y = pk2(acc[et][4 * rq + 2] * rstd * og[2] * g2, acc[et][4 * rq + 3] * rstd * og[3] * g3);
                *(u32x2*)(AO + (size_t)t * D_ + e0) = w;
            }
    }
}

DI void hgrn_a2(unsigned char* ws, LAS unsigned char* lds, int tid, int lane, int wave, int bid, int NG) {
    const unsigned short* K1 = (const unsigned short*)(ws + WS_R + R_F); const bf16* VT = (const bf16*)(ws + WS_R + R_VT);
    unsigned short* BC = (unsigned short*)(ws + WS_R + R_BC); unsigned char* STB = ws + WS_R + R_ST; float* EBL = (float*)(ws + WS_R + R_EBL);
    constexpr int BLK = 1040;
    LAS unsigned char* Ft = lds;
    LAS float* QT = (LAS float*)(lds + 32 * BLK);
    LAS unsigned char* KDT = lds + 32 * BLK + 2048;
    LAS unsigned char* BCT = lds + 65536;
    const int d = tid & 127, tq = tid >> 7;
    const int dt = wave & 3, ep = wave >> 2, dl = lane & 31, hf = lane >> 5;
#define A2_STAGE(U_) do { const int c_ = (U_) >> 4, h_ = (U_) & 15; \
        _Pragma("unroll") for (int i_ = 0; i_ < 2; ++i_) { const int m_ = wave * 2 + i_; \
            __builtin_amdgcn_global_load_lds((const unsigned*)(K1 + (size_t)(c_ * 64 + 4 * m_ + (lane >> 4)) * D_ + h_ * 128 + (lane & 15) * 8), (LAS unsigned*)(Ft + m_ * BLK), 16, 0, 0); } } while (0)
    int U = bid;
    if (U < 2048) A2_STAGE(U);
    for (; U < 2048; U += NG) {
        const int c = U >> 4, h = U & 15;
        bf16x8 vf[2][4];
#pragma unroll
        for (int e2 = 0; e2 < 2; ++e2)
#pragma unroll
            for (int ks = 0; ks < 4; ++ks) vf[e2][ks] = *(const bf16x8*)(VT + (size_t)(h * 128 + (2 * ep + e2) * 32 + dl) * S_ + c * 64 + 16 * ks + 8 * hf);
        asm volatile("s_waitcnt vmcnt(0)" ::: "memory");
        __syncthreads();
        float f[16], b[16];
        float run = 0.f;
#pragma unroll
        for (int i = 0; i < 16; ++i) { const int r = 16 * tq + i; f[i] = (float)*(const LAS _Float16*)(Ft + (r >> 2) * BLK + (r & 3) * 256 + d * 2); run += __logf(1.0f - f[i]); b[i] = run; }
        QT[tq * 128 + d] = run;
        LDS_WAIT();
        __syncthreads();
        if (U + NG < 2048) A2_STAGE(U + NG);
        const float q0 = QT[d], q1 = QT[128 + d], q2 = QT[256 + d], q3 = QT[384 + d];
        const float pre = (tq > 0 ? q0 : 0.f) + (tq > 1 ? q1 : 0.f) + (tq > 2 ? q2 : 0.f);
        const float blast = (q0 + q1) + (q2 + q3);
        float kd[16];
#pragma unroll
        for (int i = 0; i < 16; ++i) { b[i] += pre; *(LAS unsigned short*)(BCT + (16 * tq + i) * 272 + d * 2) = __builtin_bit_cast(unsigned short, (_Float16)b[i]); kd[i] = f[i] * __expf(blast - b[i]); }
        if (tq == 0) EBL[(size_t)U * 128 + d] = __expf(blast);
        *(LAS bf16x8*)(KDT + d * 144 + 32 * tq) = pack8(kd); *(LAS bf16x8*)(KDT + d * 144 + 32 * tq + 16) = pack8(kd + 8);
        LDS_WAIT();
        __syncthreads();
#pragma unroll
        for (int i = 0; i < 2; ++i) { const int q = tid + NTHREADS * i, r = q >> 4, cc = q & 15;
            *(u32x4*)(BC + (size_t)(c * 64 + r) * D_ + h * 128 + cc * 8) = *(const LAS u32x4*)(BCT + r * 272 + cc * 16); }
        f32x16 acc[2];
#pragma unroll
        for (int e2 = 0; e2 < 2; ++e2)
#pragma unroll
            for (int i = 0; i < 16; ++i) acc[e2][i] = 0.f;
#pragma unroll
        for (int ks = 0; ks < 4; ++ks) {
            const bf16x8 af = *(const LAS bf16x8*)(KDT + (dt * 32 + dl) * 144 + 32 * ks + 16 * hf);
#pragma unroll
            for (int e2 = 0; e2 < 2; ++e2) acc[e2] = MFMA32(af, vf[e2][ks], acc[e2]);
        }
#pragma unroll
        for (int e2 = 0; e2 < 2; ++e2)
#pragma unroll
            for (int s2 = 0; s2 < 2; ++s2) {
                float v[8];
#pragma unroll
                for (int i = 0; i < 8; ++i) v[i] = acc[e2][8 * s2 + i];
                *(bf16x8*)(STB + (((size_t)U * 4 + 2 * ep + e2) * 8 + 2 * dt + s2) * 1024 + lane * 16) = pack8(v);
            }
    }
#undef A2_STAGE
}

DI void hgrn_c2(unsigned char* ws, const float* ogain, LAS unsigned char* lds, int tid, int lane, int wave, int bid, int NG) {
    const bf16* Q = (const bf16*)(ws + WS_R + R_Q); const unsigned short* K1 = (const unsigned short*)(ws + WS_R + R_F); const bf16* G = (const bf16*)(ws + WS_R + R_G);
    const bf16* VT = (const bf16*)(ws + WS_R + R_VT); const unsigned short* BC = (const unsigned short*)(ws + WS_R + R_BC); const unsigned char* STB = ws + WS_R + R_ST;
    bf16* AO = (bf16*)(ws + WS_AO);
    constexpr int BLK = 1040;
    constexpr int SETB = 48 * BLK;
    LAS float* SSt = (LAS float*)(lds + 2 * SETB);
    LAS unsigned char* XFt = lds + 2 * SETB + 1024;
    const int et = wave & 3, tt = wave >> 2, tl = lane & 31, hf = lane >> 5;
    const int rt = tt * 32 + tl;
#define C2_DMA(G_, L_) do { const unsigned la_ = (unsigned)(size_t)(L_); asm volatile("s_mov_b32 m0, %1\n\ts_nop 0\n\tglobal_load_lds_dwordx4 %0, off" :: "v"(G_), "s"(la_) : "memory", "m0"); } while (0)
#define C2_STAGE(U_, S_) do { const int c_ = (U_) >> 4, h_ = (U_) & 15; LAS unsigned char* sb_ = lds + (S_) * SETB; \
        _Pragma("unroll") for (int i_ = 0; i_ < 2; ++i_) { const int m_ = wave * 2 + i_; const size_t ro_ = (size_t)(c_ * 64 + 4 * m_ + (lane >> 4)) * D_ + h_ * 128 + (lane & 15) * 8; \
            C2_DMA(BC + ro_, sb_ + m_ * BLK); C2_DMA(K1 + ro_, sb_ + (16 + m_) * BLK); C2_DMA(Q + ro_, sb_ + (32 + m_) * BLK); } } while (0)
#define C2_ROW4(T, r) ((T) + ((r) >> 2) * BLK + ((r) & 3) * 256)
#define C2_ROWQ(r) C2_ROW4(Qt, r)
#define C2_H4(p_) ({ const u32x2 w_ = *(const LAS u32x2*)(p_); (f32x4){h_lo(w_.x), h_hi(w_.x), h_lo(w_.y), h_hi(w_.y)}; })
    int U = bid;
    if (U < 2048) C2_STAGE(U, 0);
    asm volatile("s_waitcnt vmcnt(0)" ::: "memory");
    for (int iter = 0; U < 2048; U += NG, ++iter) {
        const int par = iter & 1;
        const int c = U >> 4, h = U & 15, t = c * 64 + rt;
        LAS unsigned char* BCt = lds + par * SETB; LAS unsigned char* Ft = BCt + 16 * BLK; LAS unsigned char* Qt = BCt + 32 * BLK;
        asm volatile("s_waitcnt vmcnt(4)" ::: "memory");
        __syncthreads();
        bf16x8 sfr[8]; s16x4 vlo[2][2], vhi[2][2]; u32x2 gwr[4]; f32x4 ogr[4];
#pragma unroll
        for (int ks = 0; ks < 8; ++ks) sfr[ks] = *(const bf16x8*)(STB + (((size_t)U * 4 + et) * 8 + ks) * 1024 + lane * 16);
#pragma unroll
        for (int st = 0; st < 2; ++st)
#pragma unroll
            for (int kp = 0; kp < 2; ++kp) { const bf16* vp = VT + (size_t)(h * 128 + et * 32 + tl) * S_ + c * 64 + st * 32 + 16 * kp + 4 * hf; vlo[st][kp] = *(const s16x4*)vp; vhi[st][kp] = *(const s16x4*)(vp + 8); }
#pragma unroll
        for (int rq = 0; rq < 4; ++rq) { const int e0 = h * 128 + et * 32 + 8 * rq + 4 * hf; ogr[rq] = *(const f32x4*)(ogain + e0); gwr[rq] = *(const u32x2*)(G + (size_t)t * D_ + e0); }
        EPI_FENCE();
        if (U + NG < 2048) C2_STAGE(U + NG, par ^ 1);
        EPI_FENCE();
        const LAS unsigned char* qrow = C2_ROWQ(rt) + 8 * hf; const LAS unsigned char* brow = C2_ROW4(BCt, rt) + 8 * hf; const LAS unsigned char* b31 = C2_ROW4(BCt, 31) + 8 * hf;
        bf16x8 qt[8];
#pragma unroll
        for (int ks = 0; ks < 8; ++ks) {
            const u32x2 qa = *(const LAS u32x2*)(qrow + 32 * ks), qb2 = *(const LAS u32x2*)(qrow + 32 * ks + 16);
            const float q[8] = {bf_lo(qa.x), bf_hi(qa.x), bf_lo(qa.y), bf_hi(qa.y), bf_lo(qb2.x), bf_hi(qb2.x), bf_lo(qb2.y), bf_hi(qb2.y)};
            const f32x4 b0 = C2_H4(brow + 32 * ks), b1 = C2_H4(brow + 32 * ks + 16);
            float v[8];
#pragma unroll
            for (int e = 0; e < 4; ++e) { v[e] = q[e] * __expf(b0[e]); v[4 + e] = q[4 + e] * __expf(b1[e]); }
            qt[ks] = pack8(v);
            if (ks & 1) asm volatile("" ::: "memory");
        }
        f32x16 acc;
#pragma unroll
        for (int i = 0; i < 16; ++i) acc[i] = 0.f;
#pragma unroll
        for (int ks = 0; ks < 8; ++ks) {
            acc = MFMA32(sfr[ks], qt[ks], acc);
        }
        if (et <= tt) {
            const int st = et;
            const LAS unsigned char* frow = C2_ROW4(Ft, st * 32 + tl) + 8 * hf; const LAS unsigned char* srow = C2_ROW4(BCt, st * 32 + tl) + 8 * hf;
            f32x16 X;
#pragma unroll
            for (int i = 0; i < 16; ++i) X[i] = 0.f;
#pragma unroll
            for (int ks = 0; ks < 8; ++ks) {
                const f32x4 f0 = C2_H4(frow + 32 * ks), f1 = C2_H4(frow + 32 * ks + 16);
                const f32x4 b0 = C2_H4(srow + 32 * ks), b1 = C2_H4(srow + 32 * ks + 16);
                f32x4 c0 = {0.f, 0.f, 0.f, 0.f}, c1 = {0.f, 0.f, 0.f, 0.f};
                bf16x8 qb = qt[ks];
                if (st == 1) {
                    c0 = C2_H4(b31 + 32 * ks); c1 = C2_H4(b31 + 32 * ks + 16);
                    const u32x2 qa = *(const LAS u32x2*)(qrow + 32 * ks), qb2 = *(const LAS u32x2*)(qrow + 32 * ks + 16);
                    const float q[8] = {bf_lo(qa.x), bf_hi(qa.x), bf_lo(qa.y), bf_hi(qa.y), bf_lo(qb2.x), bf_hi(qb2.x), bf_lo(qb2.y), bf_hi(qb2.y)};
                    const f32x4 t0 = C2_H4(brow + 32 * ks), t1 = C2_H4(brow + 32 * ks + 16);
                    float w[8];
#pragma unroll
                    for (int e = 0; e < 4; ++e) { w[e] = q[e] * __expf(t0[e] - c0[e]); w[4 + e] = q[4 + e] * __expf(t1[e] - c1[e]); }
                    qb = pack8(w);
                }
                float v[8];
#pragma unroll
                for (int e = 0; e < 4; ++e) { v[e] = f0[e] * __expf(c0[e] - b0[e]); v[4 + e] = f1[e] * __expf(c1[e] - b1[e]); }
                X = MFMA32(pack8(v), qb, X);
                if (ks & 1) asm volatile("" ::: "memory");
            }
            if (st == tt) {
#pragma unroll
                for (int r = 0; r < 16; ++r) { const int sl = (r & 3) + 8 * (r >> 2) + 4 * hf; X[r] = (sl <= tl) ? X[r] : 0.f; }
            }
#pragma unroll
            for (int kp = 0; kp < 2; ++kp) {
                float xv[8];
#pragma unroll
                for (int i = 0; i < 8; ++i) xv[i] = X[8 * kp + i];
                *(LAS bf16x8*)(XFt + ((st + tt) * 2 + kp) * 1024 + lane * 16) = pack8(xv);
            }
        }
        LDS_WAIT();
        __syncthreads();
#pragma unroll
        for (int st = 0; st < 2; ++st) {
            if (st <= tt) {
#pragma unroll
                for (int kp = 0; kp < 2; ++kp) {
                    const bf16x8 xb = *(const LAS bf16x8*)(XFt + ((st + tt) * 2 + kp) * 1024 + lane * 16);
                    const s16x4 lo = vlo[st][kp], hi = vhi[st][kp];
                    const bf16x8 vf = {lo[0], lo[1], lo[2], lo[3], hi[0], hi[1], hi[2], hi[3]};
                    acc = MFMA32(vf, xb, acc);
                }
            }
        }
        float ss = 0.f;
#pragma unroll
        for (int i = 0; i < 16; ++i) ss += acc[i] * acc[i];
        ss += __shfl_xor(ss, 32);
        if (hf == 0) SSt[rt * 4 + et] = ss;
        LDS_WAIT();
        __syncthreads();
        const f32x4 s4 = *(const LAS f32x4*)(SSt + rt * 4);
        const float rstd = __builtin_amdgcn_rsqf(((s4[0] + s4[1]) + (s4[2] + s4[3])) * (1.0f / 128.0f) + EPS_);
        LDS_WAIT();
        __syncthreads();
        u32x2 wo[4];
#pragma unroll
        for (int rq = 0; rq < 4; ++rq) {
            const f32x4 og = ogr[rq];
            const u32x2 gw = gwr[rq];
            const float g0 = bf_lo(gw.x), g1 = bf_hi(gw.x), g2 = bf_lo(gw.y), g3 = bf_hi(gw.y);
            wo[rq].x = pk2(acc[4 * rq] * rstd * og[0] * g0, acc[4 * rq + 1] * rstd * og[1] * g1);
            wo[rq].y = pk2(acc[4 * rq + 2] * rstd * og[2] * g2, acc[4 * rq + 3] * rstd * og[3] * g3);
        }
        { bf16* op_ = AO + (size_t)t * D_ + h * 128 + et * 32 + 4 * hf;
          asm volatile("global_store_dwordx2 %0, %1, off\n\tglobal_store_dwordx2 %0, %2, off offset:16\n\tglobal_store_dwordx2 %0, %3, off offset:32\n\tglobal_store_dwordx2 %0, %4, off offset:48"
                       :: "v"(op_), "v"(wo[0]), "v"(wo[1]), "v"(wo[2]), "v"(wo[3]) : "memory"); }
    }
#undef C2_STAGE
#undef C2_DMA
#undef C2_ROW4
#undef C2_ROWQ
#undef C2_H4
}

constexpr int N_PHASE_IDS = 41;
__global__ void __launch_bounds__(NTHREADS, 2) fwd(Args args) {
    extern __shared__ __attribute__((aligned(16))) unsigned char lds_raw[];
    LAS unsigned char* lds = (LAS unsigned char*)lds_raw;
    const int tid = threadIdx.x, lane = tid & 63, wave = __builtin_amdgcn_readfirstlane(tid >> 6);
    const int G = gridDim.x;
    const int NGW = G * NWAVES;
    unsigned char* ws_k = args.ws;
#if MK_ONE_LAUNCH
    constexpr int lo = 0, hi = N_PHASE_IDS; constexpr bool multi = true;
#else
    const int lo = args.ph_lo, hi = args.ph_hi;
    const bool multi = (hi - lo) > 1;
#endif
    volatile LAS unsigned* MISC = (volatile LAS unsigned*)(lds + LDS_MISC);
    if (tid < 4) MISC[tid] = 0u;
    __syncthreads();
    XcdBarrier bar; bar.bar = (unsigned*)(ws_k + WS_CTL) + CW_BAR; bar.x = 0; bar.st = MISC;
    if (multi) bar = xcd_barrier_post((unsigned*)(ws_k + WS_CTL) + CW_BAR, MISC);
#ifndef PH_MASK
#define PH_MASK 0xFFFF
#endif
#define IN(k) (lo <= (k) && (k) < hi)
#define EN(b) ((PH_MASK >> (b)) & 1)
#ifndef PROBE_DUP
#define PROBE_DUP 0
#endif
#ifndef PROBE_MODE
#define PROBE_MODE 0
#endif
#ifndef PROBE_BAR
#define PROBE_BAR 0
#endif
#define REP(b) for (int rep_ = ((PROBE_DUP >> (b)) & 1); rep_ >= 0; --rep_)
#define OPQ() __builtin_amdgcn_s_waitcnt(0); int tid_ = tid, bid_ = (int)blockIdx.x; GAS unsigned char* wsg_ = (GAS unsigned char*)ws_k; asm volatile("" : "+v"(tid_), "+s"(bid_), "+s"(wsg_)); unsigned char* ws = (unsigned char*)wsg_; float* X = (float*)args.out; bf16* XB = (bf16*)(ws + WS_XB); bf16* AO = (bf16*)(ws + WS_AO); float* SSQ = (float*)(ws + (sqp ? WS_SSQ1 : WS_SSQ)); float* SSQO = (float*)(ws + (sqp ? WS_SSQ : WS_SSQ1)); float* XS = (float*)(ws + WS_XS); (void)X; (void)XB; (void)AO; (void)SSQ; (void)SSQO; (void)XS; const int lane_ = tid_ & 63, wave_ = __builtin_amdgcn_readfirstlane(tid_ >> 6), gw_ = bid_ * NWAVES + wave_; (void)lane_; (void)gw_
#define SEAM(k) do { if (multi && (k) + 1 < hi) { XcdBarrier b_ = bar; GAS unsigned* bp_ = (GAS unsigned*)b_.bar; asm volatile("" : "+s"(bp_)); b_.bar = (unsigned*)bp_; xcd_barrier(b_); if (PROBE_BAR) xcd_barrier(b_); } } while (0)


    int sqp = 0;
    if (EN(0) && IN(0)) REP(0) { OPQ(); p0_prologue(args, lds, gw_, NGW, lane_, wave_); SEAM(0); }

    for (int l = 0; l < DEPTH_; ++l) {
        const int pb = 1 + 10 * l, j = l >> 1;
        for (int f = 0; f < 2; ++f) {
            const int ff = 2 * l + f, p_gu = pb + (f ? 7 : 0), p_dn = p_gu + 1;
            sqp = (3 * l + (f ? 2 : 0)) & 1;
            if (EN(1) && IN(p_gu)) REP(1) {
                OPQ();
                pg8::StaticOrder S; S.init(S_, 2 * FF_, G, bid_);
                unsigned char* Hp = ws + WS_R + R_H;
                const bool ini8 = (GUI8_MASK >> ff) & 1, in8 = !ini8 && ((GU8_MASK >> ff) & 1), out8 = (DN8_MASK >> ff) & 1;
                constexpr int G8 = GU8_MASK & ~GUI8_MASK & 0xff, G16 = ~GU8_MASK & ~GUI8_MASK & 0xff;
                constexpr int MI1 = GUI8_MASK & DN8_MASK, MI0 = GUI8_MASK & ~DN8_MASK & 0xff;
                constexpr int M11 = G8 & DN8_MASK, M10 = G8 & ~DN8_MASK & 0xff, M01 = G16 & DN8_MASK, M00 = G16 & ~DN8_MASK & 0xff;
                pg8::Gemm g8{ws + WS_X8, ws + WS_WGU + (size_t)ff * SZ_WGU, S_, 2 * FF_, D_}, g16{XB, ws + WS_WGU + (size_t)ff * SZ_WGU, S_, 2 * FF_, 2 * D_};
                if (ini8 && out8) { if constexpr (MI1 != 0) { EpiSwiglu<2, true> E{Hp, SSQ, XS}; pg8::gemm_phase<EpiSwiglu<2, true>, pg8::StaticOrder, true, true, 2>(lds, g8, S, E, tid_); } }
                else if (ini8) { if constexpr (MI0 != 0) { EpiSwiglu<2, false> E{Hp, SSQ, XS}; pg8::gemm_phase<EpiSwiglu<2, false>, pg8::StaticOrder, true, true, 2>(lds, g8, S, E, tid_); } }
                else if (in8 && out8) { if constexpr (M11 != 0) { EpiSwiglu<1, true> E{Hp, SSQ, XS}; pg8::gemm_phase<EpiSwiglu<1, true>, pg8::StaticOrder, true, true, 1>(lds, g8, S, E, tid_); } }
                else if (in8) { if constexpr (M10 != 0) { EpiSwiglu<1, false> E{Hp, SSQ, XS}; pg8::gemm_phase<EpiSwiglu<1, false>, pg8::StaticOrder, true, true, 1>(lds, g8, S, E, tid_); } }
                else if (out8) { if constexpr (M01 != 0) { EpiSwiglu<0, true> E{Hp, SSQ, XS}; pg8::gemm_phase<EpiSwiglu<0, true>, pg8::StaticOrder, true, true, 0>(lds, g16, S, E, tid_); } }
                else { if constexpr (M00 != 0) { EpiSwiglu<0, false> E{Hp, SSQ, XS}; pg8::gemm_phase<EpiSwiglu<0, false>, pg8::StaticOrder, true, true, 0>(lds, g16, S, E, tid_); } }
                if (bid_ >= G / 2 && G == 256) p0_deferred_down(args, lds, ff, (bid_ - G / 2) * NWAVES + wave_, (G / 2) * NWAVES, lane_, wave_);
                else if (G != 256) p0_deferred_down(args, lds, ff, bid_ * NWAVES + wave_, G * NWAVES, lane_, wave_);
                SEAM(p_gu);
            }
            if (EN(2) && IN(p_dn)) REP(2) {
                OPQ();
                pg8::StaticOrder S; S.init(S_, D_, G, bid_);
                EpiResid<true> E{args.in[0], X, XB, ws + WS_X8, SSQ, SSQO, XS, rep_ ? 0.0f : 0.5f, (f == 0) ? (((MIX8_MASK >> l) & 1) ? 1 : 0) : (((GUI8_MASK >> (ff + 1)) & 1) ? 1 : (((GU8_MASK >> (ff + 1)) & 1) ? 2 : 0)), ff == 0, ff == 2 * DEPTH_ - 1};
                if ((DN8_MASK >> ff) & 1) { if constexpr (DN8_MASK != 0) { pg8::Gemm g{ws + WS_R + R_H, ws + WS_WD + (size_t)ff * SZ_WD, S_, D_, FF_};
                        pg8::gemm_phase<EpiResid<true>, pg8::StaticOrder, true, true, 1, true, true>(lds, g, S, E, tid_); } }
                else { if constexpr (DN8_MASK != 0xff) { pg8::Gemm g{ws + WS_R + R_H, ws + WS_WD + (size_t)ff * SZ_WD, S_, D_, 2 * FF_};
                        pg8::gemm_phase<EpiResid<true>, pg8::StaticOrder, true, true, 0, true, true>(lds, g, S, E, tid_); } }
                SEAM(p_dn);
            }
            if (f == 0) {
                sqp = (3 * l + 1) & 1;
                if ((l & 1) == 0) {
                    if (EN(3) && IN(pb + 2)) REP(3) {
                        OPQ();
                        const bool m8 = (MIX8_MASK >> l) & 1;
                        const unsigned char* Wd = ws + WS_DWIN + (size_t)j * SZ_DWIN; const int kbp = m8 ? D_ : 2 * D_;
                        const unsigned char* xa = m8 ? (const unsigned char*)(ws + WS_X8) : (const unsigned char*)XB;
                        {
                            pg8::StaticOrder S; S.init(S_, 4096, G, bid_);
                            EpiDsaIn E{(bf16*)(ws + WS_R + R_PROJ), SSQ, XS, m8};
                            pg8::Gemm g{xa, Wd, S_, 4096, kbp};
                            if (m8) { if constexpr ((MIX8_MASK & 5) != 0) pg8::gemm_phase<EpiDsaIn, pg8::StaticOrder, true, true, 2>(lds, g, S, E, tid_); }
                            else { if constexpr ((MIX8_MASK & 5) != 5) pg8::gemm_phase<EpiDsaIn, pg8::StaticOrder, true, true, 0>(lds, g, S, E, tid_); }
                        }
                        {
                            const int ntk = kbp / 128 / 8;
                            EpiDsaEx E{(float*)(ws + WS_R + R_EX), SSQ, XS, m8};
                            for (int L = bid_; L < 256; L += G) {
                                const int pm = L >> 3, sl = L & 7;
                                pg8::Gemm g{xa + (size_t)sl * ntk * 128, Wd + (size_t)16 * 256 * kbp, S_, 256, kbp, ntk};
                                pg8::SingleOrder S1{pg8::Unit{pm, sl}};
                                if (m8) { if constexpr ((MIX8_MASK & 5) != 0) pg8::gemm_phase<EpiDsaEx, pg8::SingleOrder, true, true, 2>(lds, g, S1, E, tid_); }
                                else { if constexpr ((MIX8_MASK & 5) != 5) pg8::gemm_phase<EpiDsaEx, pg8::SingleOrder, true, true, 0>(lds, g, S1, E, tid_); }
                            }
                        }
                        SEAM(pb + 2);
                    }
                    if (EN(4) && IN(pb + 3)) REP(4) { OPQ(); dsa_prep(ws, args.in[7] + j * 128, args.in[8] + j * 128, args.in[9] + j * 64, gw_, NGW, lane_); SEAM(pb + 3); }
                    if (EN(5) && IN(pb + 4)) REP(5) { OPQ(); dsa_select(ws, lds, tid_, lane_, wave_, bid_, G, (PROBE_MODE == 3) && rep_); SEAM(pb + 4); }
                    if (EN(11) && IN(pb + 5)) REP(11) { OPQ(); dsa_attend(ws, args.in[10], lds, tid_, lane_, wave_, j + 2 * rep_); SEAM(pb + 5); }
                } else {
                    if (EN(6) && IN(pb + 2)) REP(6) {
#define HW_PTRS() const bool m8 = (MIX8_MASK >> l) & 1; const unsigned char* Wb = ws + WS_HWIN + (size_t)j * SZ_HWIN; const size_t wstep = (size_t)D_ * D_ * (m8 ? 1 : 2); const float* lbp = (const float*)(ws + WS_LB) + j * D_; const void* xa = m8 ? (const void*)(ws + WS_X8) : (const void*)XB; const int kbp = m8 ? D_ : 2 * D_; (void)lbp
#define HG_CALL(EPI, SCH, S_, G_, E_) do { if (m8) { if constexpr ((MIX8_MASK & 10) != 0) pg8::gemm_phase<EPI, SCH, true, true, 2>(lds, G_, S_, E_, tid_); } else { if constexpr ((MIX8_MASK & 10) != 10) pg8::gemm_phase<EPI, SCH, true, true, false>(lds, G_, S_, E_, tid_); } } while (0)
                        { OPQ(); HW_PTRS(); pg8::StaticOrder S; S.init(S_, D_, G, bid_);
                          pg8::Gemm g{xa, Wb, S_, D_, kbp}; EpiHgrnIn<0> E{(bf16*)(ws + WS_R + R_Q), nullptr, SSQ, lbp, XS, m8};
                          HG_CALL(EpiHgrnIn<0>, pg8::StaticOrder, S, g, E); }
                        { OPQ(); HW_PTRS(); pg8::StaticOrder S; S.init(S_, D_, G, bid_);
                          pg8::Gemm g{xa, Wb + wstep, S_, D_, kbp}; EpiHgrnIn<1> E{nullptr, (float*)(ws + WS_R + R_F), SSQ, lbp, XS, m8};
                          HG_CALL(EpiHgrnIn<1>, pg8::StaticOrder, S, g, E); }
                        { OPQ(); HW_PTRS(); pg8::StaticOrder S; S.init(S_, D_, G, bid_);
                          pg8::Gemm g{xa, Wb + 2 * wstep, S_, D_, kbp}; EpiHgrnIn<2> E{(bf16*)(ws + WS_R + R_G), nullptr, SSQ, lbp, XS, m8};
                          HG_CALL(EpiHgrnIn<2>, pg8::StaticOrder, S, g, E); }
                        {
                            OPQ(); HW_PTRS();
                            pg8::StaticOrder S; S.init(D_, S_, G, bid_);
                            pg8::Unit uu;
                            LAS float* tab = (LAS float*)(lds + LDS_TAB);
                            for (int i = 0; S.next(i, uu); ++i) {
                                __syncthreads();
                                { const int row = uu.pn * 256 + (tid_ >> 1); const f32x4* p = (const f32x4*)(SSQ + (size_t)row * 32 + 16 * (tid_ & 1));
                                  const f32x4 a = p[0], b = p[1], c = p[2], d = p[3];
                                  float s = (((a[0] + a[1]) + (a[2] + a[3])) + ((b[0] + b[1]) + (b[2] + b[3]))) + (((c[0] + c[1]) + (c[2] + c[3])) + ((d[0] + d[1]) + (d[2] + d[3])));
                                  s += __shfl_xor(s, 1);
                                  if ((tid_ & 1) == 0) tab[tid_ >> 1] = __builtin_amdgcn_rsqf(s * (1.0f / D_) + EPS_) * (m8 ? __builtin_amdgcn_rcpf(XS[row] * WI8_SCALE) : 1.0f); }
                                __syncthreads();
                                pg8::Gemm g{Wb + 3 * wstep, xa, D_, S_, kbp};
                                pg8::SingleOrder S1{uu};
                                EpiHgrnVT E{(bf16*)(ws + WS_R + R_VT), tab, m8};
                                if (m8) { if constexpr ((MIX8_MASK & 10) != 0) pg8::gemm_phase<EpiHgrnVT, pg8::SingleOrder, true, true, 2, true, false>(lds, g, S1, E, tid_); }
                                else { if constexpr ((MIX8_MASK & 10) != 10) pg8::gemm_phase<EpiHgrnVT, pg8::SingleOrder, true, true, false, true, false>(lds, g, S1, E, tid_); }
                            }
                        }
                        SEAM(pb + 2);
                    }
                    if (EN(7) && IN(pb + 3)) REP(7) { OPQ(); hgrn_a2(ws, lds, tid_, lane_, wave_, bid_, G); SEAM(pb + 3); }
                    if (EN(8) && IN(pb + 4)) REP(8) { OPQ(); hgrn_b(ws, bid_ * NTHREADS + tid_, G * NTHREADS, rep_); SEAM(pb + 4); }
                    if (EN(9) && IN(pb + 5)) REP(9) { OPQ(); hgrn_c2(ws, args.in[14] + j * D_, lds, tid_, lane_, wave_, bid_, G); SEAM(pb + 5); }
                }
                if (EN(10) && IN(pb + 6)) REP(10) {
                    OPQ();
                    const bf16* Wo = (l & 1) ? (const bf16*)(ws + WS_HWO + (size_t)j * SZ_WO) : (const bf16*)(ws + WS_DWO + (size_t)j * SZ_WO);
                    pg8::Gemm g{AO, Wo, S_, D_, 2 * D_}; pg8::StaticOrder S; S.init(S_, D_, G, bid_);
                    EpiResid<false> E{args.in[0], X, XB, ws + WS_X8, SSQ, SSQO, XS, rep_ ? 0.0f : 1.0f, ((GUI8_MASK >> (2 * l + 1)) & 1) ? 1 : (((GU8_MASK >> (2 * l + 1)) & 1) ? 2 : 0), false, false};
                    pg8::gemm_phase<EpiResid<false>, pg8::StaticOrder, true, true>(lds, g, S, E, tid_);
                    SEAM(pb + 6);
                }
            }
        }
    }
#undef IN
#undef SEAM
}

extern "C" void kernel_launch(void* const* d_in, const int* in_sizes, int n_in, void* d_out, int out_size, void* d_ws, size_t ws_size, hipStream_t stream) {
    static int grid = 0;
    if (grid == 0) {
        if (n_in != 15 || in_sizes[0] != S_ * D_ || out_size != S_ * D_ || ws_size < WS_END) {
            fprintf(stderr, "kernel_launch: unexpected shapes/workspace (n_in %d, in0 %d, out %d, ws %zu, need %zu); nothing launched\n", n_in, n_in > 0 ? in_sizes[0] : -1, out_size, ws_size, (size_t)WS_END);
            grid = -1; return; }
        int dev = 0, cus = 0, per_cu = 0;
        if (hipGetDevice(&dev) != hipSuccess || hipDeviceGetAttribute(&cus, hipDeviceAttributeMultiprocessorCount, dev) != hipSuccess) { grid = -1; return; }
        if (hipFuncSetAttribute((const void*)fwd, hipFuncAttributeMaxDynamicSharedMemorySize, LDS_BYTES) != hipSuccess) { fprintf(stderr, "kernel_launch: hipFuncSetAttribute failed\n"); grid = -1; return; }
        if (hipOccupancyMaxActiveBlocksPerMultiprocessor(&per_cu, (const void*)fwd, NTHREADS, LDS_BYTES) != hipSuccess || per_cu < 1)
            fprintf(stderr, "kernel_launch: note: occupancy query reports %d workgroups per CU\n", per_cu);
        (void)hipGetLastError();
        grid = cus;
    }
    if (grid < 0) return;
    if (hipMemsetAsync((char*)d_ws + WS_CTL, 0, CTL_ZERO_BYTES, stream) != hipSuccess) return;
    Args a{};
    for (int i = 0; i < 15; ++i) a.in[i] = (const float*)d_in[i];
    a.out = (float*)d_out; a.ws = (unsigned char*)d_ws;
#if MK_ONE_LAUNCH
    a.ph_lo = 0; a.ph_hi = N_PHASE_IDS;
    hipLaunchKernelGGL(fwd, dim3(grid), dim3(NTHREADS), LDS_BYTES, stream, a);
#else
    for (int p = 0; p < N_PHASE_IDS; ++p) {
        const int r = (p - 1) % 10, l = (p - 1) / 10;
        if (p > 0) { if (r == 9) continue; }
        a.ph_lo = p; a.ph_hi = p + 1;
        hipLaunchKernelGGL(fwd, dim3(grid), dim3(NTHREADS), LDS_BYTES, stream, a);
    }
#endif
}
```
